# Optimizing an MI355X kernel written in HIP

```python
import jax
import jax.numpy as jnp
from jax import lax
import numpy as np

D_MODEL = 1024
BATCH = 4
SEQ = 8192
DEPTH = 4

GRID_W = 64
CTX_LEN = 256
N_MIXERS = 3
N_MLA_LAYERS = (DEPTH + 2) // 3
N_NA_LAYERS = (DEPTH + 1) // 3
N_SWA_LAYERS = DEPTH // 3

D_FF = -(-8 * D_MODEL // (3 * 256)) * 256
NORM_EPS = 1e-6
ROPE_THETA = 10000.0
NEG_INF = -1e30
Q_BLOCK = 128

MLA_HEADS = D_MODEL // 128
MLA_Q_LORA = D_MODEL // 4
MLA_KV_LORA = D_MODEL // 4
MLA_NOPE = 128
MLA_ROPE = 64
MLA_V = 128

NA_HEADS = D_MODEL // 64
NA_HEAD_DIM = 64
NA_WIN_ROWS = 8
NA_WIN_COLS = 16

SWA_HEADS = D_MODEL // 64
SWA_KV_HEADS = SWA_HEADS // 8
SWA_HEAD_DIM = 64
SWA_WINDOW = 128
SWA_BLOCK = 128

kernel_name = "hybrid_mla_na_swa_dit_trunk"


def rms_norm(x, g):
    xf = x.astype(jnp.float32)
    y = xf * lax.rsqrt(jnp.mean(xf * xf, axis=-1, keepdims=True) + NORM_EPS)
    return (y * g.astype(jnp.float32)).astype(x.dtype)


def modulate(h, shift, scale):
    return h * (1 + scale) + shift


def axial_rope_tables(n_tokens, rot_dim):
    t = jnp.arange(n_tokens)
    row = (t // GRID_W).astype(jnp.float32)
    col = (t % GRID_W).astype(jnp.float32)
    n_freq = rot_dim // 4
    inv = ROPE_THETA ** (-jnp.arange(n_freq, dtype=jnp.float32) / n_freq)
    ang = jnp.concatenate([row[:, None] * inv, col[:, None] * inv], axis=-1)
    return jnp.cos(ang), jnp.sin(ang)


def apply_rope(x, cos, sin):
    xf = x.astype(jnp.float32)
    half = xf.shape[-1] // 2
    x1, x2 = xf[..., :half], xf[..., half:]
    cs, sn = cos[None, :, None, :], sin[None, :, None, :]
    return jnp.concatenate([x1 * cs - x2 * sn, x2 * cs + x1 * sn], axis=-1).astype(x.dtype)


def softmax_attend(q, k, v, scale):
    s = jnp.einsum('bqhd,bkhd->bhqk', q, k).astype(jnp.float32) * scale
    p = jax.nn.softmax(s, axis=-1).astype(v.dtype)
    return jnp.einsum('bhqk,bkhd->bqhd', p, v)


def dense_block_attention(q, k, v, scale):
    b, n, h, dk = q.shape
    nb = n // Q_BLOCK
    qb = jnp.moveaxis(q.reshape(b, nb, Q_BLOCK, h, dk), 1, 0)
    out = lax.map(lambda q_blk: softmax_attend(q_blk, k, v, scale), qb)
    return jnp.moveaxis(out, 0, 1).reshape(b, n, h, v.shape[-1])


def swiglu(h, w_in, w_out):
    gate, up = jnp.split(h @ w_in, 2, axis=-1)
    return (jax.nn.silu(gate) * up) @ w_out


def mla_project(h, w_in, g_q, w_uq, g_kv, w_ukv):
    b, n, _ = h.shape
    a = h @ w_in
    q_lat = a[..., :MLA_Q_LORA]
    kv_lat = a[..., MLA_Q_LORA:MLA_Q_LORA + MLA_KV_LORA]
    k_pe = a[..., MLA_Q_LORA + MLA_KV_LORA:][:, :, None, :]
    q = (rms_norm(q_lat, g_q) @ w_uq).reshape(b, n, MLA_HEADS, MLA_NOPE + MLA_ROPE)
    kv = (rms_norm(kv_lat, g_kv) @ w_ukv).reshape(b, n, MLA_HEADS, MLA_NOPE + MLA_V)
    return q[..., :MLA_NOPE], q[..., MLA_NOPE:], kv[..., :MLA_NOPE], k_pe, kv[..., MLA_NOPE:]


def mla_assemble(q_nope, q_pe, k_nope, k_pe):
    q = jnp.concatenate([q_nope, q_pe], axis=-1)
    k = jnp.concatenate([k_nope, jnp.broadcast_to(k_pe, k_nope.shape[:-1] + (MLA_ROPE,))], axis=-1)
    return q, k


def mla_mixer(hx, hc, w_in, g_q, w_uq, g_kv, w_ukv, w_o, ctx_out):
    b, n, _ = hx.shape
    scale = (MLA_NOPE + MLA_ROPE) ** -0.5
    q_nope, q_pe, k_nope, k_pe, v = mla_project(hx, w_in, g_q, w_uq, g_kv, w_ukv)
    cos, sin = axial_rope_tables(n, MLA_ROPE)
    q, k = mla_assemble(q_nope, apply_rope(q_pe, cos, sin), k_nope, apply_rope(k_pe, cos, sin))
    cq_nope, cq_pe, ck_nope, ck_pe, vc = mla_project(hc, w_in, g_q, w_uq, g_kv, w_ukv)
    qc, kc = mla_assemble(cq_nope, cq_pe, ck_nope, ck_pe)
    k_all = jnp.concatenate([kc, k], axis=1)
    v_all = jnp.concatenate([vc, v], axis=1)
    ox = dense_block_attention(q, k_all, v_all, scale).reshape(b, n, MLA_HEADS * MLA_V) @ w_o
    oc = None
    if ctx_out:
        oc = softmax_attend(qc, kc, vc, scale).reshape(b, hc.shape[1], MLA_HEADS * MLA_V) @ w_o
    return ox, oc


def na_mixer(hx, hc, w_qkv, rpb, w_o, ctx_out):
    b, n, _ = hx.shape
    rows = n // GRID_W
    wr = min(NA_WIN_ROWS, rows)
    wc = NA_WIN_COLS
    hd = NA_HEADS * NA_HEAD_DIM
    scale = NA_HEAD_DIM ** -0.5
    qkv = (hx @ w_qkv).reshape(b, rows, GRID_W, 3, NA_HEADS, NA_HEAD_DIM)
    q, k, v = qkv[..., 0, :, :], qkv[..., 1, :, :], qkv[..., 2, :, :]
    lc = hc.shape[1]
    qkv_c = (hc @ w_qkv).reshape(b, lc, 3, NA_HEADS, NA_HEAD_DIM)
    qc, kc, vc = qkv_c[:, :, 0], qkv_c[:, :, 1], qkv_c[:, :, 2]
    cols = jnp.arange(GRID_W)
    col_start = jnp.clip(cols - wc // 2, 0, GRID_W - wc)
    col_ok = (cols[None, :] >= col_start[:, None]) & (cols[None, :] < col_start[:, None] + wc)
    col_idx = jnp.clip(cols[None, :] - cols[:, None], 1 - wc, wc - 1) + (NA_WIN_COLS - 1)

    def one_row(r):
        rs = jnp.clip(r - wr // 2, 0, rows - wr)
        q_r = lax.dynamic_index_in_dim(q, r, axis=1, keepdims=False)
        k_r = lax.dynamic_slice_in_dim(k, rs, wr, axis=1)
        v_r = lax.dynamic_slice_in_dim(v, rs, wr, axis=1)
        s = jnp.einsum('bqhd,bikhd->bhqik', q_r, k_r).astype(jnp.float32) * scale
        row_idx = rs + jnp.arange(wr) - r + (NA_WIN_ROWS - 1)
        bias = rpb[:, row_idx[None, :, None], col_idx[:, None, :]]
        s = jnp.where(col_ok[:, None, :], s + bias.astype(jnp.float32), NEG_INF)
        s_c = jnp.einsum('bqhd,bkhd->bhqk', q_r, kc).astype(jnp.float32) * scale
        logits = jnp.concatenate([s.reshape(b, NA_HEADS, GRID_W, wr * GRID_W), s_c], axis=-1)
        p = jax.nn.softmax(logits, axis=-1).astype(v.dtype)
        p_n = p[..., :wr * GRID_W].reshape(b, NA_HEADS, GRID_W, wr, GRID_W)
        p_c = p[..., wr * GRID_W:]
        return jnp.einsum('bhqik,bikhd->bqhd', p_n, v_r) + jnp.einsum('bhqk,bkhd->bqhd', p_c, vc)

    out = lax.map(one_row, jnp.arange(rows))
    ox = jnp.moveaxis(out, 0, 1).reshape(b, n, hd) @ w_o
    oc = None
    if ctx_out:
        oc = softmax_attend(qc, kc, vc, scale).reshape(b, lc, hd) @ w_o
    return ox, oc


def swa_mixer(hx, hc, w_qkv, sink, w_o, ctx_out):
    b, n, _ = hx.shape
    hq, hk, dh = SWA_HEADS, SWA_KV_HEADS, SWA_HEAD_DIM
    g = hq // hk
    scale = dh ** -0.5

    def split_qkv(h):
        a = h @ w_qkv
        lead = a.shape[:2]
        q_ = a[..., :hq * dh].reshape(lead + (hq, dh))
        k_ = a[..., hq * dh:(hq + hk) * dh].reshape(lead + (hk, dh))
        v_ = a[..., (hq + hk) * dh:].reshape(lead + (hk, dh))
        return q_, k_, v_

    q, k, v = split_qkv(hx)
    qc, kc, vc = split_qkv(hc)
    lc = hc.shape[1]
    cos, sin = axial_rope_tables(n, dh)
    q = apply_rope(q, cos, sin)
    k = apply_rope(k, cos, sin)
    sink_l = sink.astype(jnp.float32).reshape(hk, g)
    pad = ((0, 0), (SWA_WINDOW, SWA_WINDOW), (0, 0), (0, 0))
    kp = jnp.pad(k, pad)
    vp = jnp.pad(v, pad)
    nb = n // SWA_BLOCK
    span = SWA_BLOCK + 2 * SWA_WINDOW
    qb = jnp.moveaxis(q.reshape(b, nb, SWA_BLOCK, hk, g, dh), 1, 0)
    rel = jnp.arange(span)[None, :] - SWA_WINDOW - jnp.arange(SWA_BLOCK)[:, None]

    def one_block(args):
        blk, q_blk = args
        start = blk * SWA_BLOCK
        k_blk = lax.dynamic_slice_in_dim(kp, start, span, axis=1)
        v_blk = lax.dynamic_slice_in_dim(vp, start, span, axis=1)
        kpos = start - SWA_WINDOW + jnp.arange(span)
        ok = (jnp.abs(rel) <= SWA_WINDOW) & ((kpos >= 0) & (kpos < n))[None, :]
        s = jnp.einsum('bqkgd,bjkd->bkgqj', q_blk, k_blk).astype(jnp.float32) * scale
        s = jnp.where(ok, s, NEG_INF)
        s_c = jnp.einsum('bqkgd,bjkd->bkgqj', q_blk, kc).astype(jnp.float32) * scale
        sink_col = jnp.broadcast_to(sink_l[None, :, :, None, None], s.shape[:-1] + (1,))
        p = jax.nn.softmax(jnp.concatenate([s, s_c, sink_col], axis=-1), axis=-1).astype(v.dtype)
        return (jnp.einsum('bkgqj,bjkd->bqkgd', p[..., :span], v_blk)
                + jnp.einsum('bkgqj,bjkd->bqkgd', p[..., span:span + lc], vc))

    out = lax.map(one_block, (jnp.arange(nb), qb))
    ox = jnp.moveaxis(out, 0, 1).reshape(b, n, hq * dh) @ w_o
    oc = None
    if ctx_out:
        qcg = qc.reshape(b, lc, hk, g, dh)
        s = jnp.einsum('bqkgd,bjkd->bkgqj', qcg, kc).astype(jnp.float32) * scale
        sink_col = jnp.broadcast_to(sink_l[None, :, :, None, None], s.shape[:-1] + (1,))
        p = jax.nn.softmax(jnp.concatenate([s, sink_col], axis=-1), axis=-1)[..., :lc].astype(vc.dtype)
        oc = jnp.einsum('bkgqj,bjkd->bqkgd', p, vc).reshape(b, lc, hq * dh) @ w_o
    return ox, oc


def setup_inputs(seed: int = 0) -> dict:
    key = jax.random.key(seed)
    keys = iter(jax.random.split(key, 32))
    D = D_MODEL

    def normal(shape, std=1.0):
        return jax.random.normal(next(keys), shape, jnp.float32) * std

    def weight(shape, fan_in, gain=1.0):
        return normal(shape, gain * fan_in ** -0.5)

    def norm_gain(shape):
        return 1.0 + normal(shape, 0.05)

    return {
        "x": normal((BATCH, SEQ, D)),
        "c": normal((BATCH, D)),
        "ctx": normal((BATCH, CTX_LEN, D)),
        "c_ctx": normal((D,)),
        "w_mod": weight((DEPTH, D, 6 * D), D, 0.5),
        "b_mod": normal((DEPTH, 6 * D), 0.02),
        "g_pre_mix": norm_gain((DEPTH, D)),
        "g_post_mix": norm_gain((DEPTH, D)),
        "g_pre_ffn": norm_gain((DEPTH, D)),
        "g_post_ffn": norm_gain((DEPTH, D)),
        "w_ffn_in": weight((DEPTH, D, 2 * D_FF), D),
        "w_ffn_out": weight((DEPTH, D_FF, D), D_FF),
        "mla_w_in": weight((N_MLA_LAYERS, D, MLA_Q_LORA + MLA_KV_LORA + MLA_ROPE), D),
        "mla_g_q": norm_gain((N_MLA_LAYERS, MLA_Q_LORA)),
        "mla_w_uq": weight((N_MLA_LAYERS, MLA_Q_LORA, MLA_HEADS * (MLA_NOPE + MLA_ROPE)), MLA_Q_LORA),
        "mla_g_kv": norm_gain((N_MLA_LAYERS, MLA_KV_LORA)),
        "mla_w_ukv": weight((N_MLA_LAYERS, MLA_KV_LORA, MLA_HEADS * (MLA_NOPE + MLA_V)), MLA_KV_LORA),
        "mla_w_o": weight((N_MLA_LAYERS, MLA_HEADS * MLA_V, D), MLA_HEADS * MLA_V),
        "na_w_qkv": weight((N_NA_LAYERS, D, 3 * NA_HEADS * NA_HEAD_DIM), D),
        "na_rpb": normal((N_NA_LAYERS, NA_HEADS, 2 * NA_WIN_ROWS - 1, 2 * NA_WIN_COLS - 1), 0.1),
        "na_w_o": weight((N_NA_LAYERS, NA_HEADS * NA_HEAD_DIM, D), NA_HEADS * NA_HEAD_DIM),
        "swa_w_qkv": weight((N_SWA_LAYERS, D, (SWA_HEADS + 2 * SWA_KV_HEADS) * SWA_HEAD_DIM), D),
        "swa_sink": normal((N_SWA_LAYERS, SWA_HEADS), 0.5),
        "swa_w_o": weight((N_SWA_LAYERS, SWA_HEADS * SWA_HEAD_DIM, D), SWA_HEADS * SWA_HEAD_DIM),
    }


def reference(x, c, ctx, c_ctx, w_mod, b_mod, g_pre_mix, g_post_mix, g_pre_ffn, g_post_ffn,
              w_ffn_in, w_ffn_out, mla_w_in, mla_g_q, mla_w_uq, mla_g_kv, mla_w_ukv, mla_w_o,
              na_w_qkv, na_rpb, na_w_o, swa_w_qkv, swa_sink, swa_w_o):
    for i in range(DEPTH):
        last = i == DEPTH - 1
        mod_x = jax.nn.silu(c) @ w_mod[i] + b_mod[i]
        mod_c = jax.nn.silu(c_ctx) @ w_mod[i] + b_mod[i]
        sh_m, sc_m, gt_m, sh_f, sc_f, gt_f = jnp.split(mod_x[:, None, :], 6, axis=-1)
        csh_m, csc_m, cgt_m, csh_f, csc_f, cgt_f = jnp.split(mod_c, 6, axis=-1)

        hx = modulate(rms_norm(x, g_pre_mix[i]), sh_m, sc_m)
        hc = modulate(rms_norm(ctx, g_pre_mix[i]), csh_m, csc_m)
        kind, j = i % N_MIXERS, i // N_MIXERS
        if kind == 0:
            ox, oc = mla_mixer(hx, hc, mla_w_in[j], mla_g_q[j], mla_w_uq[j], mla_g_kv[j],
                               mla_w_ukv[j], mla_w_o[j], not last)
        elif kind == 1:
            ox, oc = na_mixer(hx, hc, na_w_qkv[j], na_rpb[j], na_w_o[j], not last)
        else:
            ox, oc = swa_mixer(hx, hc, swa_w_qkv[j], swa_sink[j], swa_w_o[j], not last)

        x = x + gt_m * rms_norm(ox, g_post_mix[i])
        hx = modulate(rms_norm(x, g_pre_ffn[i]), sh_f, sc_f)
        x = x + gt_f * rms_norm(swiglu(hx, w_ffn_in[i], w_ffn_out[i]), g_post_ffn[i])

        if not last:
            ctx = ctx + cgt_m * rms_norm(oc, g_post_mix[i])
            hc = modulate(rms_norm(ctx, g_pre_ffn[i]), csh_f, csc_f)
            ctx = ctx + cgt_f * rms_norm(swiglu(hc, w_ffn_in[i], w_ffn_out[i]), g_post_ffn[i])
    return x
```

```cpp
#include <hip/hip_runtime.h>
#include <hip/hip_cooperative_groups.h>
#include <cstdio>
#include <cstdint>
namespace cg = cooperative_groups;

constexpr int DM = 1024, NBATCH = 4, SEQ = 8192, NLAT = NBATCH * SEQ, LC = 256, NCTX = NBATCH * LC, TOK = NLAT + NCTX, DFF = 2816, DEPTH = 4;
constexpr int MLA_KEYS = SEQ + LC;
#ifndef MLA_SDEPTH
#define MLA_SDEPTH 1
#endif
namespace pg8 {
#define PG8_LAS __attribute__((address_space(3)))
typedef unsigned short bf16_t;
typedef short bf16x8 __attribute__((ext_vector_type(8)));
typedef float f32x4 __attribute__((ext_vector_type(4)));
typedef unsigned u32x4 __attribute__((ext_vector_type(4)));
constexpr int BM = 256, BK = 64, HALF = 128, HTB = HALF * BK * 2  , STAGE_BYTES = 8 * HTB, NXCD = 8, WGM = 8;

__host__ __device__ __forceinline__ int lds_byte(int r, int c) { const int st = (r >> 4) * 2 + (c >> 5), rr = r & 15, cc = c & 31, ob = rr * 64 + cc * 2; return st * 1024 + (ob ^ (((ob >> 9) & 1) << 5)); }
__host__ __device__ __forceinline__ void stage_rc(int b, int& R, int& C) { const int st = b / 1024, sb = b % 1024, swz = sb ^ (((sb >> 9) & 1) << 5); R = (st >> 1) * 16 + swz / 64; C = (st & 1) * 32 + (swz % 64) / 2; }
__host__ __device__ __forceinline__ int perm32(int rho) { const int n = rho >> 4, i = rho & 15; return 8 * (i >> 2) + 4 * n + (i & 3); }

struct Unit { int pm, pn; };
struct Gemm { const bf16_t* A; const bf16_t* Bt; int M, N, K; };

struct StaticOrder {
    int nM, nN, nwg, G, c;
    __host__ __device__ void init(int M, int N, int G_, int c_) { nM = M / BM; nN = N / BM; nwg = nM * nN; G = G_; c = c_; }
    __host__ __device__ bool next(int i, Unit& u) const {
        const long L = (long)i * G + c; if (L >= nwg) return false;
        int wgid = (int)L; { const int q = nwg / NXCD, r = nwg % NXCD, xcd = wgid % NXCD, off = wgid / NXCD; wgid = (xcd < r ? xcd * (q + 1) : r * (q + 1) + (xcd - r) * q) + off; }
        const int nig = WGM * nN, gid = wgid / nig, fm = gid * WGM, gsz = (nM - fm) < WGM ? (nM - fm) : WGM;
        u.pm = fm + ((wgid % nig) % gsz); u.pn = (wgid % nig) / gsz; return true;
    }
    __device__ __forceinline__ void a_ready(const Unit&) const {}
    __device__ __forceinline__ void done(const Unit&) const {}
};

__device__ __forceinline__ unsigned cvt_pk_bf16(float lo, float hi) { unsigned r; asm volatile("v_cvt_pk_bf16_f32 %0, %1, %2" : "=v"(r) : "v"(lo), "v"(hi)); return r; }
typedef float f32x2 __attribute__((ext_vector_type(2)));
struct EpiArgs { int kind; int ldc; bf16_t* o0; bf16_t* o1; const float* rope; };
__device__ __forceinline__ u32x4 pack8(const f32x4& v0, const f32x4& v1) { u32x4 w; w.x = cvt_pk_bf16(v0[0], v0[1]); w.y = cvt_pk_bf16(v0[2], v0[3]); w.z = cvt_pk_bf16(v1[0], v1[1]); w.w = cvt_pk_bf16(v1[2], v1[3]); return w; }
__device__ __forceinline__ void rope8(f32x4& v0, f32x4& v1, const float* rp) {
    const f32x4 a = *(const f32x4*)rp, b = *(const f32x4*)(rp + 4);
    const f32x4 x0 = v0, x1 = v1;
    v0[0] = x0[0] * a[0] - x0[1] * a[1]; v0[1] = x0[1] * a[0] + x0[0] * a[1];
    v0[2] = x0[2] * a[2] - x0[3] * a[3]; v0[3] = x0[3] * a[2] + x0[2] * a[3];
    v1[0] = x1[0] * b[0] - x1[1] * b[1]; v1[1] = x1[1] * b[0] + x1[0] * b[1];
    v1[2] = x1[2] * b[2] - x1[3] * b[3]; v1[3] = x1[3] * b[2] + x1[2] * b[3];
}
template <int KIND> __device__ __forceinline__ void emit8(const EpiArgs& a, int row, int col, f32x4 v0, f32x4 v1) {
    if constexpr (KIND == 0) { *(u32x4*)(a.o0 + (size_t)row * a.ldc + col) = pack8(v0, v1); }
    else if constexpr (KIND == 1) {
        float r[4];
#pragma unroll
        for (int i = 0; i < 4; ++i) { const float g = v0[i]; r[i] = g * v1[i] * __builtin_amdgcn_rcpf(1.0f + __builtin_amdgcn_exp2f(-g * 1.4426950408889634f)); }
        typedef unsigned u32x2 __attribute__((ext_vector_type(2))); u32x2 w; w.x = cvt_pk_bf16(r[0], r[1]); w.y = cvt_pk_bf16(r[2], r[3]);
        *(u32x2*)(a.o0 + (size_t)row * DFF + (col >> 1)) = w; }
    else if constexpr (KIND == 2) {
        const int within = col % 192;
        if (within >= 128 && row < NLAT) rope8(v0, v1, a.rope + ((size_t)(row & (SEQ - 1)) * 32 + ((within - 128) >> 1)) * 2);
        *(u32x4*)(a.o0 + (size_t)row * 1536 + col) = pack8(v0, v1); }
    else if constexpr (KIND == 3) {
        const int h = col >> 8, w = col & 255; int b, key;
        if (row < NLAT) { b = row >> 13; key = LC + (row & (SEQ - 1)); } else { const int r2 = row - NLAT; b = r2 >> 8; key = r2 & 255; }
        const size_t base = (size_t)(b * 8 + h) * MLA_KEYS + key;
        if (w < 128) *(u32x4*)(a.o0 + base * 192 + w) = pack8(v0, v1); else *(u32x4*)(a.o1 + base * 128 + (w - 128)) = pack8(v0, v1); }
    else {
        if (col < 1152 && row < NLAT) rope8(v0, v1, a.rope + ((size_t)(row & (SEQ - 1)) * 32 + ((col & 63) >> 1)) * 2);
        *(u32x4*)(a.o0 + (size_t)row * 1280 + col) = pack8(v0, v1); }
}
struct EpiGen {
    static constexpr bool PERM = true, AFTER_DRAIN = false;
    EpiArgs a;
    template <int KIND> __device__ __forceinline__ void run(const f32x4 (&acc)[2][2][4][2], const Unit& u, int wr, int wc, int fr, int fq) const {
        const int row0 = u.pm * BM + wr * 64 + fr, col0 = u.pn * BM + wc * 32 + 8 * fq;
#pragma unroll
        for (int ai = 0; ai < 2; ++ai)
#pragma unroll
            for (int m = 0; m < 4; ++m)
#pragma unroll
                for (int bj = 0; bj < 2; ++bj) { emit8<KIND>(a, row0 + ai * HALF + m * 16, col0 + bj * HALF, acc[ai][bj][m][0], acc[ai][bj][m][1]); asm volatile("" ::: "memory"); }
    }
    __device__ __forceinline__ void operator()(const f32x4 (&acc)[2][2][4][2], const Unit& u, int wr, int wc, int fr, int fq) const {
        switch (a.kind) { case 0: run<0>(acc, u, wr, wc, fr, fq); break; case 1: run<1>(acc, u, wr, wc, fr, fq); break; case 2: run<2>(acc, u, wr, wc, fr, fq); break;
                          case 3: run<3>(acc, u, wr, wc, fr, fq); break; default: run<4>(acc, u, wr, wc, fr, fq); break; }
    }
};
template <class Epi, class Sched, bool ALIGN_EPI = false, bool SP2 = false>
__device__ __forceinline__ void gemm_phase(PG8_LAS unsigned char* lds, const Gemm g, const Sched& S, const Epi& E, const int tid) {
    const int wid = __builtin_amdgcn_readfirstlane(tid >> 6), lane = tid & 63, wr = wid >> 2, wc = wid & 3, fr = lane & 15, fq = lane >> 4;
    const int K = g.K, nt = K / BK;
    unsigned voffA[2], voffB[2];
#pragma unroll
    for (int i = 0; i < 2; ++i) { int R, C; stage_rc(tid * 16 + i * 8192, R, C); const int Rb = Epi::PERM ? ((R & ~31) + perm32(R & 31)) : R;
        voffA[i] = (unsigned)(R * K + C) * 2u; voffB[i] = (unsigned)(Rb * K + C) * 2u; }
    const size_t kstep = (size_t)(BK * 2);
    const size_t hstep = (size_t)HALF * K * 2;
    const size_t tstep = 2 * hstep;
    const unsigned ldsw = (unsigned)wid * 1024u;
    const int aoff = lds_byte(wr * 64 + fr, fq * 8), boff = lds_byte(wc * 32 + fr, fq * 8);
#define PG8_SA(b, h) (((b) * 2 + (h)) * HTB)
#define PG8_SB(b, h) ((4 + (b) * 2 + (h)) * HTB)
#define PG8_STAGE(bufoff, gbase, voff) do { _Pragma("unroll") for (int _i = 0; _i < 2; ++_i) \
        __builtin_amdgcn_global_load_lds((const unsigned*)((const char*)(gbase) + (voff)[_i]), (PG8_LAS unsigned*)(lds + (bufoff) + ldsw + _i * 8192), 16, 0, 0); } while (0)
#define PG8_LDA(dst, b, h) do { _Pragma("unroll") for (int m = 0; m < 4; ++m) _Pragma("unroll") for (int k = 0; k < 2; ++k) dst[m][k] = *(const PG8_LAS bf16x8*)(lds + PG8_SA(b, h) + aoff + m * 2048 + k * 1024); } while (0)
#define PG8_LDB(dst, b, h) do { _Pragma("unroll") for (int n = 0; n < 2; ++n) _Pragma("unroll") for (int k = 0; k < 2; ++k) dst[n][k] = *(const PG8_LAS bf16x8*)(lds + PG8_SB(b, h) + boff + n * 2048 + k * 1024); } while (0)
#define PG8_MMA(ai, bj, At, Bt) do { __builtin_amdgcn_s_setprio(1); _Pragma("unroll") for (int m = 0; m < 4; ++m) _Pragma("unroll") for (int n = 0; n < 2; ++n) _Pragma("unroll") for (int k = 0; k < 2; ++k) \
        acc[ai][bj][m][n] = __builtin_amdgcn_mfma_f32_16x16x32_bf16(Bt[n][k], At[m][k], acc[ai][bj][m][n], 0, 0, 0); __builtin_amdgcn_s_setprio(0); } while (0)
#define PG8_WAIT_V(n) asm volatile("s_waitcnt vmcnt(" #n ")" ::: "memory")
#define PG8_WAIT_L(n) asm volatile("s_waitcnt lgkmcnt(" #n ")" ::: "memory")
#define PG8_BAR __builtin_amdgcn_s_barrier()
#define PG8_SCHED __builtin_amdgcn_sched_barrier(0)
    Unit cur, nxt; int ui = 0;
    if (!S.next(0, cur)) return;
    f32x4 acc[2][2][4][2];
#pragma unroll
    for (int a = 0; a < 2; ++a)
#pragma unroll
        for (int b = 0; b < 2; ++b)
#pragma unroll
            for (int m = 0; m < 4; ++m)
#pragma unroll
                for (int n = 0; n < 2; ++n) acc[a][b][m][n] = (f32x4){0.f, 0.f, 0.f, 0.f};
    bf16x8 At[4][2], B0[2][2], B1[2][2];
    const char* cA = (const char*)g.A + (size_t)cur.pm * tstep; const char* cB = (const char*)g.Bt + (size_t)cur.pn * tstep;
    S.a_ready(cur);
    if constexpr (SP2) {
        PG8_STAGE(PG8_SB(0, 0), cB, voffB); PG8_STAGE(PG8_SB(0, 1), cB + hstep, voffB); PG8_STAGE(PG8_SA(0, 0), cA, voffA); PG8_STAGE(PG8_SA(0, 1), cA + hstep, voffA);
        if (wr == 1) PG8_BAR;
        PG8_WAIT_V(2); PG8_BAR;
        PG8_STAGE(PG8_SB(1, 0), cB + kstep, voffB); PG8_STAGE(PG8_SA(1, 0), cA + kstep, voffA); PG8_STAGE(PG8_SB(1, 1), cB + hstep + kstep, voffB);
        PG8_WAIT_V(6); PG8_BAR;
    } else {
        PG8_STAGE(PG8_SB(0, 0), cB, voffB); PG8_STAGE(PG8_SA(0, 0), cA, voffA); PG8_STAGE(PG8_SB(0, 1), cB + hstep, voffB); PG8_STAGE(PG8_SA(0, 1), cA + hstep, voffA);
        if (wr == 1) PG8_BAR;
        PG8_WAIT_V(4); PG8_BAR;
        PG8_STAGE(PG8_SB(1, 0), cB + kstep, voffB); PG8_STAGE(PG8_SA(1, 0), cA + kstep, voffA); PG8_STAGE(PG8_SB(1, 1), cB + hstep + kstep, voffB);
        PG8_WAIT_V(6); PG8_BAR;
    }
    for (;;) {
        const bool has_next = S.next(ui + 1, nxt);
        const char* nA = has_next ? (const char*)g.A + (size_t)nxt.pm * tstep : cA; const char* nB = has_next ? (const char*)g.Bt + (size_t)nxt.pn * tstep : cB;
        for (int t = 0; t < nt; t += 2) {
            const bool last = (t == nt - 2);
            const char* a1 = cA + (size_t)(t + 1) * kstep;
            const char* a2 = last ? nA : cA + (size_t)(t + 2) * kstep; const char* b2 = last ? nB : cB + (size_t)(t + 2) * kstep;
            const char* a3 = a2 + kstep; const char* b3 = b2 + kstep;
            if (last && has_next) S.a_ready(nxt);
            if constexpr (SP2) {
            PG8_LDB(B0, 0, 0); PG8_LDB(B1, 0, 1); PG8_SCHED; PG8_LDA(At, 0, 0); PG8_STAGE(PG8_SA(1, 1), a1 + hstep, voffA);
            PG8_WAIT_V(8); PG8_WAIT_L(0); PG8_BAR; PG8_MMA(0, 0, At, B0); PG8_MMA(0, 1, At, B1); PG8_BAR; PG8_SCHED;
            PG8_LDA(At, 0, 1); PG8_STAGE(PG8_SB(0, 0), b2, voffB); PG8_STAGE(PG8_SB(0, 1), b2 + hstep, voffB); PG8_STAGE(PG8_SA(0, 0), a2, voffA);
            PG8_WAIT_V(8); PG8_WAIT_L(0); PG8_BAR; PG8_MMA(1, 0, At, B0); PG8_MMA(1, 1, At, B1); PG8_BAR; PG8_SCHED;
            PG8_LDB(B0, 1, 0); PG8_LDB(B1, 1, 1); PG8_SCHED; PG8_LDA(At, 1, 0); PG8_STAGE(PG8_SA(0, 1), a2 + hstep, voffA);
            PG8_WAIT_V(8); PG8_WAIT_L(0); PG8_BAR; PG8_MMA(0, 0, At, B0); PG8_MMA(0, 1, At, B1); PG8_BAR; PG8_SCHED;
            PG8_LDA(At, 1, 1); PG8_STAGE(PG8_SB(1, 0), b3, voffB); PG8_STAGE(PG8_SB(1, 1), b3 + hstep, voffB); PG8_STAGE(PG8_SA(1, 0), a3, voffA);
            PG8_WAIT_V(8); PG8_WAIT_L(0); PG8_BAR; PG8_MMA(1, 0, At, B0); PG8_MMA(1, 1, At, B1); PG8_BAR; PG8_SCHED;
            } else {
            PG8_LDB(B0, 0, 0); PG8_SCHED; PG8_LDA(At, 0, 0); PG8_STAGE(PG8_SA(1, 1), a1 + hstep, voffA);
            PG8_WAIT_L(8); PG8_BAR; PG8_WAIT_L(0); PG8_MMA(0, 0, At, B0); PG8_BAR; PG8_SCHED;
            PG8_LDB(B1, 0, 1); PG8_STAGE(PG8_SB(0, 0), b2, voffB);
            PG8_BAR; PG8_WAIT_L(0); PG8_MMA(0, 1, At, B1); PG8_BAR;
            PG8_LDA(At, 0, 1); PG8_STAGE(PG8_SA(0, 0), a2, voffA);
            PG8_BAR; PG8_WAIT_L(0); PG8_MMA(1, 0, At, B0); PG8_BAR; PG8_SCHED;
            PG8_STAGE(PG8_SB(0, 1), b2 + hstep, voffB);
            PG8_WAIT_V(6); PG8_BAR; PG8_MMA(1, 1, At, B1); PG8_BAR;
            PG8_LDB(B0, 1, 0); PG8_SCHED; PG8_LDA(At, 1, 0); PG8_STAGE(PG8_SA(0, 1), a2 + hstep, voffA);
            PG8_WAIT_L(8); PG8_BAR; PG8_WAIT_L(0); PG8_MMA(0, 0, At, B0); PG8_BAR; PG8_SCHED;
            PG8_LDB(B1, 1, 1); PG8_STAGE(PG8_SB(1, 0), b3, voffB);
            PG8_BAR; PG8_WAIT_L(0); PG8_MMA(0, 1, At, B1); PG8_BAR;
            PG8_LDA(At, 1, 1); PG8_STAGE(PG8_SA(1, 0), a3, voffA);
            PG8_BAR; PG8_WAIT_L(0); PG8_MMA(1, 0, At, B0); PG8_BAR; PG8_SCHED;
            PG8_STAGE(PG8_SB(1, 1), b3 + hstep, voffB);
            PG8_WAIT_V(6); PG8_BAR; PG8_MMA(1, 1, At, B1); PG8_BAR;
            }
        }
        if constexpr (ALIGN_EPI) { if (wr == 0) PG8_BAR; }
        if constexpr (!Epi::AFTER_DRAIN) { E(acc, cur, wr, wc, fr, fq); S.done(cur); }
        if (!has_next) break;
#pragma unroll
        for (int a = 0; a < 2; ++a)
#pragma unroll
            for (int b = 0; b < 2; ++b)
#pragma unroll
                for (int m = 0; m < 4; ++m)
#pragma unroll
                    for (int n = 0; n < 2; ++n) acc[a][b][m][n] = (f32x4){0.f, 0.f, 0.f, 0.f};
        cur = nxt; cA = nA; cB = nB; ++ui;
        if constexpr (ALIGN_EPI) { if (wr == 1) PG8_BAR; }
    }
    PG8_WAIT_V(0);
    if constexpr (!ALIGN_EPI) { if (wr == 0) PG8_BAR; }
    PG8_BAR;
    if constexpr (Epi::AFTER_DRAIN) { E.fused(acc, cur, wr, wc, fr, fq, lds, wid, lane); S.done(cur); }
#undef PG8_SA
#undef PG8_SB
#undef PG8_STAGE
#undef PG8_LDA
#undef PG8_LDB
#undef PG8_MMA
#undef PG8_WAIT_V
#undef PG8_WAIT_L
#undef PG8_BAR
#undef PG8_SCHED
}
}
namespace att {
using bf16x8 = __attribute__((ext_vector_type(8))) short;
using s16x4  = __attribute__((ext_vector_type(4))) short;
using f32x16 = __attribute__((ext_vector_type(16))) float;
using u32x4  = __attribute__((ext_vector_type(4))) unsigned;
typedef unsigned short bf16_t;
#define SBAR() __builtin_amdgcn_sched_barrier(0)
__device__ __forceinline__ int crow(int r, int hi) { return (r & 3) + 8 * (r >> 2) + 4 * hi; }
__device__ __forceinline__ unsigned cvtpk(float lo, float hi) { unsigned r; asm volatile("v_cvt_pk_bf16_f32 %0, %1, %2" : "=v"(r) : "v"(lo), "v"(hi)); return r; }
template <int DK> __device__ __forceinline__ int kswz(int row, int colB) { return row * (DK * 2) + (colB ^ ((row & 7) << 4)); }

__device__ __forceinline__ void partialSM(f32x16& p0, f32x16& p1, float& m_reg, float& mn, float& alpha, const float C, const float THRS) {
  float pmax = p0[0];
#pragma unroll
  for (int r = 1; r < 16; ++r) pmax = fmaxf(pmax, p0[r]);
#pragma unroll
  for (int r = 0; r < 16; ++r) pmax = fmaxf(pmax, p1[r]);
  { auto rr = __builtin_amdgcn_permlane32_swap(__float_as_uint(pmax), __float_as_uint(pmax), false, false);
    pmax = fmaxf(__uint_as_float(rr[0]), __uint_as_float(rr[1])); }
  if (__builtin_expect(__all(pmax - m_reg <= THRS), 1)) { mn = m_reg; alpha = 1.f; }
  else { mn = fmaxf(m_reg, pmax); alpha = __builtin_amdgcn_exp2f((m_reg - mn) * C); m_reg = mn; }
  const float mnC = -mn * C;
#pragma unroll
  for (int r = 0; r < 16; ++r) p0[r] = fmaf(p0[r], C, mnC);
#pragma unroll
  for (int r = 0; r < 16; ++r) p1[r] = fmaf(p1[r], C, mnC);
#pragma unroll
  for (int r = 0; r < 16; ++r) p0[r] = __builtin_amdgcn_exp2f(p0[r]);
}
__device__ __forceinline__ void finishSM(f32x16& p0, f32x16& p1, float alpha, float& l_reg, bf16x8& pa0, bf16x8& pa1, bf16x8& pa2, bf16x8& pa3) {
#pragma unroll
  for (int r = 0; r < 16; ++r) p1[r] = __builtin_amdgcn_exp2f(p1[r]);
  float ps = 0;
#pragma unroll
  for (int r = 0; r < 16; ++r) ps += p0[r];
#pragma unroll
  for (int r = 0; r < 16; ++r) ps += p1[r];
  { auto rr = __builtin_amdgcn_permlane32_swap(__float_as_uint(ps), __float_as_uint(ps), false, false);
    ps = __uint_as_float(rr[0]) + __uint_as_float(rr[1]); }
  l_reg = l_reg * alpha + ps;
#define PK4(P, BASE, OUT) do { unsigned a0 = cvtpk(P[BASE + 0], P[BASE + 1]), a1 = cvtpk(P[BASE + 2], P[BASE + 3]);   \
    unsigned b0 = cvtpk(P[BASE + 4], P[BASE + 5]), b1 = cvtpk(P[BASE + 6], P[BASE + 7]);                              \
    auto r0 = __builtin_amdgcn_permlane32_swap(a0, b0, false, false); auto r1 = __builtin_amdgcn_permlane32_swap(a1, b1, false, false); \
    u32x4 w = {r0[0], r1[0], r0[1], r1[1]}; OUT = *reinterpret_cast<bf16x8*>(&w); } while (0)
  PK4(p0, 0, pa0); PK4(p0, 8, pa1); PK4(p1, 0, pa2); PK4(p1, 8, pa3);
#undef PK4
}
template <int DK> __device__ __forceinline__ void qkt(f32x16& p0, f32x16& p1, const char* Ks, const bf16x8* qr, const unsigned* kb) {
  p0 = f32x16{}; p1 = f32x16{};
#pragma unroll
  for (int d0 = 0; d0 < DK / 16; ++d0) { const char* a = Ks + kb[d0 & 3];
    const bf16x8 b0 = *reinterpret_cast<const bf16x8*>(a + (d0 >> 2) * 128);
    const bf16x8 b1 = *reinterpret_cast<const bf16x8*>(a + (d0 >> 2) * 128 + 32 * DK * 2);
    p0 = __builtin_amdgcn_mfma_f32_32x32x16_bf16(b0, qr[d0], p0, 0, 0, 0);
    p1 = __builtin_amdgcn_mfma_f32_32x32x16_bf16(b1, qr[d0], p1, 0, 0, 0); }
}
template <int DV> __device__ __forceinline__ int v_st(int k, int c) { const int kk = (k & ~0xC) | ((k & 4) << 1) | ((k & 8) >> 1); return ((kk >> 3) * (DV / 32) + (c >> 5)) * 512 + ((kk & 7) * 32 + (c & 31)) * 2; }
__device__ __forceinline__ int v_rd_base(int lane) { return ((lane & 3) << 3) | (((lane >> 2) & 3) << 6) | (((lane >> 4) & 1) << 5) | (((lane >> 5) & 1) << 8); }
template <int DV> constexpr int v_rd_off(int d0, int ks, int half) { return d0 * 512 + ks * (DV / 32) * 1024 + half * (DV / 32) * 512; }
template <int OFF> __device__ __forceinline__ s16x4 tr_read(int vb) { s16x4 r; asm volatile("ds_read_b64_tr_b16 %0, %1 offset:%2" : "=&v"(r) : "v"(vb), "i"(OFF) : "memory"); return r; }
template <int DV, int D0> __device__ __forceinline__ void pv_one(f32x16& od, int vb, bf16x8 pa0, bf16x8 pa1, bf16x8 pa2, bf16x8 pa3) {
  const s16x4 l0 = tr_read<v_rd_off<DV>(D0, 0, 0)>(vb), h0 = tr_read<v_rd_off<DV>(D0, 0, 1)>(vb), l1 = tr_read<v_rd_off<DV>(D0, 1, 0)>(vb), h1 = tr_read<v_rd_off<DV>(D0, 1, 1)>(vb);
  const s16x4 l2 = tr_read<v_rd_off<DV>(D0, 2, 0)>(vb), h2 = tr_read<v_rd_off<DV>(D0, 2, 1)>(vb), l3 = tr_read<v_rd_off<DV>(D0, 3, 0)>(vb), h3 = tr_read<v_rd_off<DV>(D0, 3, 1)>(vb);
  asm volatile("s_waitcnt lgkmcnt(0)" ::: "memory"); SBAR();
#define PK(L, H) (bf16x8){L[0], L[1], L[2], L[3], H[0], H[1], H[2], H[3]}
  od = __builtin_amdgcn_mfma_f32_32x32x16_bf16(pa0, PK(l0, h0), od, 0, 0, 0);
  od = __builtin_amdgcn_mfma_f32_32x32x16_bf16(pa1, PK(l1, h1), od, 0, 0, 0);
  od = __builtin_amdgcn_mfma_f32_32x32x16_bf16(pa2, PK(l2, h2), od, 0, 0, 0);
  od = __builtin_amdgcn_mfma_f32_32x32x16_bf16(pa3, PK(l3, h3), od, 0, 0, 0);
#undef PK
}
template <int DV> __device__ __forceinline__ void pv_all(f32x16* o, int vb, bf16x8 pa0, bf16x8 pa1, bf16x8 pa2, bf16x8 pa3) {
  pv_one<DV, 0>(o[0], vb, pa0, pa1, pa2, pa3); pv_one<DV, 1>(o[1], vb, pa0, pa1, pa2, pa3);
  if constexpr (DV == 128) { pv_one<DV, 2>(o[2], vb, pa0, pa1, pa2, pa3); pv_one<DV, 3>(o[3], vb, pa0, pa1, pa2, pa3); }
}
struct UnitP {
  const bf16_t* Q;
  const bf16_t *Kc, *Vc, *Kn, *Vn;
  bf16_t* O;
  int NT; float m0, l0; int a0, a1;
};
template <int MODE> __device__ __forceinline__ void apply_mask(f32x16& p0, f32x16& p1, int jj, const UnitP& u, int wid, int r32, int hi, const float* bias_l) {
  const float NEG = -1e30f;
  if constexpr (MODE == 2) {
    const int ks = u.a0 - 128 + 64 * jj; const bool tv = (ks >= 0 && ks < SEQ);
    const int rel0 = -128 + 64 * jj - (wid * 32 + r32);
#pragma unroll
    for (int r = 0; r < 16; ++r) { const int rel = rel0 + crow(r, hi);
      const bool ok0 = tv && rel >= -128 && rel <= 128, ok1 = tv && rel + 32 >= -128 && rel + 32 <= 128;
      p0[r] = ok0 ? p0[r] : NEG; p1[r] = ok1 ? p1[r] : NEG; }
  } else if constexpr (MODE == 1) {
    const int r = u.a0 + (wid >> 1), c = (wid & 1) * 32 + r32, kr = u.a1 + jj;
    const int rs = min(max(r - 4, 0), 120), cs = min(max(c - 8, 0), 48); const bool rok = (kr >= rs && kr < rs + 8);
    const int ib = (kr - r + 7) * 31 - c + 15;
#pragma unroll
    for (int q = 0; q < 16; ++q) { const int k0 = crow(q, hi), k1 = k0 + 32;
      const bool ok0 = rok && k0 >= cs && k0 < cs + 16, ok1 = rok && k1 >= cs && k1 < cs + 16;
      const float b0 = bias_l[ok0 ? ib + k0 : 0], b1 = bias_l[ok1 ? ib + k1 : 0];
      p0[q] = ok0 ? p0[q] + b0 : NEG; p1[q] = ok1 ? p1[q] + b1 : NEG; }
  }
}
template <int DK, int DV, int LDQ, int LDK, int LDV, int MODE, int SDEPTH, bool SERIAL>
__device__ __forceinline__ void attn_unit(const UnitP& u, char* lds, const float* bias_l, const int tid) {
  constexpr float SCALE = (DK == 192) ? 0.07216878364870322f : 0.125f;
  constexpr float C = SCALE * 1.4426950408889634f, THRS = 8.f / SCALE;
  constexpr int SHM_V = 64 * DV * 2, SHM_K = 64 * DK * 2, KC = DK / 64, VC = DV / 64, ND = DK / 16, NO = DV / 32;
  const int wid = tid >> 6, lane = tid & 63, r32 = lane & 31, hi = lane >> 5;
  char* V_lds = lds; char* K_lds = lds + 2 * SHM_V;
  float* ws = (float*)(lds + 2 * SHM_V + 2 * SHM_K) + wid * 64; float* li_l = ws; float* al_l = ws + 32;
  float m_reg = u.m0, l_reg = u.l0; f32x16 o[NO]; bf16x8 qr[ND];
#pragma unroll
  for (int d = 0; d < NO; ++d) o[d] = f32x16{};
  const bf16_t* Qw = u.Q + (long)(wid * 32 + r32) * LDQ + hi * 8;
#pragma unroll
  for (int d0 = 0; d0 < ND; ++d0) qr[d0] = *reinterpret_cast<const bf16x8*>(Qw + d0 * 16);
  unsigned kofs[KC], kdst[KC], vofs[VC], vdst[VC];
#pragma unroll
  for (int c = 0; c < KC; ++c) { const int id = tid + 512 * c, row = id / (DK / 8), ch = id % (DK / 8); kofs[c] = row * LDK + ch * 8; kdst[c] = kswz<DK>(row, ch * 16); }
#pragma unroll
  for (int c = 0; c < VC; ++c) { const int id = tid + 512 * c, row = id / (DV / 8), ch = id % (DV / 8); vofs[c] = row * LDV + ch * 8; vdst[c] = v_st<DV>(row, ch * 8); }
  const int vb0 = (int)(uintptr_t)V_lds + v_rd_base(lane);
  unsigned kb[4];
#pragma unroll
  for (int e = 0; e < 4; ++e) kb[e] = (unsigned)(r32 * (DK * 2) + ((e * 32 + hi * 16) ^ ((r32 & 7) << 4)));
  struct { bf16x8 k[KC]; bf16x8 v[VC]; } sr_[SDEPTH];
#define TILE_PTRS(j, Kt, Vt) do { if ((j) < 4) { Kt = u.Kc + (long)(j) * 64 * LDK; Vt = u.Vc + (long)(j) * 64 * LDV; } \
    else if (MODE == 2) { int ks_ = u.a0 - 128 + 64 * ((j) - 4); if (ks_ < 0 || ks_ >= SEQ) ks_ = 0; Kt = u.Kn + (long)ks_ * LDK; Vt = u.Vn + (long)ks_ * LDV; } \
    else { Kt = u.Kn + (long)((j) - 4) * 64 * LDK; Vt = u.Vn + (long)((j) - 4) * 64 * LDV; } } while (0)
#define SLOAD(i, j) do { const bf16_t *Kt_, *Vt_; TILE_PTRS(j, Kt_, Vt_); \
    _Pragma("unroll") for (int c = 0; c < VC; ++c) sr_[i].v[c] = *reinterpret_cast<const bf16x8*>(Vt_ + vofs[c]); \
    _Pragma("unroll") for (int c = 0; c < KC; ++c) sr_[i].k[c] = *reinterpret_cast<const bf16x8*>(Kt_ + kofs[c]); } while (0)
#define SWRITE(b, i) do { _Pragma("unroll") for (int c = 0; c < VC; ++c) *(bf16x8*)(V_lds + (b) * SHM_V + vdst[c]) = sr_[i].v[c]; \
    _Pragma("unroll") for (int c = 0; c < KC; ++c) *(bf16x8*)(K_lds + (b) * SHM_K + kdst[c]) = sr_[i].k[c]; } while (0)
#define SWAIT() do { if constexpr (SDEPTH == 2) asm volatile("s_waitcnt vmcnt(%0)" :: "n"(KC + VC) : "memory"); else asm volatile("s_waitcnt vmcnt(0)" ::: "memory"); } while (0)
#define RESC(a) do { if (__any((a) < 1.f)) { if (hi == 0) al_l[r32] = (a); asm volatile("s_waitcnt lgkmcnt(0)" ::: "memory"); \
    _Pragma("unroll") for (int d = 0; d < NO; ++d) _Pragma("unroll") for (int r = 0; r < 16; ++r) o[d][r] *= al_l[crow(r, hi)]; } } while (0)
#define MASK(P0, P1, j) do { if (MODE != 0 && (j) >= 4) apply_mask<MODE>(P0, P1, (j) - 4, u, wid, r32, hi, bias_l); } while (0)
  bf16x8 pa0, pa1, pa2, pa3; const int NT = u.NT;
  if constexpr (SERIAL) {
    f32x16 p0, p1; float mn, al;
    SLOAD(0, 0); asm volatile("s_waitcnt vmcnt(0)" ::: "memory"); SWRITE(0, 0); __syncthreads();
    for (int j = 0; j < NT; ++j) {
      const int b = j & 1;
      if (j + 1 < NT) SLOAD(0, j + 1);
      SBAR(); qkt<DK>(p0, p1, K_lds + b * SHM_K, qr, kb); MASK(p0, p1, j);
      partialSM(p0, p1, m_reg, mn, al, C, THRS); RESC(al);
      finishSM(p0, p1, al, l_reg, pa0, pa1, pa2, pa3); SBAR();
      pv_all<DV>(o, vb0 + b * SHM_V, pa0, pa1, pa2, pa3); SBAR();
      if (j + 1 < NT) SWRITE(b ^ 1, 0);
      __syncthreads();
    }
  } else {
  f32x16 pA0, pA1, pB0, pB1; float mnA, mnB, alA, alB;
  constexpr int SE = 0, SO = SDEPTH - 1;
  SLOAD(SE, 0); asm volatile("s_waitcnt vmcnt(0)" ::: "memory"); SWRITE(0, SE); __syncthreads();
  qkt<DK>(pA0, pA1, K_lds, qr, kb); partialSM(pA0, pA1, m_reg, mnA, alA, C, THRS);
  SLOAD(SO, 1); if constexpr (SDEPTH == 2) { if (2 < NT) SLOAD(SE, 2); }
  SWAIT(); SWRITE(1, SO); __syncthreads();
  for (int j = 1; j + 1 < NT; j += 2) {
    SBAR(); qkt<DK>(pB0, pB1, K_lds + SHM_K, qr, kb); finishSM(pA0, pA1, alA, l_reg, pa0, pa1, pa2, pa3); SBAR();
    SLOAD(SO, j + SDEPTH); SBAR();
    pv_all<DV>(o, vb0, pa0, pa1, pa2, pa3); MASK(pB0, pB1, j); partialSM(pB0, pB1, m_reg, mnB, alB, C, THRS);
    __syncthreads(); SWAIT(); SWRITE(0, SE);
    RESC(alB); __syncthreads();
    SBAR(); qkt<DK>(pA0, pA1, K_lds, qr, kb); finishSM(pB0, pB1, alB, l_reg, pa0, pa1, pa2, pa3); SBAR();
    if (SDEPTH == 1 || j + 3 < NT) SLOAD(SE, j + 1 + SDEPTH); SBAR();
    pv_all<DV>(o, vb0 + SHM_V, pa0, pa1, pa2, pa3); MASK(pA0, pA1, j + 1); partialSM(pA0, pA1, m_reg, mnA, alA, C, THRS);
    __syncthreads(); SWAIT(); SWRITE(1, SO);
    RESC(alA); __syncthreads();
  }
  SBAR(); qkt<DK>(pB0, pB1, K_lds + SHM_K, qr, kb); finishSM(pA0, pA1, alA, l_reg, pa0, pa1, pa2, pa3); SBAR();
  pv_all<DV>(o, vb0, pa0, pa1, pa2, pa3); MASK(pB0, pB1, NT - 1); partialSM(pB0, pB1, m_reg, mnB, alB, C, THRS);
  __syncthreads(); RESC(alB);
  finishSM(pB0, pB1, alB, l_reg, pa0, pa1, pa2, pa3); SBAR();
  pv_all<DV>(o, vb0 + SHM_V, pa0, pa1, pa2, pa3);
  }
  { int t2 = tid; asm volatile("" : "+v"(t2)); const int wid2 = t2 >> 6, lane2 = t2 & 63, r32b = lane2 & 31, hib = lane2 >> 5;
    float* li2 = (float*)(lds + 2 * SHM_V + 2 * SHM_K) + wid2 * 64;
    if (hib == 0) li2[r32b] = l_reg; asm volatile("s_waitcnt lgkmcnt(0)" ::: "memory");
    __syncthreads();
    bf16_t* stg = (bf16_t*)lds + wid2 * 32 * DV;
#pragma unroll
    for (int r = 0; r < 16; ++r) { const int orow = crow(r, hib); const float rl = __builtin_amdgcn_rcpf(li2[orow]);
#pragma unroll
      for (int d0 = 0; d0 < NO; ++d0) { const unsigned w = cvtpk(o[d0][r] * rl, 0.f); stg[orow * DV + d0 * 32 + r32b] = (bf16_t)(w & 0xffffu); } }
    asm volatile("s_waitcnt lgkmcnt(0)" ::: "memory");
    bf16_t* Ow = u.O + (long)(wid2 * 32) * DM;
#pragma unroll
    for (int i = 0; i < (32 * DV / 8) / 64; ++i) { const int id = i * 64 + lane2, row = id / (DV / 8), ch = id % (DV / 8);
      const u32x4 v = *(const u32x4*)(stg + row * DV + ch * 8); *(u32x4*)(Ow + (long)row * DM + ch * 8) = v; } }
  __syncthreads();
#undef TILE_PTRS
#undef SLOAD
#undef SWRITE
#undef SWAIT
#undef RESC
#undef MASK
}
#undef SBAR
}
typedef unsigned short bf16_t;
typedef float f32x4 __attribute__((ext_vector_type(4)));
typedef unsigned u32x4 __attribute__((ext_vector_type(4)));
typedef unsigned u32x2 __attribute__((ext_vector_type(2)));
#define LAS __attribute__((address_space(3)))
constexpr size_t MiB = 1u << 20;
constexpr size_t WS_MOD = 0, WS_ROPE = 1 * MiB, WS_XCTX = 3 * MiB;
constexpr size_t WS_WFI = 8 * MiB, WS_WFO = 52 * MiB, WS_WMLA = 74 * MiB, WS_WNA = 85 * MiB, WS_WSWA = 93 * MiB;
constexpr size_t MLA_W_STRIDE = (size_t)(768 * 1024 + 1536 * 256 + 2048 * 256 + 1024 * 1024) * 2;
constexpr size_t MLA_OFF_UQ = (size_t)768 * 1024 * 2, MLA_OFF_UKV = MLA_OFF_UQ + (size_t)1536 * 256 * 2, MLA_OFF_WO = MLA_OFF_UKV + (size_t)2048 * 256 * 2;
constexpr size_t WS_XN = 98 * MiB, WS_S = 164 * MiB, WS_Q = 197 * MiB, WS_K = 296 * MiB, WS_V = 395 * MiB, WS_END = 461 * MiB;
static_assert(WS_WMLA + 2 * MLA_W_STRIDE <= WS_WNA && WS_XN + (size_t)TOK * DM * 2 <= WS_S && WS_S + (size_t)TOK * 512 * 2 <= WS_Q, "ws map");
static_assert(WS_Q + (size_t)TOK * 1536 * 2 <= WS_K && WS_K + (size_t)TOK * 8 * 192 * 2 <= WS_V && WS_V + (size_t)TOK * DM * 2 <= WS_END, "ws map 2");
static_assert(WS_Q + (size_t)TOK * 3072 * 2 <= WS_V && WS_Q + (size_t)TOK * DFF * 2 <= WS_V, "overlays");
constexpr int LDS_BYTES = 147456, NWAVES = 8, NTHREADS = 512;
constexpr float NORM_EPS = 1e-6f;

struct WDesc { const float* src; bf16_t* dst; int K, N, Np, kind, first, pad; };
constexpr int NWD = 20;
struct Params {
  const float* in[24]; float* out; unsigned char* ws;
  int nph, lo, hi, nitems;
  unsigned char prog[64];
  WDesc wd[NWD];
};

__device__ __forceinline__ unsigned f2bf(float f) { unsigned u = __builtin_bit_cast(unsigned, f); return (u + 0x7fffu + ((u >> 16) & 1u)) >> 16; }
__device__ __forceinline__ unsigned pk2(float lo, float hi) { return f2bf(lo) | (f2bf(hi) << 16); }
__device__ __forceinline__ float bf2f(unsigned short b) { return __builtin_bit_cast(float, (unsigned)b << 16); }
__device__ __forceinline__ float wave_sum(float v, int lane) {
#pragma unroll
  for (int o = 1; o < 64; o <<= 1) v += __builtin_bit_cast(float, __builtin_amdgcn_ds_bpermute((lane ^ o) << 2, __builtin_bit_cast(int, v)));
  return v;
}
__device__ __forceinline__ int srccol(int kind, int np) {
  switch (kind) {
    case 1: { const int grp = np >> 3, w = np & 7; return (w < 4) ? grp * 4 + w : DFF + grp * 4 + (w - 4); }
    case 2: { if (np < 512) return np; if (np < 576) { const int q = np - 512; return 512 + (q >> 1) + 32 * (q & 1); } return -1; }
    case 3: { const int h = np / 192, w = np % 192; if (w < 128) return np; const int q = w - 128; return h * 192 + 128 + (q >> 1) + 32 * (q & 1); }
    case 4: { if (np >= 1152) return np; const int hh = np >> 6, q = np & 63; return hh * 64 + (q >> 1) + 32 * (q & 1); }
    default: return np;
  }
}
__device__ __forceinline__ void transpose_item(const WDesc& d, LAS float* scr, int item, int lane) {
  const int nblk = d.Np / 32, kb = item / nblk, nb = item % nblk, k0 = 64 * kb, n0 = 32 * nb;
  const int sc = srccol(d.kind, n0 + (lane & 31));
#pragma unroll 8
  for (int i = 0; i < 32; ++i) { const int kk = 2 * i + (lane >> 5); scr[kk * 33 + (lane & 31)] = (sc >= 0) ? d.src[(size_t)(k0 + kk) * d.N + sc] : 0.f; }
  asm volatile("s_waitcnt lgkmcnt(0)" ::: "memory");
  const int c = lane & 7;
#pragma unroll
  for (int j = 0; j < 4; ++j) { const int n = (lane >> 3) + 8 * j; const LAS float* s = scr + (8 * c) * 33 + n;
    u32x4 o; o.x = pk2(s[0 * 33], s[1 * 33]); o.y = pk2(s[2 * 33], s[3 * 33]); o.z = pk2(s[4 * 33], s[5 * 33]); o.w = pk2(s[6 * 33], s[7 * 33]);
    *(u32x4*)(d.dst + (size_t)(n0 + n) * d.K + k0 + 8 * c) = o; }
  asm volatile("s_waitcnt lgkmcnt(0)" ::: "memory");
}
__device__ __forceinline__ float* xrow(const Params& P, int row) { return row < NLAT ? P.out + (size_t)row * DM : (float*)(P.ws + WS_XCTX) + (size_t)(row - NLAT) * DM; }
__device__ __forceinline__ const float* modvec(const Params& P, int layer, int row, int which) {
  const int r = row < NLAT ? (row >> 13) : 4; return (const float*)(P.ws + WS_MOD) + ((size_t)(layer * 5 + r) * 6 + which) * DM;
}
template <bool INIT> __device__ __forceinline__ void row_pass(const Params& P, int row, int lane, const bf16_t* src, const float* g_post, const float* gate,
                                                             bool do_norm, const float* g_pre, const float* shift, const float* scale) {
  f32x4 v[4];
  float* xr = xrow(P, row);
  if constexpr (INIT) { const float* s = row < NLAT ? P.in[0] + (size_t)row * DM : P.in[2] + (size_t)(row - NLAT) * DM;
#pragma unroll
    for (int j = 0; j < 4; ++j) { v[j] = *(const f32x4*)(s + 4 * lane + 256 * j); *(f32x4*)(xr + 4 * lane + 256 * j) = v[j]; }
  } else {
    f32x4 a[4]; float ss = 0.f;
#pragma unroll
    for (int j = 0; j < 4; ++j) { const u32x2 w = *(const u32x2*)(src + (size_t)row * DM + 4 * lane + 256 * j);
      a[j][0] = __builtin_bit_cast(float, w.x << 16); a[j][1] = __builtin_bit_cast(float, w.x & 0xffff0000u); a[j][2] = __builtin_bit_cast(float, w.y << 16); a[j][3] = __builtin_bit_cast(float, w.y & 0xffff0000u);
      ss += (a[j][0] * a[j][0] + a[j][1] * a[j][1]) + (a[j][2] * a[j][2] + a[j][3] * a[j][3]); }
    const float rstd = 1.0f / sqrtf(wave_sum(ss, lane) * (1.0f / DM) + NORM_EPS);
#pragma unroll
    for (int j = 0; j < 4; ++j) { const int c = 4 * lane + 256 * j; const f32x4 x = *(const f32x4*)(xr + c), g = *(const f32x4*)(g_post + c), gt = *(const f32x4*)(gate + c);
      v[j] = x + gt * (a[j] * rstd * g); *(f32x4*)(xr + c) = v[j]; }
  }
  if (do_norm) {
    float ss = 0.f;
#pragma unroll
    for (int j = 0; j < 4; ++j) ss += (v[j][0] * v[j][0] + v[j][1] * v[j][1]) + (v[j][2] * v[j][2] + v[j][3] * v[j][3]);
    const float rstd = 1.0f / sqrtf(wave_sum(ss, lane) * (1.0f / DM) + NORM_EPS);
    bf16_t* xn = (bf16_t*)(P.ws + WS_XN) + (size_t)row * DM;
#pragma unroll
    for (int j = 0; j < 4; ++j) { const int c = 4 * lane + 256 * j; const f32x4 g = *(const f32x4*)(g_pre + c), sh = *(const f32x4*)(shift + c), sc = *(const f32x4*)(scale + c);
      const f32x4 h = (v[j] * rstd * g) * (1.0f + sc) + sh; u32x2 w; w.x = pk2(h[0], h[1]); w.y = pk2(h[2], h[3]); *(u32x2*)(xn + c) = w; }
  }
}

typedef const __attribute__((address_space(4))) Params* KargPtr;
__global__ void __launch_bounds__(NTHREADS, 2) fwd_mega(Params Pbyval) {
  extern __shared__ __attribute__((aligned(16))) unsigned char lds[];
  cg::grid_group grid = cg::this_grid();
  const int G0 = gridDim.x, bx0 = blockIdx.x;
  const int ph_lo = Pbyval.lo, ph_hi = Pbyval.hi;

  for (int ph = ph_lo; ph < ph_hi; ++ph) {
    int tid = threadIdx.x; asm volatile("" : "+v"(tid));
    int G = G0, bx = bx0; asm volatile("" : "+s"(G), "+s"(bx));
    KargPtr Pq = (KargPtr)__builtin_amdgcn_kernarg_segment_ptr(); asm volatile("" : "+s"(Pq));
    const Params& P = *(const Params*)Pq;
    const int vcu = (G % 8 == 0) ? (bx % 8) * (G / 8) + bx / 8 : bx;
    const int NGW = G * NWAVES;
    const int lane = tid & 63, wave = __builtin_amdgcn_readfirstlane(tid >> 6), gw = vcu * NWAVES + wave;
    unsigned char* ws = P.ws;
    const float* rope = (const float*)(ws + WS_ROPE);
    bf16_t* XN = (bf16_t*)(ws + WS_XN); bf16_t* SB = (bf16_t*)(ws + WS_S); bf16_t* QB = (bf16_t*)(ws + WS_Q); bf16_t* KB = (bf16_t*)(ws + WS_K); bf16_t* VB = (bf16_t*)(ws + WS_V);
    const int code = P.prog[ph], l = code >> 4, step = code & 15, kind = l % 3, jl = l / 3; const bool last = (l == DEPTH - 1);
    if (step == 0) {
      { LAS float* sc_l = (LAS float*)lds;
        LAS float* red = sc_l + 5 * DM;
        for (int i = tid; i < 5 * DM; i += NTHREADS) { const int r = i >> 10, k = i & 1023; const float c = (r < 4) ? P.in[1][r * DM + k] : P.in[3][k]; sc_l[i] = c / (1.0f + __expf(-c)); }
        __syncthreads();
        for (int task = bx; task < DEPTH * 96; task += G) { const int ly = task / 96, n0 = (task % 96) * 64;
          const float* W = P.in[4] + (size_t)ly * DM * 6 * DM + n0 + lane; float acc[5] = {0.f, 0.f, 0.f, 0.f, 0.f};
#pragma unroll 8
          for (int k = wave * 128; k < wave * 128 + 128; ++k) { const float w = W[(size_t)k * 6 * DM];
#pragma unroll
            for (int r = 0; r < 5; ++r) acc[r] += sc_l[r * DM + k] * w; }
#pragma unroll
          for (int r = 0; r < 5; ++r) red[(wave * 5 + r) * 64 + lane] = acc[r];
          __syncthreads();
          if (tid < 320) { const int r = tid >> 6, n = tid & 63; float s = P.in[5][(size_t)ly * 6 * DM + n0 + n];
#pragma unroll
            for (int w = 0; w < 8; ++w) s += red[(w * 5 + r) * 64 + n];
            const int col = n0 + n; ((float*)(ws + WS_MOD))[((size_t)(ly * 5 + r) * 6 + (col >> 10)) * DM + (col & 1023)] = s; }
          __syncthreads(); }
      }
      { LAS float* scr = (LAS float*)lds + wave * (64 * 33);
        for (int it = gw; it < P.nitems; it += NGW) { int m = 0;
#pragma unroll 1
          for (int q = 1; q < NWD; ++q) if (it >= P.wd[q].first) m = q;
          transpose_item(P.wd[m], scr, it - P.wd[m].first, lane); } }
      for (int i = bx * NTHREADS + tid; i < SEQ * 32; i += G * NTHREADS) { const int t = i >> 5, p = i & 31; const float inv = powf(10000.0f, -(float)(p & 15) / 16.0f);
        const float ang = (float)((p < 16) ? (t >> 6) : (t & 63)) * inv; ((float*)(ws + WS_ROPE))[2 * i] = cosf(ang); ((float*)(ws + WS_ROPE))[2 * i + 1] = sinf(ang); }
    } else if (step == 1) {
      for (int row = gw; row < TOK; row += NGW)
        row_pass<true>(P, row, lane, nullptr, nullptr, nullptr, true, P.in[6], modvec(P, 0, row, 0), modvec(P, 0, row, 1));
    } else if (step == 2 || step == 4 || step == 6 || step == 8 || step == 9) {
      const int ng = (step == 4) ? 2 : 1;
      for (int gi = 0; gi < ng; ++gi) {
        pg8::Gemm g; pg8::EpiArgs ea; ea.rope = rope; ea.o1 = nullptr; ea.ldc = DM; ea.kind = 0; ea.o0 = nullptr;
        const unsigned char* wm = ws + WS_WMLA + (size_t)jl * MLA_W_STRIDE;
        g.M = (last && step >= 6) ? NLAT : TOK;
        if (step == 2) { g.A = XN; g.K = DM;
          if (kind == 0) { g.Bt = (const bf16_t*)wm; g.N = 768; ea.kind = 0; ea.o0 = VB; ea.ldc = 768; }
          else if (kind == 1) { g.Bt = (const bf16_t*)(ws + WS_WNA); g.N = 3072; ea.kind = 0; ea.o0 = QB; ea.ldc = 3072; }
          else { g.Bt = (const bf16_t*)(ws + WS_WSWA); g.N = 1280; ea.kind = 4; ea.o0 = QB; }
        } else if (step == 4) { g.K = 256;
          if (gi == 0) { g.A = SB; g.Bt = (const bf16_t*)(wm + MLA_OFF_UQ); g.N = 1536; ea.kind = 2; ea.o0 = QB; }
          else { g.A = SB + (size_t)TOK * 256; g.Bt = (const bf16_t*)(wm + MLA_OFF_UKV); g.N = 2048; ea.kind = 3; ea.o0 = KB; ea.o1 = VB; }
        } else if (step == 6) { g.A = XN; g.K = DM; g.N = DM; ea.kind = 0; ea.o0 = VB; ea.ldc = DM;
          g.Bt = (kind == 0) ? (const bf16_t*)(wm + MLA_OFF_WO) : (kind == 1) ? (const bf16_t*)(ws + WS_WNA + (size_t)3072 * 1024 * 2) : (const bf16_t*)(ws + WS_WSWA + (size_t)1280 * 1024 * 2);
        } else if (step == 8) { g.A = XN; g.K = DM; g.N = 2 * DFF; g.Bt = (const bf16_t*)(ws + WS_WFI) + (size_t)l * 2 * DFF * DM; ea.kind = 1; ea.o0 = QB; }
        else { g.A = QB; g.K = DFF; g.N = DM; g.Bt = (const bf16_t*)(ws + WS_WFO) + (size_t)l * DM * DFF; ea.kind = 0; ea.o0 = VB; ea.ldc = DM; }
        pg8::StaticOrder S; S.init(g.M, g.N, G, bx); pg8::EpiGen E{ea};
#ifndef DBG_NO_GEMM
        pg8::gemm_phase<pg8::EpiGen, pg8::StaticOrder, true, true>((LAS unsigned char*)lds, g, S, E, tid);
#endif
        __syncthreads();
      }
    } else if (step == 3) {
      const bf16_t* A1 = VB; const float* gq = P.in[13] + jl * 256; const float* gkv = P.in[15] + jl * 256;
      for (int row = gw; row < TOK; row += NGW) {
        const bf16_t* a = A1 + (size_t)row * 768;
#pragma unroll
        for (int part = 0; part < 2; ++part) { const u32x2 w = *(const u32x2*)(a + part * 256 + 4 * lane);
          float x[4] = {__builtin_bit_cast(float, w.x << 16), __builtin_bit_cast(float, w.x & 0xffff0000u), __builtin_bit_cast(float, w.y << 16), __builtin_bit_cast(float, w.y & 0xffff0000u)};
          const float ss = wave_sum((x[0] * x[0] + x[1] * x[1]) + (x[2] * x[2] + x[3] * x[3]), lane); const float rstd = 1.0f / sqrtf(ss * (1.0f / 256.0f) + NORM_EPS);
          const f32x4 g = *(const f32x4*)((part ? gkv : gq) + 4 * lane); u32x2 o; o.x = pk2(x[0] * rstd * g[0], x[1] * rstd * g[1]); o.y = pk2(x[2] * rstd * g[2], x[3] * rstd * g[3]);
          *(u32x2*)(SB + (size_t)part * TOK * 256 + (size_t)row * 256 + 4 * lane) = o; }
        if (lane < 32) { const unsigned w = *(const unsigned*)(a + 512 + 2 * lane); float x1 = __builtin_bit_cast(float, w << 16), x2 = __builtin_bit_cast(float, w & 0xffff0000u);
          int b, key;
          if (row < NLAT) { const int t = row & (SEQ - 1); const float c = rope[(t * 32 + lane) * 2], s = rope[(t * 32 + lane) * 2 + 1]; const float y1 = x1 * c - x2 * s, y2 = x2 * c + x1 * s; x1 = y1; x2 = y2; b = row >> 13; key = LC + t; }
          else { const int r2 = row - NLAT; b = r2 >> 8; key = r2 & 255; }
          const unsigned o = pk2(x1, x2);
#pragma unroll
          for (int h = 0; h < 8; ++h) *(unsigned*)(KB + ((size_t)(b * 8 + h) * MLA_KEYS + key) * 192 + 128 + 2 * lane) = o; }
      }
    } else if (step == 5) {
      float* bias_l = (float*)(lds + 135168);
      if (kind == 0) {
        const int nun = last ? 1024 : 1056;
        for (int id = vcu; id < nun; id += G) { att::UnitP u; u.m0 = -1e30f; u.l0 = 0.f; u.a0 = 0; u.a1 = 0;
          int bh, row0; if (id < 1024) { bh = id >> 5; row0 = (bh >> 3) * SEQ + (id & 31) * 256; u.NT = 4 + SEQ / 64; } else { bh = id - 1024; row0 = NLAT + (bh >> 3) * LC; u.NT = 4; }
          const int h = bh & 7; const bf16_t* Kbh = KB + (size_t)bh * MLA_KEYS * 192; const bf16_t* Vbh = VB + (size_t)bh * MLA_KEYS * 128;
          u.Q = QB + (size_t)row0 * 1536 + h * 192; u.Kc = Kbh; u.Vc = Vbh; u.Kn = Kbh + (size_t)LC * 192; u.Vn = Vbh + (size_t)LC * 128; u.O = XN + (size_t)row0 * DM + h * 128;
#ifndef DBG_NO_ATT0
          att::attn_unit<192, 128, 1536, 192, 128, 0, MLA_SDEPTH, true>(u, (char*)lds, bias_l, tid);
#endif
        }
      } else if (kind == 1) {
        const float* rpb = P.in[19] + (size_t)jl * 16 * 465;
        const int nun = last ? 2048 : 2112;
        for (int id = vcu; id < nun; id += G) { att::UnitP u; u.m0 = -1e30f; u.l0 = 0.f;
          int bh, row0, qb = 0; if (id < 2048) { bh = id >> 5; qb = id & 31; row0 = (bh >> 4) * SEQ + qb * 256; u.NT = 16; } else { bh = id - 2048; row0 = NLAT + (bh >> 4) * LC; u.NT = 4; }
          const int b = bh >> 4, h = bh & 15; const int R0 = qb * 4, KR0 = min(max(R0 - 4, 0), 116); u.a0 = R0; u.a1 = KR0;
          u.Q = QB + (size_t)row0 * 3072 + h * 64; u.Kc = QB + (size_t)(NLAT + b * LC) * 3072 + 1024 + h * 64; u.Vc = u.Kc + 1024;
          u.Kn = QB + (size_t)(b * SEQ + KR0 * 64) * 3072 + 1024 + h * 64; u.Vn = u.Kn + 1024; u.O = XN + (size_t)row0 * DM + h * 64;
          for (int i = tid; i < 465; i += NTHREADS) bias_l[i] = rpb[h * 465 + i] * 8.0f;
          __syncthreads();
#ifndef DBG_NO_ATT1
          att::attn_unit<64, 64, 3072, 3072, 3072, 1, 2, false>(u, (char*)lds, bias_l, tid);
#endif
        }
      } else {
        const float* sink = P.in[22] + (size_t)jl * 16;
        const int nun = last ? 2048 : 2112;
        for (int id = vcu; id < nun; id += G) { att::UnitP u; u.a1 = 0;
          int bh, row0, qb = 0; if (id < 2048) { bh = id >> 5; qb = id & 31; row0 = (bh >> 4) * SEQ + qb * 256; u.NT = 12; } else { bh = id - 2048; row0 = NLAT + (bh >> 4) * LC; u.NT = 4; }
          const int b = bh >> 4, h = bh & 15, kvh = h >> 3; u.a0 = qb * 256; u.m0 = sink[h] * 8.0f; u.l0 = 1.0f;
          u.Q = QB + (size_t)row0 * 1280 + h * 64; u.Kc = QB + (size_t)(NLAT + b * LC) * 1280 + 1024 + kvh * 64; u.Vc = u.Kc + 128;
          u.Kn = QB + (size_t)(b * SEQ) * 1280 + 1024 + kvh * 64; u.Vn = u.Kn + 128; u.O = XN + (size_t)row0 * DM + h * 64;
#ifndef DBG_NO_ATT2
          att::attn_unit<64, 64, 1280, 1280, 1280, 2, 2, false>(u, (char*)lds, bias_l, tid);
#endif
        }
      }
    } else if (step == 7) {
      const int nrows = last ? NLAT : TOK;
      for (int row = gw; row < nrows; row += NGW)
        row_pass<false>(P, row, lane, VB, P.in[7] + l * DM, modvec(P, l, row, 2), true, P.in[8] + l * DM, modvec(P, l, row, 3), modvec(P, l, row, 4));
    } else if (step == 10) {
      const int nrows = last ? NLAT : TOK; const int ln = last ? l : l + 1;
      for (int row = gw; row < nrows; row += NGW)
        row_pass<false>(P, row, lane, VB, P.in[9] + l * DM, modvec(P, l, row, 5), !last, P.in[6] + ln * DM, modvec(P, ln, row, 0), modvec(P, ln, row, 1));
    }
    if (ph + 1 < ph_hi) grid.sync();
  }
}

#ifndef N_LAUNCH_SPLIT
#define N_LAUNCH_SPLIT 0
#endif
extern "C" void kernel_launch(void* const* d_in, const int* in_sizes, int n_in, void* d_out, int out_size, void* d_ws, size_t ws_size, hipStream_t stream) {
  static int grid = 0;
  if (grid == 0) {
    if (n_in != 24 || out_size != NLAT * DM || ws_size < WS_END) { fprintf(stderr, "kernel_launch: unexpected shapes n_in %d out %d ws %zu (need %zu)\n", n_in, out_size, ws_size, (size_t)WS_END); grid = -1; return; }
    int dev = 0, cus = 0, per_cu = 0;
    hipGetDevice(&dev); hipDeviceGetAttribute(&cus, hipDeviceAttributeMultiprocessorCount, dev);
    if (hipFuncSetAttribute((const void*)fwd_mega, hipFuncAttributeMaxDynamicSharedMemorySize, LDS_BYTES) != hipSuccess) { fprintf(stderr, "kernel_launch: hipFuncSetAttribute failed\n"); grid = -1; return; }
    if (hipOccupancyMaxActiveBlocksPerMultiprocessor(&per_cu, (const void*)fwd_mega, NTHREADS, LDS_BYTES) != hipSuccess || per_cu < 1) { fprintf(stderr, "kernel_launch: occupancy query says %d\n", per_cu); per_cu = 1; }
    (void)hipGetLastError();
    grid = cus * 1;
    fprintf(stderr, "kernel_launch: grid %d (cus %d, per_cu %d)\n", grid, cus, per_cu);
  }
  if (grid < 0) return;
  Params p{};
  for (int i = 0; i < 24; ++i) p.in[i] = (const float*)d_in[i];
  p.out = (float*)d_out; p.ws = (unsigned char*)d_ws;
  int n = 0; p.prog[n++] = 0; p.prog[n++] = 1;
  for (int l = 0; l < DEPTH; ++l) { const int kind = l % 3; const int steps_mla[9] = {2, 3, 4, 5, 6, 7, 8, 9, 10}, steps_o[7] = {2, 5, 6, 7, 8, 9, 10};
    if (kind == 0) for (int s = 0; s < 9; ++s) p.prog[n++] = (unsigned char)((l << 4) | steps_mla[s]); else for (int s = 0; s < 7; ++s) p.prog[n++] = (unsigned char)((l << 4) | steps_o[s]); }
  p.nph = n;
  unsigned char* ws = (unsigned char*)d_ws; int q = 0, first = 0;
  auto add = [&](const float* src, size_t dst_off, int K, int N, int Np, int kind) { WDesc& d = p.wd[q++]; d.src = src; d.dst = (bf16_t*)(ws + dst_off); d.K = K; d.N = N; d.Np = Np; d.kind = kind; d.first = first; d.pad = 0; first += (K / 64) * (Np / 32); };
  for (int l = 0; l < DEPTH; ++l) add(p.in[10] + (size_t)l * DM * 2 * DFF, WS_WFI + (size_t)l * 2 * DFF * DM * 2, DM, 2 * DFF, 2 * DFF, 1);
  for (int l = 0; l < DEPTH; ++l) add(p.in[11] + (size_t)l * DFF * DM, WS_WFO + (size_t)l * DM * DFF * 2, DFF, DM, DM, 0);
  for (int j = 0; j < 2; ++j) { const size_t b = WS_WMLA + j * MLA_W_STRIDE;
    add(p.in[12] + (size_t)j * DM * 576, b, DM, 576, 768, 2); add(p.in[14] + (size_t)j * 256 * 1536, b + MLA_OFF_UQ, 256, 1536, 1536, 3);
    add(p.in[16] + (size_t)j * 256 * 2048, b + MLA_OFF_UKV, 256, 2048, 2048, 0); add(p.in[17] + (size_t)j * DM * DM, b + MLA_OFF_WO, DM, DM, DM, 0); }
  add(p.in[18], WS_WNA, DM, 3072, 3072, 0); add(p.in[20], WS_WNA + (size_t)3072 * 1024 * 2, DM, DM, DM, 0);
  add(p.in[21], WS_WSWA, DM, 1280, 1280, 4); add(p.in[23], WS_WSWA + (size_t)1280 * 1024 * 2, DM, DM, DM, 0);
  p.nitems = first;
#if N_LAUNCH_SPLIT
  for (int ph = 0; ph < n; ++ph) { p.lo = ph; p.hi = ph + 1; hipLaunchKernelGGL(fwd_mega, dim3(grid), dim3(NTHREADS), LDS_BYTES, stream, p); }
#else
  p.lo = 0; p.hi = n;
  void* args[] = {&p};
  hipError_t e = hipLaunchCooperativeKernel((const void*)fwd_mega, dim3(grid), dim3(NTHREADS), args, LDS_BYTES, stream);
  if (e != hipSuccess) fprintf(stderr, "kernel_launch: cooperative launch failed: %s (grid %d)\n", hipGetErrorString(e), grid);
#endif
}
```

```cpp
#include <hip/hip_runtime.h>
#include <hip/hip_cooperative_groups.h>
#include <cstdio>
#include <cstdint>
namespace cg = cooperative_groups;

constexpr int DM = 1024, NBATCH = 4, SEQ = 8192, NLAT = NBATCH * SEQ, LC = 256, NCTX = NBATCH * LC, TOK = NLAT + NCTX, DFF = 2816, DEPTH = 4;
constexpr int MLA_KEYS = SEQ + LC;
#ifndef MLA_SDEPTH
#define MLA_SDEPTH 1
#endif
namespace pg8 {
#define PG8_LAS __attribute__((address_space(3)))
typedef unsigned short bf16_t;
typedef short bf16x8 __attribute__((ext_vector_type(8)));
typedef float f32x4 __attribute__((ext_vector_type(4)));
typedef unsigned u32x4 __attribute__((ext_vector_type(4)));
constexpr int BM = 256, BK = 64, HALF = 128, HTB = HALF * BK * 2  , STAGE_BYTES = 8 * HTB, NXCD = 8, WGM = 8;

__host__ __device__ __forceinline__ int lds_byte(int r, int c) { const int st = (r >> 4) * 2 + (c >> 5), rr = r & 15, cc = c & 31, ob = rr * 64 + cc * 2; return st * 1024 + (ob ^ (((ob >> 9) & 1) << 5)); }
__host__ __device__ __forceinline__ void stage_rc(int b, int& R, int& C) { const int st = b / 1024, sb = b % 1024, swz = sb ^ (((sb >> 9) & 1) << 5); R = (st >> 1) * 16 + swz / 64; C = (st & 1) * 32 + (swz % 64) / 2; }
__host__ __device__ __forceinline__ int perm32(int rho) { const int n = rho >> 4, i = rho & 15; return 8 * (i >> 2) + 4 * n + (i & 3); }

struct Unit { int pm, pn; };
struct Gemm { const bf16_t* A; const bf16_t* Bt; int M, N, K; };

struct StaticOrder {
    int nM, nN, nwg, G, c;
    __host__ __device__ void init(int M, int N, int G_, int c_) { nM = M / BM; nN = N / BM; nwg = nM * nN; G = G_; c = c_; }
    __host__ __device__ bool next(int i, Unit& u) const {
        const long L = (long)i * G + c; if (L >= nwg) return false;
        int wgid = (int)L; { const int q = nwg / NXCD, r = nwg % NXCD, xcd = wgid % NXCD, off = wgid / NXCD; wgid = (xcd < r ? xcd * (q + 1) : r * (q + 1) + (xcd - r) * q) + off; }
        const int nig = WGM * nN, gid = wgid / nig, fm = gid * WGM, gsz = (nM - fm) < WGM ? (nM - fm) : WGM;
        u.pm = fm + ((wgid % nig) % gsz); u.pn = (wgid % nig) / gsz; return true;
    }
    __device__ __forceinline__ void a_ready(const Unit&) const {}
    __device__ __forceinline__ void done(const Unit&) const {}
};

__device__ __forceinline__ unsigned cvt_pk_bf16(float lo, float hi) { unsigned r; asm volatile("v_cvt_pk_bf16_f32 %0, %1, %2" : "=v"(r) : "v"(lo), "v"(hi)); return r; }
typedef float f32x2 __attribute__((ext_vector_type(2)));
struct EpiArgs { int kind; int ldc; bf16_t* o0; bf16_t* o1; const float* rope; };
__device__ __forceinline__ u32x4 pack8(const f32x4& v0, const f32x4& v1) { u32x4 w; w.x = cvt_pk_bf16(v0[0], v0[1]); w.y = cvt_pk_bf16(v0[2], v0[3]); w.z = cvt_pk_bf16(v1[0], v1[1]); w.w = cvt_pk_bf16(v1[2], v1[3]); return w; }
__device__ __forceinline__ void rope8(f32x4& v0, f32x4& v1, const float* rp) {
    const f32x4 a = *(const f32x4*)rp, b = *(const f32x4*)(rp + 4);
    const f32x4 x0 = v0, x1 = v1;
    v0[0] = x0[0] * a[0] - x0[1] * a[1]; v0[1] = x0[1] * a[0] + x0[0] * a[1];
    v0[2] = x0[2] * a[2] - x0[3] * a[3]; v0[3] = x0[3] * a[2] + x0[2] * a[3];
    v1[0] = x1[0] * b[0] - x1[1] * b[1]; v1[1] = x1[1] * b[0] + x1[0] * b[1];
    v1[2] = x1[2] * b[2] - x1[3] * b[3]; v1[3] = x1[3] * b[2] + x1[2] * b[3];
}
template <int KIND> __device__ __forceinline__ void emit8(const EpiArgs& a, int row, int col, f32x4 v0, f32x4 v1) {
    if constexpr (KIND == 0) { *(u32x4*)(a.o0 + (size_t)row * a.ldc + col) = pack8(v0, v1); }
    else if constexpr (KIND == 1) {
        float r[4];
#pragma unroll
        for (int i = 0; i < 4; ++i) { const float g = v0[i]; r[i] = g * v1[i] * __builtin_amdgcn_rcpf(1.0f + __builtin_amdgcn_exp2f(-g * 1.4426950408889634f)); }
        typedef unsigned u32x2 __attribute__((ext_vector_type(2))); u32x2 w; w.x = cvt_pk_bf16(r[0], r[1]); w.y = cvt_pk_bf16(r[2], r[3]);
        *(u32x2*)(a.o0 + (size_t)row * DFF + (col >> 1)) = w; }
    else if constexpr (KIND == 2) {
        const int within = col % 192;
        if (within >= 128 && row < NLAT) rope8(v0, v1, a.rope + ((size_t)(row & (SEQ - 1)) * 32 + ((within - 128) >> 1)) * 2);
        *(u32x4*)(a.o0 + (size_t)row * 1536 + col) = pack8(v0, v1); }
    else if constexpr (KIND == 3) {
        const int h = col >> 8, w = col & 255; int b, key;
        if (row < NLAT) { b = row >> 13; key = LC + (row & (SEQ - 1)); } else { const int r2 = row - NLAT; b = r2 >> 8; key = r2 & 255; }
        const size_t base = (size_t)(b * 8 + h) * MLA_KEYS + key;
        if (w < 128) *(u32x4*)(a.o0 + base * 192 + w) = pack8(v0, v1); else *(u32x4*)(a.o1 + base * 128 + (w - 128)) = pack8(v0, v1); }
    else {
        if (col < 1152 && row < NLAT) rope8(v0, v1, a.rope + ((size_t)(row & (SEQ - 1)) * 32 + ((col & 63) >> 1)) * 2);
        *(u32x4*)(a.o0 + (size_t)row * 1280 + col) = pack8(v0, v1); }
}
struct EpiGen {
    static constexpr bool PERM = true, AFTER_DRAIN = false;
    EpiArgs a;
    template <int KIND> __device__ __forceinline__ void run(const f32x4 (&acc)[2][2][4][2], const Unit& u, int wr, int wc, int fr, int fq) const {
        const int row0 = u.pm * BM + wr * 64 + fr, col0 = u.pn * BM + wc * 32 + 8 * fq;
#pragma unroll
        for (int ai = 0; ai < 2; ++ai)
#pragma unroll
            for (int m = 0; m < 4; ++m)
#pragma unroll
                for (int bj = 0; bj < 2; ++bj) { emit8<KIND>(a, row0 + ai * HALF + m * 16, col0 + bj * HALF, acc[ai][bj][m][0], acc[ai][bj][m][1]); asm volatile("" ::: "memory"); }
    }
    __device__ __forceinline__ void operator()(const f32x4 (&acc)[2][2][4][2], const Unit& u, int wr, int wc, int fr, int fq) const {
        switch (a.kind) { case 0: run<0>(acc, u, wr, wc, fr, fq); break; case 1: run<1>(acc, u, wr, wc, fr, fq); break; case 2: run<2>(acc, u, wr, wc, fr, fq); break;
                          case 3: run<3>(acc, u, wr, wc, fr, fq); break; default: run<4>(acc, u, wr, wc, fr, fq); break; }
    }
};
template <class Epi, class Sched, bool ALIGN_EPI = false, bool SP2 = false>
__device__ __forceinline__ void gemm_phase(PG8_LAS unsigned char* lds, const Gemm g, const Sched& S, const Epi& E, const int tid) {
    const int wid = __builtin_amdgcn_readfirstlane(tid >> 6), lane = tid & 63, wr = wid >> 2, wc = wid & 3, fr = lane & 15, fq = lane >> 4;
    const int K = g.K, nt = K / BK;
    unsigned voffA[2], voffB[2];
#pragma unroll
    for (int i = 0; i < 2; ++i) { int R, C; stage_rc(tid * 16 + i * 8192, R, C); const int Rb = Epi::PERM ? ((R & ~31) + perm32(R & 31)) : R;
        voffA[i] = (unsigned)(R * K + C) * 2u; voffB[i] = (unsigned)(Rb * K + C) * 2u; }
    const size_t kstep = (size_t)(BK * 2);
    const size_t hstep = (size_t)HALF * K * 2;
    const size_t tstep = 2 * hstep;
    const unsigned ldsw = (unsigned)wid * 1024u;
    const int aoff = lds_byte(wr * 64 + fr, fq * 8), boff = lds_byte(wc * 32 + fr, fq * 8);
#define PG8_SA(b, h) (((b) * 2 + (h)) * HTB)
#define PG8_SB(b, h) ((4 + (b) * 2 + (h)) * HTB)
#define PG8_STAGE(bufoff, gbase, voff) do { _Pragma("unroll") for (int _i = 0; _i < 2; ++_i) \
        __builtin_amdgcn_global_load_lds((const unsigned*)((const char*)(gbase) + (voff)[_i]), (PG8_LAS unsigned*)(lds + (bufoff) + ldsw + _i * 8192), 16, 0, 0); } while (0)
#define PG8_LDA(dst, b, h) do { _Pragma("unroll") for (int m = 0; m < 4; ++m) _Pragma("unroll") for (int k = 0; k < 2; ++k) dst[m][k] = *(const PG8_LAS bf16x8*)(lds + PG8_SA(b, h) + aoff + m * 2048 + k * 1024); } while (0)
#define PG8_LDB(dst, b, h) do { _Pragma("unroll") for (int n = 0; n < 2; ++n) _Pragma("unroll") for (int k = 0; k < 2; ++k) dst[n][k] = *(const PG8_LAS bf16x8*)(lds + PG8_SB(b, h) + boff + n * 2048 + k * 1024); } while (0)
#define PG8_MMA(ai, bj, At, Bt) do { __builtin_amdgcn_s_setprio(1); _Pragma("unroll") for (int m = 0; m < 4; ++m) _Pragma("unroll") for (int n = 0; n < 2; ++n) _Pragma("unroll") for (int k = 0; k < 2; ++k) \
        acc[ai][bj][m][n] = __builtin_amdgcn_mfma_f32_16x16x32_bf16(Bt[n][k], At[m][k], acc[ai][bj][m][n], 0, 0, 0); __builtin_amdgcn_s_setprio(0); } while (0)
#define PG8_WAIT_V(n) asm volatile("s_waitcnt vmcnt(" #n ")" ::: "memory")
#define PG8_WAIT_L(n) asm volatile("s_waitcnt lgkmcnt(" #n ")" ::: "memory")
#define PG8_BAR __builtin_amdgcn_s_barrier()
#define PG8_SCHED __builtin_amdgcn_sched_barrier(0)
    Unit cur, nxt; int ui = 0;
    if (!S.next(0, cur)) return;
    f32x4 acc[2][2][4][2];
#pragma unroll
    for (int a = 0; a < 2; ++a)
#pragma unroll
        for (int b = 0; b < 2; ++b)
#pragma unroll
            for (int m = 0; m < 4; ++m)
#pragma unroll
                for (int n = 0; n < 2; ++n) acc[a][b][m][n] = (f32x4){0.f, 0.f, 0.f, 0.f};
    bf16x8 At[4][2], B0[2][2], B1[2][2];
    const char* cA = (const char*)g.A + (size_t)cur.pm * tstep; const char* cB = (const char*)g.Bt + (size_t)cur.pn * tstep;
    S.a_ready(cur);
    if constexpr (SP2) {
        PG8_STAGE(PG8_SB(0, 0), cB, voffB); PG8_STAGE(PG8_SB(0, 1), cB + hstep, voffB); PG8_STAGE(PG8_SA(0, 0), cA, voffA); PG8_STAGE(PG8_SA(0, 1), cA + hstep, voffA);
        if (wr == 1) PG8_BAR;
        PG8_WAIT_V(2); PG8_BAR;
        PG8_STAGE(PG8_SB(1, 0), cB + kstep, voffB); PG8_STAGE(PG8_SA(1, 0), cA + kstep, voffA); PG8_STAGE(PG8_SB(1, 1), cB + hstep + kstep, voffB);
        PG8_WAIT_V(6); PG8_BAR;
    } else {
        PG8_STAGE(PG8_SB(0, 0), cB, voffB); PG8_STAGE(PG8_SA(0, 0), cA, voffA); PG8_STAGE(PG8_SB(0, 1), cB + hstep, voffB); PG8_STAGE(PG8_SA(0, 1), cA + hstep, voffA);
        if (wr == 1) PG8_BAR;
        PG8_WAIT_V(4); PG8_BAR;
        PG8_STAGE(PG8_SB(1, 0), cB + kstep, voffB); PG8_STAGE(PG8_SA(1, 0), cA + kstep, voffA); PG8_STAGE(PG8_SB(1, 1), cB + hstep + kstep, voffB);
        PG8_WAIT_V(6); PG8_BAR;
    }
    for (;;) {
        const bool has_next = S.next(ui + 1, nxt);
        const char* nA = has_next ? (const char*)g.A + (size_t)nxt.pm * tstep : cA; const char* nB = has_next ? (const char*)g.Bt + (size_t)nxt.pn * tstep : cB;
        for (int t = 0; t < nt; t += 2) {
            const bool last = (t == nt - 2);
            const char* a1 = cA + (size_t)(t + 1) * kstep;
            const char* a2 = last ? nA : cA + (size_t)(t + 2) * kstep; const char* b2 = last ? nB : cB + (size_t)(t + 2) * kstep;
            const char* a3 = a2 + kstep; const char* b3 = b2 + kstep;
            if (last && has_next) S.a_ready(nxt);
            if constexpr (SP2) {
            PG8_LDB(B0, 0, 0); PG8_LDB(B1, 0, 1); PG8_SCHED; PG8_LDA(At, 0, 0); PG8_STAGE(PG8_SA(1, 1), a1 + hstep, voffA);
            PG8_WAIT_V(8); PG8_WAIT_L(0); PG8_BAR; PG8_MMA(0, 0, At, B0); PG8_MMA(0, 1, At, B1); PG8_BAR; PG8_SCHED;
            PG8_LDA(At, 0, 1); PG8_STAGE(PG8_SB(0, 0), b2, voffB); PG8_STAGE(PG8_SB(0, 1), b2 + hstep, voffB); PG8_STAGE(PG8_SA(0, 0), a2, voffA);
            PG8_WAIT_V(8); PG8_WAIT_L(0); PG8_BAR; PG8_MMA(1, 0, At, B0); PG8_MMA(1, 1, At, B1); PG8_BAR; PG8_SCHED;
            PG8_LDB(B0, 1, 0); PG8_LDB(B1, 1, 1); PG8_SCHED; PG8_LDA(At, 1, 0); PG8_STAGE(PG8_SA(0, 1), a2 + hstep, voffA);
            PG8_WAIT_V(8); PG8_WAIT_L(0); PG8_BAR; PG8_MMA(0, 0, At, B0); PG8_MMA(0, 1, At, B1); PG8_BAR; PG8_SCHED;
            PG8_LDA(At, 1, 1); PG8_STAGE(PG8_SB(1, 0), b3, voffB); PG8_STAGE(PG8_SB(1, 1), b3 + hstep, voffB); PG8_STAGE(PG8_SA(1, 0), a3, voffA);
            PG8_WAIT_V(8); PG8_WAIT_L(0); PG8_BAR; PG8_MMA(1, 0, At, B0); PG8_MMA(1, 1, At, B1); PG8_BAR; PG8_SCHED;
            } else {
            PG8_LDB(B0, 0, 0); PG8_SCHED; PG8_LDA(At, 0, 0); PG8_STAGE(PG8_SA(1, 1), a1 + hstep, voffA);
            PG8_WAIT_L(8); PG8_BAR; PG8_WAIT_L(0); PG8_MMA(0, 0, At, B0); PG8_BAR; PG8_SCHED;
            PG8_LDB(B1, 0, 1); PG8_STAGE(PG8_SB(0, 0), b2, voffB);
            PG8_BAR; PG8_WAIT_L(0); PG8_MMA(0, 1, At, B1); PG8_BAR;
            PG8_LDA(At, 0, 1); PG8_STAGE(PG8_SA(0, 0), a2, voffA);
            PG8_BAR; PG8_WAIT_L(0); PG8_MMA(1, 0, At, B0); PG8_BAR; PG8_SCHED;
            PG8_STAGE(PG8_SB(0, 1), b2 + hstep, voffB);
            PG8_WAIT_V(6); PG8_BAR; PG8_MMA(1, 1, At, B1); PG8_BAR;
            PG8_LDB(B0, 1, 0); PG8_SCHED; PG8_LDA(At, 1, 0); PG8_STAGE(PG8_SA(0, 1), a2 + hstep, voffA);
            PG8_WAIT_L(8); PG8_BAR; PG8_WAIT_L(0); PG8_MMA(0, 0, At, B0); PG8_BAR; PG8_SCHED;
            PG8_LDB(B1, 1, 1); PG8_STAGE(PG8_SB(1, 0), b3, voffB);
            PG8_BAR; PG8_WAIT_L(0); PG8_MMA(0, 1, At, B1); PG8_BAR;
            PG8_LDA(At, 1, 1); PG8_STAGE(PG8_SA(1, 0), a3, voffA);
            PG8_BAR; PG8_WAIT_L(0); PG8_MMA(1, 0, At, B0); PG8_BAR; PG8_SCHED;
            PG8_STAGE(PG8_SB(1, 1), b3 + hstep, voffB);
            PG8_WAIT_V(6); PG8_BAR; PG8_MMA(1, 1, At, B1); PG8_BAR;
            }
        }
        if constexpr (ALIGN_EPI) { if (wr == 0) PG8_BAR; }
        if constexpr (!Epi::AFTER_DRAIN) { E(acc, cur, wr, wc, fr, fq); S.done(cur); }
        if (!has_next) break;
#pragma unroll
        for (int a = 0; a < 2; ++a)
#pragma unroll
            for (int b = 0; b < 2; ++b)
#pragma unroll
                for (int m = 0; m < 4; ++m)
#pragma unroll
                    for (int n = 0; n < 2; ++n) acc[a][b][m][n] = (f32x4){0.f, 0.f, 0.f, 0.f};
        cur = nxt; cA = nA; cB = nB; ++ui;
        if constexpr (ALIGN_EPI) { if (wr == 1) PG8_BAR; }
    }
    PG8_WAIT_V(0);
    if constexpr (!ALIGN_EPI) { if (wr == 0) PG8_BAR; }
    PG8_BAR;
    if constexpr (Epi::AFTER_DRAIN) { E.fused(acc, cur, wr, wc, fr, fq, lds, wid, lane); S.done(cur); }
#undef PG8_SA
#undef PG8_SB
#undef PG8_STAGE
#undef PG8_LDA
#undef PG8_LDB
#undef PG8_MMA
#undef PG8_WAIT_V
#undef PG8_WAIT_L
#undef PG8_BAR
#undef PG8_SCHED
}
}
namespace att {
using bf16x8 = __attribute__((ext_vector_type(8))) short;
using s16x4  = __attribute__((ext_vector_type(4))) short;
using f32x16 = __attribute__((ext_vector_type(16))) float;
using u32x4  = __attribute__((ext_vector_type(4))) unsigned;
typedef unsigned short bf16_t;
#define SBAR() __builtin_amdgcn_sched_barrier(0)
__device__ __forceinline__ int crow(int r, int hi) { return (r & 3) + 8 * (r >> 2) + 4 * hi; }
__device__ __forceinline__ unsigned cvtpk(float lo, float hi) { unsigned r; asm volatile("v_cvt_pk_bf16_f32 %0, %1, %2" : "=v"(r) : "v"(lo), "v"(hi)); return r; }
template <int DK> __device__ __forceinline__ int kswz(int row, int colB) { return row * (DK * 2) + (colB ^ ((row & 7) << 4)); }

__device__ __forceinline__ void partialSM(f32x16& p0, f32x16& p1, float& m_reg, float& mn, float& alpha, const float C, const float THRS) {
  float pmax = p0[0];
#pragma unroll
  for (int r = 1; r < 16; ++r) pmax = fmaxf(pmax, p0[r]);
#pragma unroll
  for (int r = 0; r < 16; ++r) pmax = fmaxf(pmax, p1[r]);
  { auto rr = __builtin_amdgcn_permlane32_swap(__float_as_uint(pmax), __float_as_uint(pmax), false, false);
    pmax = fmaxf(__uint_as_float(rr[0]), __uint_as_float(rr[1])); }
  if (__builtin_expect(__all(pmax - m_reg <= THRS), 1)) { mn = m_reg; alpha = 1.f; }
  else { mn = fmaxf(m_reg, pmax); alpha = __builtin_amdgcn_exp2f((m_reg - mn) * C); m_reg = mn; }
  const float mnC = -mn * C;
#pragma unroll
  for (int r = 0; r < 16; ++r) p0[r] = fmaf(p0[r], C, mnC);
#pragma unroll
  for (int r = 0; r < 16; ++r) p1[r] = fmaf(p1[r], C, mnC);
#pragma unroll
  for (int r = 0; r < 16; ++r) p0[r] = __builtin_amdgcn_exp2f(p0[r]);
}
__device__ __forceinline__ void finishSM(f32x16& p0, f32x16& p1, float alpha, float& l_reg, bf16x8& pa0, bf16x8& pa1, bf16x8& pa2, bf16x8& pa3) {
#pragma unroll
  for (int r = 0; r < 16; ++r) p1[r] = __builtin_amdgcn_exp2f(p1[r]);
  float ps = 0;
#pragma unroll
  for (int r = 0; r < 16; ++r) ps += p0[r];
#pragma unroll
  for (int r = 0; r < 16; ++r) ps += p1[r];
  { auto rr = __builtin_amdgcn_permlane32_swap(__float_as_uint(ps), __float_as_uint(ps), false, false);
    ps = __uint_as_float(rr[0]) + __uint_as_float(rr[1]); }
  l_reg = l_reg * alpha + ps;
#define PK4(P, BASE, OUT) do { unsigned a0 = cvtpk(P[BASE + 0], P[BASE + 1]), a1 = cvtpk(P[BASE + 2], P[BASE + 3]);   \
    unsigned b0 = cvtpk(P[BASE + 4], P[BASE + 5]), b1 = cvtpk(P[BASE + 6], P[BASE + 7]);                              \
    auto r0 = __builtin_amdgcn_permlane32_swap(a0, b0, false, false); auto r1 = __builtin_amdgcn_permlane32_swap(a1, b1, false, false); \
    u32x4 w = {r0[0], r1[0], r0[1], r1[1]}; OUT = *reinterpret_cast<bf16x8*>(&w); } while (0)
  PK4(p0, 0, pa0); PK4(p0, 8, pa1); PK4(p1, 0, pa2); PK4(p1, 8, pa3);
#undef PK4
}
template <int DK> __device__ __forceinline__ void qkt(f32x16& p0, f32x16& p1, const char* Ks, const bf16x8* qr, const unsigned* kb) {
  p0 = f32x16{}; p1 = f32x16{};
#pragma unroll
  for (int d0 = 0; d0 < DK / 16; ++d0) { const char* a = Ks + kb[d0 & 3];
    const bf16x8 b0 = *reinterpret_cast<const bf16x8*>(a + (d0 >> 2) * 128);
    const bf16x8 b1 = *reinterpret_cast<const bf16x8*>(a + (d0 >> 2) * 128 + 32 * DK * 2);
    p0 = __builtin_amdgcn_mfma_f32_32x32x16_bf16(b0, qr[d0], p0, 0, 0, 0);
    p1 = __builtin_amdgcn_mfma_f32_32x32x16_bf16(b1, qr[d0], p1, 0, 0, 0); }
}
template <int DV> __device__ __forceinline__ int v_st(int k, int c) { const int kk = (k & ~0xC) | ((k & 4) << 1) | ((k & 8) >> 1); return ((kk >> 3) * (DV / 32) + (c >> 5)) * 512 + ((kk & 7) * 32 + (c & 31)) * 2; }
__device__ __forceinline__ int v_rd_base(int lane) { return ((lane & 3) << 3) | (((lane >> 2) & 3) << 6) | (((lane >> 4) & 1) << 5) | (((lane >> 5) & 1) << 8); }
template <int DV> constexpr int v_rd_off(int d0, int ks, int half) { return d0 * 512 + ks * (DV / 32) * 1024 + half * (DV / 32) * 512; }
template <int OFF> __device__ __forceinline__ s16x4 tr_read(int vb) { s16x4 r; asm volatile("ds_read_b64_tr_b16 %0, %1 offset:%2" : "=&v"(r) : "v"(vb), "i"(OFF) : "memory"); return r; }
template <int DV, int D0> __device__ __forceinline__ void pv_one(f32x16& od, int vb, bf16x8 pa0, bf16x8 pa1, bf16x8 pa2, bf16x8 pa3) {
  const s16x4 l0 = tr_read<v_rd_off<DV>(D0, 0, 0)>(vb), h0 = tr_read<v_rd_off<DV>(D0, 0, 1)>(vb), l1 = tr_read<v_rd_off<DV>(D0, 1, 0)>(vb), h1 = tr_read<v_rd_off<DV>(D0, 1, 1)>(vb);
  const s16x4 l2 = tr_read<v_rd_off<DV>(D0, 2, 0)>(vb), h2 = tr_read<v_rd_off<DV>(D0, 2, 1)>(vb), l3 = tr_read<v_rd_off<DV>(D0, 3, 0)>(vb), h3 = tr_read<v_rd_off<DV>(D0, 3, 1)>(vb);
  asm volatile("s_waitcnt lgkmcnt(0)" ::: "memory"); SBAR();
#define PK(L, H) (bf16x8){L[0], L[1], L[2], L[3], H[0], H[1], H[2], H[3]}
  od = __builtin_amdgcn_mfma_f32_32x32x16_bf16(pa0, PK(l0, h0), od, 0, 0, 0);
  od = __builtin_amdgcn_mfma_f32_32x32x16_bf16(pa1, PK(l1, h1), od, 0, 0, 0);
  od = __builtin_amdgcn_mfma_f32_32x32x16_bf16(pa2, PK(l2, h2), od, 0, 0, 0);
  od = __builtin_amdgcn_mfma_f32_32x32x16_bf16(pa3, PK(l3, h3), od, 0, 0, 0);
#undef PK
}
template <int DV> __device__ __forceinline__ void pv_all(f32x16* o, int vb, bf16x8 pa0, bf16x8 pa1, bf16x8 pa2, bf16x8 pa3) {
  pv_one<DV, 0>(o[0], vb, pa0, pa1, pa2, pa3); pv_one<DV, 1>(o[1], vb, pa0, pa1, pa2, pa3);
  if constexpr (DV == 128) { pv_one<DV, 2>(o[2], vb, pa0, pa1, pa2, pa3); pv_one<DV, 3>(o[3], vb, pa0, pa1, pa2, pa3); }
}
struct UnitP {
  const bf16_t* Q;
  const bf16_t *Kc, *Vc, *Kn, *Vn;
  bf16_t* O;
  int NT; float m0, l0; int a0, a1;
};
template <int MODE> __device__ __forceinline__ void apply_mask(f32x16& p0, f32x16& p1, int jj, const UnitP& u, int wid, int r32, int hi, const float* bias_l) {
  const float NEG = -1e30f;
  if constexpr (MODE == 2) {
    const int ks = u.a0 - 128 + 64 * jj; const bool tv = (ks >= 0 && ks < SEQ);
    const int rel0 = -128 + 64 * jj - (wid * 32 + r32);
#pragma unroll
    for (int r = 0; r < 16; ++r) { const int rel = rel0 + crow(r, hi);
      const bool ok0 = tv && rel >= -128 && rel <= 128, ok1 = tv && rel + 32 >= -128 && rel + 32 <= 128;
      p0[r] = ok0 ? p0[r] : NEG; p1[r] = ok1 ? p1[r] : NEG; }
  } else if constexpr (MODE == 1) {
    const int r = u.a0 + (wid >> 1), c = (wid & 1) * 32 + r32, kr = u.a1 + jj;
    const int rs = min(max(r - 4, 0), 120), cs = min(max(c - 8, 0), 48); const bool rok = (kr >= rs && kr < rs + 8);
    const int ib = (kr - r + 7) * 31 - c + 15;
#pragma unroll
    for (int q = 0; q < 16; ++q) { const int k0 = crow(q, hi), k1 = k0 + 32;
      const bool ok0 = rok && k0 >= cs && k0 < cs + 16, ok1 = rok && k1 >= cs && k1 < cs + 16;
      const float b0 = bias_l[ok0 ? ib + k0 : 0], b1 = bias_l[ok1 ? ib + k1 : 0];
      p0[q] = ok0 ? p0[q] + b0 : NEG; p1[q] = ok1 ? p1[q] + b1 : NEG; }
  }
}
template <int DK, int DV, int LDQ, int LDK, int LDV, int MODE, int SDEPTH, bool SERIAL>
__device__ __forceinline__ void attn_unit(const UnitP& u, char* lds, const float* bias_l, const int tid) {
  constexpr float SCALE = (DK == 192) ? 0.07216878364870322f : 0.125f;
  constexpr float C = SCALE * 1.4426950408889634f, THRS = 8.f / SCALE;
  constexpr int SHM_V = 64 * DV * 2, SHM_K = 64 * DK * 2, KC = DK / 64, VC = DV / 64, ND = DK / 16, NO = DV / 32;
  const int wid = tid >> 6, lane = tid & 63, r32 = lane & 31, hi = lane >> 5;
  char* V_lds = lds; char* K_lds = lds + 2 * SHM_V;
  float* ws = (float*)(lds + 2 * SHM_V + 2 * SHM_K) + wid * 64; float* li_l = ws; float* al_l = ws + 32;
  float m_reg = u.m0, l_reg = u.l0; f32x16 o[NO]; bf16x8 qr[ND];
#pragma unroll
  for (int d = 0; d < NO; ++d) o[d] = f32x16{};
  const bf16_t* Qw = u.Q + (long)(wid * 32 + r32) * LDQ + hi * 8;
#pragma unroll
  for (int d0 = 0; d0 < ND; ++d0) qr[d0] = *reinterpret_cast<const bf16x8*>(Qw + d0 * 16);
  unsigned kofs[KC], kdst[KC], vofs[VC], vdst[VC];
#pragma unroll
  for (int c = 0; c < KC; ++c) { const int id = tid + 512 * c, row = id / (DK / 8), ch = id % (DK / 8); kofs[c] = row * LDK + ch * 8; kdst[c] = kswz<DK>(row, ch * 16); }
#pragma unroll
  for (int c = 0; c < VC; ++c) { const int id = tid + 512 * c, row = id / (DV / 8), ch = id % (DV / 8); vofs[c] = row * LDV + ch * 8; vdst[c] = v_st<DV>(row, ch * 8); }
  const int vb0 = (int)(uintptr_t)V_lds + v_rd_base(lane);
  unsigned kb[4];
#pragma unroll
  for (int e = 0; e < 4; ++e) kb[e] = (unsigned)(r32 * (DK * 2) + ((e * 32 + hi * 16) ^ ((r32 & 7) << 4)));
  struct { bf16x8 k[KC]; bf16x8 v[VC]; } sr_[SDEPTH];
#define TILE_PTRS(j, Kt, Vt) do { if ((j) < 4) { Kt = u.Kc + (long)(j) * 64 * LDK; Vt = u.Vc + (long)(j) * 64 * LDV; } \
    else if (MODE == 2) { int ks_ = u.a0 - 128 + 64 * ((j) - 4); if (ks_ < 0 || ks_ >= SEQ) ks_ = 0; Kt = u.Kn + (long)ks_ * LDK; Vt = u.Vn + (long)ks_ * LDV; } \
    else { Kt = u.Kn + (long)((j) - 4) * 64 * LDK; Vt = u.Vn + (long)((j) - 4) * 64 * LDV; } } while (0)
#define SLOAD(i, j) do { const bf16_t *Kt_, *Vt_; TILE_PTRS(j, Kt_, Vt_); \
    _Pragma("unroll") for (int c = 0; c < VC; ++c) sr_[i].v[c] = *reinterpret_cast<const bf16x8*>(Vt_ + vofs[c]); \
    _Pragma("unroll") for (int c = 0; c < KC; ++c) sr_[i].k[c] = *reinterpret_cast<const bf16x8*>(Kt_ + kofs[c]); } while (0)
#define SWRITE(b, i) do { _Pragma("unroll") for (int c = 0; c < VC; ++c) *(bf16x8*)(V_lds + (b) * SHM_V + vdst[c]) = sr_[i].v[c]; \
    _Pragma("unroll") for (int c = 0; c < KC; ++c) *(bf16x8*)(K_lds + (b) * SHM_K + kdst[c]) = sr_[i].k[c]; } while (0)
#define SWAIT() do { if constexpr (SDEPTH == 2) asm volatile("s_waitcnt vmcnt(%0)" :: "n"(KC + VC) : "memory"); else asm volatile("s_waitcnt vmcnt(0)" ::: "memory"); } while (0)
#define RESC(a) do { if (__any((a) < 1.f)) { if (hi == 0) al_l[r32] = (a); asm volatile("s_waitcnt lgkmcnt(0)" ::: "memory"); \
    _Pragma("unroll") for (int d = 0; d < NO; ++d) _Pragma("unroll") for (int r = 0; r < 16; ++r) o[d][r] *= al_l[crow(r, hi)]; } } while (0)
#define MASK(P0, P1, j) do { if (MODE != 0 && (j) >= 4) apply_mask<MODE>(P0, P1, (j) - 4, u, wid, r32, hi, bias_l); } while (0)
  bf16x8 pa0, pa1, pa2, pa3; const int NT = u.NT;
  if constexpr (SERIAL) {
    f32x16 p0, p1; float mn, al;
    SLOAD(0, 0); asm volatile("s_waitcnt vmcnt(0)" ::: "memory"); SWRITE(0, 0); __syncthreads();
    for (int j = 0; j < NT; ++j) {
      const int b = j & 1;
      if (j + 1 < NT) SLOAD(0, j + 1);
      SBAR(); qkt<DK>(p0, p1, K_lds + b * SHM_K, qr, kb); MASK(p0, p1, j);
      partialSM(p0, p1, m_reg, mn, al, C, THRS); RESC(al);
      finishSM(p0, p1, al, l_reg, pa0, pa1, pa2, pa3); SBAR();
      pv_all<DV>(o, vb0 + b * SHM_V, pa0, pa1, pa2, pa3); SBAR();
      if (j + 1 < NT) SWRITE(b ^ 1, 0);
      __syncthreads();
    }
  } else {
  f32x16 pA0, pA1, pB0, pB1; float mnA, mnB, alA, alB;
  constexpr int SE = 0, SO = SDEPTH - 1;
  SLOAD(SE, 0); asm volatile("s_waitcnt vmcnt(0)" ::: "memory"); SWRITE(0, SE); __syncthreads();
  qkt<DK>(pA0, pA1, K_lds, qr, kb); partialSM(pA0, pA1, m_reg, mnA, alA, C, THRS);
  SLOAD(SO, 1); if constexpr (SDEPTH == 2) { if (2 < NT) SLOAD(SE, 2); }
  SWAIT(); SWRITE(1, SO); __syncthreads();
  for (int j = 1; j + 1 < NT; j += 2) {
    SBAR(); qkt<DK>(pB0, pB1, K_lds + SHM_K, qr, kb); finishSM(pA0, pA1, alA, l_reg, pa0, pa1, pa2, pa3); SBAR();
    SLOAD(SO, j + SDEPTH); SBAR();
    pv_all<DV>(o, vb0, pa0, pa1, pa2, pa3); MASK(pB0, pB1, j); partialSM(pB0, pB1, m_reg, mnB, alB, C, THRS);
    __syncthreads(); SWAIT(); SWRITE(0, SE);
    RESC(alB); __syncthreads();
    SBAR(); qkt<DK>(pA0, pA1, K_lds, qr, kb); finishSM(pB0, pB1, alB, l_reg, pa0, pa1, pa2, pa3); SBAR();
    if (SDEPTH == 1 || j + 3 < NT) SLOAD(SE, j + 1 + SDEPTH); SBAR();
    pv_all<DV>(o, vb0 + SHM_V, pa0, pa1, pa2, pa3); MASK(pA0, pA1, j + 1); partialSM(pA0, pA1, m_reg, mnA, alA, C, THRS);
    __syncthreads(); SWAIT(); SWRITE(1, SO);
    RESC(alA); __syncthreads();
  }
  SBAR(); qkt<DK>(pB0, pB1, K_lds + SHM_K, qr, kb); finishSM(pA0, pA1, alA, l_reg, pa0, pa1, pa2, pa3); SBAR();
  pv_all<DV>(o, vb0, pa0, pa1, pa2, pa3); MASK(pB0, pB1, NT - 1); partialSM(pB0, pB1, m_reg, mnB, alB, C, THRS);
  __syncthreads(); RESC(alB);
  finishSM(pB0, pB1, alB, l_reg, pa0, pa1, pa2, pa3); SBAR();
  pv_all<DV>(o, vb0 + SHM_V, pa0, pa1, pa2, pa3);
  }
  { int t2 = tid; asm volatile("" : "+v"(t2)); const int wid2 = t2 >> 6, lane2 = t2 & 63, r32b = lane2 & 31, hib = lane2 >> 5;
    float* li2 = (float*)(lds + 2 * SHM_V + 2 * SHM_K) + wid2 * 64;
    if (hib == 0) li2[r32b] = l_reg; asm volatile("s_waitcnt lgkmcnt(0)" ::: "memory");
    __syncthreads();
    bf16_t* stg = (bf16_t*)lds + wid2 * 32 * DV;
#pragma unroll
    for (int r = 0; r < 16; ++r) { const int orow = crow(r, hib); const float rl = __builtin_amdgcn_rcpf(li2[orow]);
#pragma unroll
      for (int d0 = 0; d0 < NO; ++d0) { const unsigned w = cvtpk(o[d0][r] * rl, 0.f); stg[orow * DV + d0 * 32 + r32b] = (bf16_t)(w & 0xffffu); } }
    asm volatile("s_waitcnt lgkmcnt(0)" ::: "memory");
    bf16_t* Ow = u.O + (long)(wid2 * 32) * DM;
#pragma unroll
    for (int i = 0; i < (32 * DV / 8) / 64; ++i) { const int id = i * 64 + lane2, row = id / (DV / 8), ch = id % (DV / 8);
      const u32x4 v = *(const u32x4*)(stg + row * DV + ch * 8); *(u32x4*)(Ow + (long)row * DM + ch * 8) = v; } }
  __syncthreads();
#undef TILE_PTRS
#undef SLOAD
#undef SWRITE
#undef SWAIT
#undef RESC
#undef MASK
}
#undef SBAR
}
typedef unsigned short bf16_t;
typedef float f32x4 __attribute__((ext_vector_type(4)));
typedef unsigned u32x4 __attribute__((ext_vector_type(4)));
typedef unsigned u32x2 __attribute__((ext_vector_type(2)));
#define LAS __attribute__((address_space(3)))
#define XB_TMO      128
#define XB_XCNT(j)  (256  + 64 * (j))
#define XB_XSUB(j)  (1280 + 64 * (j))
#define XB_XGEN(j)  (2304 + 64 * (j))
#define XB_TOP      3328
#define XB_TOPGEN   3392
#define XCD_BAR_WORDS 3456
#define XB_SPIN_CAP (1u << 18)

__device__ __forceinline__ unsigned xb_ld(unsigned* p)              { return __hip_atomic_load(p, __ATOMIC_RELAXED, __HIP_MEMORY_SCOPE_AGENT); }
__device__ __forceinline__ unsigned xb_add(unsigned* p, unsigned v) { return __hip_atomic_fetch_add(p, v, __ATOMIC_RELAXED, __HIP_MEMORY_SCOPE_AGENT); }
__device__ __forceinline__ unsigned xb_xcc_id() { return (unsigned)__builtin_amdgcn_s_getreg((3 << 11) | 20) & 0xFu; }
#define XB_SPIN(cond, bar) do { unsigned _sp = 0; while (cond) { __builtin_amdgcn_s_sleep(1); \
    if ((++_sp & 255u) == 0u) { if (xb_ld(&(bar)[XB_TMO])) break; if (_sp > XB_SPIN_CAP) { atomicAdd(&(bar)[XB_TMO], 1u); break; } } } } while (0)

struct XcdBarrier {
    unsigned* bar; unsigned x;
    volatile LAS unsigned* st;
};

__device__ __forceinline__ XcdBarrier xcd_barrier_post(unsigned* bar, volatile LAS unsigned* st) {
    XcdBarrier b; b.bar = bar; b.x = xb_xcc_id(); b.st = st;
    if (threadIdx.x == 0) (void)xb_add(&bar[XB_XCNT(b.x)], 1u);
    return b;
}
__device__ __forceinline__ void xcd_barrier_complete(unsigned* bar, unsigned x, unsigned& nloc, unsigned& nx) {
    const unsigned G = gridDim.x * gridDim.y * gridDim.z;
    unsigned sum, cnt, mine, sp = 0u;
    for (;;) {
        sum = 0u; cnt = 0u; mine = 0u;
#pragma unroll
        for (unsigned j = 0; j < 16; ++j) { const unsigned c = xb_ld(&bar[XB_XCNT(j)]); sum += c; cnt += (c > 0u) ? 1u : 0u; mine = (j == x) ? c : mine; }
        if (sum == G) break;
        __builtin_amdgcn_s_sleep(1);
        if ((++sp & 255u) == 0u) { if (xb_ld(&bar[XB_TMO])) break; if (sp > XB_SPIN_CAP) { atomicAdd(&bar[XB_TMO], 1u); break; } }
    }
    nloc = mine > 0u ? mine : 1u; nx = cnt > 0u ? cnt : 1u;
}

__device__ __forceinline__ void xcd_barrier(const XcdBarrier& b) {
    asm volatile("s_waitcnt vmcnt(0)" ::: "memory");
    __syncthreads();
    if (threadIdx.x == 0) {
        unsigned* bar = b.bar;
        __builtin_amdgcn_s_waitcnt(0);
        unsigned nloc = b.st[0], nx = b.st[1];
        if (nloc == 0u) { xcd_barrier_complete(bar, b.x, nloc, nx); b.st[0] = nloc; b.st[1] = nx; }
        const unsigned old = xb_add(&bar[XB_XSUB(b.x)], 1u);
        const unsigned gen = old / nloc;
        if (old + 1u == (gen + 1u) * nloc) {
            __builtin_amdgcn_fence(__ATOMIC_RELEASE, "agent");
            asm volatile("s_waitcnt vmcnt(0)" ::: "memory");
            const unsigned og = xb_add(&bar[XB_TOP], 1u);
            const unsigned tg = og / nx;
            if (og + 1u == (tg + 1u) * nx) xb_add(&bar[XB_TOPGEN], 1u);
            else XB_SPIN(xb_ld(&bar[XB_TOPGEN]) == tg, bar);
            __builtin_amdgcn_fence(__ATOMIC_ACQUIRE, "agent");
            xb_add(&bar[XB_XGEN(b.x)], 1u);
            asm volatile("s_waitcnt vmcnt(0)" ::: "memory");
        } else {
            XB_SPIN(xb_ld(&bar[XB_XGEN(b.x)]) == gen, bar);
            __builtin_amdgcn_fence(__ATOMIC_ACQUIRE, "agent");
            asm volatile("s_waitcnt vmcnt(0)" ::: "memory");
        }
    }
    __syncthreads();
}

constexpr size_t MiB = 1u << 20;
constexpr size_t WS_BAR = 7 * MiB, BAR_BYTES = 16384;
constexpr size_t WS_MOD = 0, WS_ROPE = 1 * MiB, WS_XCTX = 3 * MiB;
constexpr size_t WS_WFI = 8 * MiB, WS_WFO = 52 * MiB, WS_WMLA = 74 * MiB, WS_WNA = 85 * MiB, WS_WSWA = 93 * MiB;
constexpr size_t MLA_W_STRIDE = (size_t)(768 * 1024 + 1536 * 256 + 2048 * 256 + 1024 * 1024) * 2;
constexpr size_t MLA_OFF_UQ = (size_t)768 * 1024 * 2, MLA_OFF_UKV = MLA_OFF_UQ + (size_t)1536 * 256 * 2, MLA_OFF_WO = MLA_OFF_UKV + (size_t)2048 * 256 * 2;
constexpr size_t WS_XN = 98 * MiB, WS_S = 164 * MiB, WS_Q = 197 * MiB, WS_K = 296 * MiB, WS_V = 395 * MiB, WS_END = 461 * MiB;
static_assert(WS_WMLA + 2 * MLA_W_STRIDE <= WS_WNA && WS_XN + (size_t)TOK * DM * 2 <= WS_S && WS_S + (size_t)TOK * 512 * 2 <= WS_Q, "ws map");
static_assert(WS_Q + (size_t)TOK * 1536 * 2 <= WS_K && WS_K + (size_t)TOK * 8 * 192 * 2 <= WS_V && WS_V + (size_t)TOK * DM * 2 <= WS_END, "ws map 2");
static_assert(WS_Q + (size_t)TOK * 3072 * 2 <= WS_V && WS_Q + (size_t)TOK * DFF * 2 <= WS_V, "overlays");
constexpr int LDS_BYTES = 147456, NWAVES = 8, NTHREADS = 512;
constexpr float NORM_EPS = 1e-6f;

struct WDesc { const float* src; bf16_t* dst; int K, N, Np, kind, first, pad; };
constexpr int NWD = 20;
struct Params {
  const float* in[24]; float* out; unsigned char* ws;
  int nph, lo, hi, nitems;
  unsigned char prog[64];
  WDesc wd[NWD];
};

__device__ __forceinline__ unsigned f2bf(float f) { unsigned u = __builtin_bit_cast(unsigned, f); return (u + 0x7fffu + ((u >> 16) & 1u)) >> 16; }
__device__ __forceinline__ unsigned pk2(float lo, float hi) { return f2bf(lo) | (f2bf(hi) << 16); }
__device__ __forceinline__ float bf2f(unsigned short b) { return __builtin_bit_cast(float, (unsigned)b << 16); }
__device__ __forceinline__ float wave_sum(float v, int lane) {
#pragma unroll
  for (int o = 1; o < 64; o <<= 1) v += __builtin_bit_cast(float, __builtin_amdgcn_ds_bpermute((lane ^ o) << 2, __builtin_bit_cast(int, v)));
  return v;
}
__device__ __forceinline__ int srccol(int kind, int np) {
  switch (kind) {
    case 1: { const int grp = np >> 3, w = np & 7; return (w < 4) ? grp * 4 + w : DFF + grp * 4 + (w - 4); }
    case 2: { if (np < 512) return np; if (np < 576) { const int q = np - 512; return 512 + (q >> 1) + 32 * (q & 1); } return -1; }
    case 3: { const int h = np / 192, w = np % 192; if (w < 128) return np; const int q = w - 128; return h * 192 + 128 + (q >> 1) + 32 * (q & 1); }
    case 4: { if (np >= 1152) return np; const int hh = np >> 6, q = np & 63; return hh * 64 + (q >> 1) + 32 * (q & 1); }
    default: return np;
  }
}
__device__ __forceinline__ void transpose_item(const WDesc& d, LAS float* scr, int item, int lane) {
  const int nblk = d.Np / 32, kb = item / nblk, nb = item % nblk, k0 = 64 * kb, n0 = 32 * nb;
  const int sc = srccol(d.kind, n0 + (lane & 31));
#pragma unroll 8
  for (int i = 0; i < 32; ++i) { const int kk = 2 * i + (lane >> 5); scr[kk * 33 + (lane & 31)] = (sc >= 0) ? d.src[(size_t)(k0 + kk) * d.N + sc] : 0.f; }
  asm volatile("s_waitcnt lgkmcnt(0)" ::: "memory");
  const int c = lane & 7;
#pragma unroll
  for (int j = 0; j < 4; ++j) { const int n = (lane >> 3) + 8 * j; const LAS float* s = scr + (8 * c) * 33 + n;
    u32x4 o; o.x = pk2(s[0 * 33], s[1 * 33]); o.y = pk2(s[2 * 33], s[3 * 33]); o.z = pk2(s[4 * 33], s[5 * 33]); o.w = pk2(s[6 * 33], s[7 * 33]);
    *(u32x4*)(d.dst + (size_t)(n0 + n) * d.K + k0 + 8 * c) = o; }
  asm volatile("s_waitcnt lgkmcnt(0)" ::: "memory");
}
__device__ __forceinline__ float* xrow(const Params& P, int row) { return row < NLAT ? P.out + (size_t)row * DM : (float*)(P.ws + WS_XCTX) + (size_t)(row - NLAT) * DM; }
__device__ __forceinline__ const float* modvec(const Params& P, int layer, int row, int which) {
  const int r = row < NLAT ? (row >> 13) : 4; return (const float*)(P.ws + WS_MOD) + ((size_t)(layer * 5 + r) * 6 + which) * DM;
}
template <bool INIT> __device__ __forceinline__ void row_pass(const Params& P, int row, int lane, const bf16_t* src, const float* g_post, const float* gate,
                                                             bool do_norm, const float* g_pre, const float* shift, const float* scale) {
  f32x4 v[4];
  float* xr = xrow(P, row);
  if constexpr (INIT) { const float* s = row < NLAT ? P.in[0] + (size_t)row * DM : P.in[2] + (size_t)(row - NLAT) * DM;
#pragma unroll
    for (int j = 0; j < 4; ++j) { v[j] = *(const f32x4*)(s + 4 * lane + 256 * j); *(f32x4*)(xr + 4 * lane + 256 * j) = v[j]; }
  } else {
    f32x4 a[4]; float ss = 0.f;
#pragma unroll
    for (int j = 0; j < 4; ++j) { const u32x2 w = *(const u32x2*)(src + (size_t)row * DM + 4 * lane + 256 * j);
      a[j][0] = __builtin_bit_cast(float, w.x << 16); a[j][1] = __builtin_bit_cast(float, w.x & 0xffff0000u); a[j][2] = __builtin_bit_cast(float, w.y << 16); a[j][3] = __builtin_bit_cast(float, w.y & 0xffff0000u);
      ss += (a[j][0] * a[j][0] + a[j][1] * a[j][1]) + (a[j][2] * a[j][2] + a[j][3] * a[j][3]); }
    const float rstd = 1.0f / sqrtf(wave_sum(ss, lane) * (1.0f / DM) + NORM_EPS);
#pragma unroll
    for (int j = 0; j < 4; ++j) { const int c = 4 * lane + 256 * j; const f32x4 x = *(const f32x4*)(xr + c), g = *(const f32x4*)(g_post + c), gt = *(const f32x4*)(gate + c);
      v[j] = x + gt * (a[j] * rstd * g); *(f32x4*)(xr + c) = v[j]; }
  }
  if (do_norm) {
    float ss = 0.f;
#pragma unroll
    for (int j = 0; j < 4; ++j) ss += (v[j][0] * v[j][0] + v[j][1] * v[j][1]) + (v[j][2] * v[j][2] + v[j][3] * v[j][3]);
    const float rstd = 1.0f / sqrtf(wave_sum(ss, lane) * (1.0f / DM) + NORM_EPS);
    bf16_t* xn = (bf16_t*)(P.ws + WS_XN) + (size_t)row * DM;
#pragma unroll
    for (int j = 0; j < 4; ++j) { const int c = 4 * lane + 256 * j; const f32x4 g = *(const f32x4*)(g_pre + c), sh = *(const f32x4*)(shift + c), sc = *(const f32x4*)(scale + c);
      const f32x4 h = (v[j] * rstd * g) * (1.0f + sc) + sh; u32x2 w; w.x = pk2(h[0], h[1]); w.y = pk2(h[2], h[3]); *(u32x2*)(xn + c) = w; }
  }
}

typedef const __attribute__((address_space(4))) Params* KargPtr;
__global__ void __launch_bounds__(NTHREADS, 2) fwd_mega(Params Pbyval) {
  extern __shared__ __attribute__((aligned(16))) unsigned char lds[];
  cg::grid_group grid = cg::this_grid();
  volatile LAS unsigned* bst = (volatile LAS unsigned*)((LAS unsigned char*)lds + (LDS_BYTES - 64));
  if (threadIdx.x < 2) bst[threadIdx.x] = 0u;
  __syncthreads();
  XcdBarrier xbar = xcd_barrier_post((unsigned*)(Pbyval.ws + WS_BAR), bst);
  const int G0 = gridDim.x, bx0 = blockIdx.x;
  const int ph_lo = Pbyval.lo, ph_hi = Pbyval.hi;

  int rep = 0; (void)rep;
#ifdef PROBE_EXTRA_SYNCS
  for (int i = 0; i < PROBE_EXTRA_SYNCS; ++i) grid.sync();
#endif
  for (int ph = ph_lo; ph < ph_hi; ++ph) {
    int tid = threadIdx.x; asm volatile("" : "+v"(tid));
    int G = G0, bx = bx0; asm volatile("" : "+s"(G), "+s"(bx));
    KargPtr Pq = (KargPtr)__builtin_amdgcn_kernarg_segment_ptr(); asm volatile("" : "+s"(Pq));
    const Params& P = *(const Params*)Pq;
    const int vcu = (G % 8 == 0) ? (bx % 8) * (G / 8) + bx / 8 : bx;
    const int NGW = G * NWAVES;
    const int lane = tid & 63, wave = __builtin_amdgcn_readfirstlane(tid >> 6), gw = vcu * NWAVES + wave;
    unsigned char* ws = P.ws;
    const float* rope = (const float*)(ws + WS_ROPE);
    bf16_t* XN = (bf16_t*)(ws + WS_XN); bf16_t* SB = (bf16_t*)(ws + WS_S); bf16_t* QB = (bf16_t*)(ws + WS_Q); bf16_t* KB = (bf16_t*)(ws + WS_K); bf16_t* VB = (bf16_t*)(ws + WS_V);
    const int code = P.prog[ph], l = code >> 4, step = code & 15, kind = l % 3, jl = l / 3; const bool last = (l == DEPTH - 1);
    if (step == 0) {
      { LAS float* sc_l = (LAS float*)lds;
        LAS float* red = sc_l + 5 * DM;
        for (int i = tid; i < 5 * DM; i += NTHREADS) { const int r = i >> 10, k = i & 1023; const float c = (r < 4) ? P.in[1][r * DM + k] : P.in[3][k]; sc_l[i] = c / (1.0f + __expf(-c)); }
        __syncthreads();
        for (int task = bx; task < DEPTH * 96; task += G) { const int ly = task / 96, n0 = (task % 96) * 64;
          const float* W = P.in[4] + (size_t)ly * DM * 6 * DM + n0 + lane; float acc[5] = {0.f, 0.f, 0.f, 0.f, 0.f};
#pragma unroll 8
          for (int k = wave * 128; k < wave * 128 + 128; ++k) { const float w = W[(size_t)k * 6 * DM];
#pragma unroll
            for (int r = 0; r < 5; ++r) acc[r] += sc_l[r * DM + k] * w; }
#pragma unroll
          for (int r = 0; r < 5; ++r) red[(wave * 5 + r) * 64 + lane] = acc[r];
          __syncthreads();
          if (tid < 320) { const int r = tid >> 6, n = tid & 63; float s = P.in[5][(size_t)ly * 6 * DM + n0 + n];
#pragma unroll
            for (int w = 0; w < 8; ++w) s += red[(w * 5 + r) * 64 + n];
            const int col = n0 + n; ((float*)(ws + WS_MOD))[((size_t)(ly * 5 + r) * 6 + (col >> 10)) * DM + (col & 1023)] = s; }
          __syncthreads(); }
      }
      { LAS float* scr = (LAS float*)lds + wave * (64 * 33);
        for (int it = gw; it < P.nitems; it += NGW) { int m = 0;
#pragma unroll 1
          for (int q = 1; q < NWD; ++q) if (it >= P.wd[q].first) m = q;
          transpose_item(P.wd[m], scr, it - P.wd[m].first, lane); } }
      for (int i = bx * NTHREADS + tid; i < SEQ * 32; i += G * NTHREADS) { const int t = i >> 5, p = i & 31; const float inv = powf(10000.0f, -(float)(p & 15) / 16.0f);
        const float ang = (float)((p < 16) ? (t >> 6) : (t & 63)) * inv; ((float*)(ws + WS_ROPE))[2 * i] = cosf(ang); ((float*)(ws + WS_ROPE))[2 * i + 1] = sinf(ang); }
    } else if (step == 1) {
      for (int row = gw; row < TOK; row += NGW)
        row_pass<true>(P, row, lane, nullptr, nullptr, nullptr, true, P.in[6], modvec(P, 0, row, 0), modvec(P, 0, row, 1));
    } else if (step == 2 || step == 4 || step == 6 || step == 8 || step == 9) {
      const int ng = (step == 4) ? 2 : 1;
      for (int gi = 0; gi < ng; ++gi) {
        pg8::Gemm g; pg8::EpiArgs ea; ea.rope = rope; ea.o1 = nullptr; ea.ldc = DM; ea.kind = 0; ea.o0 = nullptr;
        const unsigned char* wm = ws + WS_WMLA + (size_t)jl * MLA_W_STRIDE;
        g.M = (last && step >= 6) ? NLAT : TOK;
        if (step == 2) { g.A = XN; g.K = DM;
          if (kind == 0) { g.Bt = (const bf16_t*)wm; g.N = 768; ea.kind = 0; ea.o0 = VB; ea.ldc = 768; }
          else if (kind == 1) { g.Bt = (const bf16_t*)(ws + WS_WNA); g.N = 3072; ea.kind = 0; ea.o0 = QB; ea.ldc = 3072; }
          else { g.Bt = (const bf16_t*)(ws + WS_WSWA); g.N = 1280; ea.kind = 4; ea.o0 = QB; }
        } else if (step == 4) { g.K = 256;
          if (gi == 0) { g.A = SB; g.Bt = (const bf16_t*)(wm + MLA_OFF_UQ); g.N = 1536; ea.kind = 2; ea.o0 = QB; }
          else { g.A = SB + (size_t)TOK * 256; g.Bt = (const bf16_t*)(wm + MLA_OFF_UKV); g.N = 2048; ea.kind = 3; ea.o0 = KB; ea.o1 = VB; }
        } else if (step == 6) { g.A = XN; g.K = DM; g.N = DM; ea.kind = 0; ea.o0 = VB; ea.ldc = DM;
          g.Bt = (kind == 0) ? (const bf16_t*)(wm + MLA_OFF_WO) : (kind == 1) ? (const bf16_t*)(ws + WS_WNA + (size_t)3072 * 1024 * 2) : (const bf16_t*)(ws + WS_WSWA + (size_t)1280 * 1024 * 2);
        } else if (step == 8) { g.A = XN; g.K = DM; g.N = 2 * DFF; g.Bt = (const bf16_t*)(ws + WS_WFI) + (size_t)l * 2 * DFF * DM; ea.kind = 1; ea.o0 = QB; }
        else { g.A = QB; g.K = DFF; g.N = DM; g.Bt = (const bf16_t*)(ws + WS_WFO) + (size_t)l * DM * DFF; ea.kind = 0; ea.o0 = VB; ea.ldc = DM; }
        pg8::StaticOrder S; S.init(g.M, g.N, G, bx); pg8::EpiGen E{ea};
#ifndef DBG_NO_GEMM
        pg8::gemm_phase<pg8::EpiGen, pg8::StaticOrder, true, true>((LAS unsigned char*)lds, g, S, E, tid);
#endif
        __syncthreads();
      }
    } else if (step == 3) {
      const bf16_t* A1 = VB; const float* gq = P.in[13] + jl * 256; const float* gkv = P.in[15] + jl * 256;
      for (int row = gw; row < TOK; row += NGW) {
        const bf16_t* a = A1 + (size_t)row * 768;
#pragma unroll
        for (int part = 0; part < 2; ++part) { const u32x2 w = *(const u32x2*)(a + part * 256 + 4 * lane);
          float x[4] = {__builtin_bit_cast(float, w.x << 16), __builtin_bit_cast(float, w.x & 0xffff0000u), __builtin_bit_cast(float, w.y << 16), __builtin_bit_cast(float, w.y & 0xffff0000u)};
          const float ss = wave_sum((x[0] * x[0] + x[1] * x[1]) + (x[2] * x[2] + x[3] * x[3]), lane); const float rstd = 1.0f / sqrtf(ss * (1.0f / 256.0f) + NORM_EPS);
          const f32x4 g = *(const f32x4*)((part ? gkv : gq) + 4 * lane); u32x2 o; o.x = pk2(x[0] * rstd * g[0], x[1] * rstd * g[1]); o.y = pk2(x[2] * rstd * g[2], x[3] * rstd * g[3]);
          *(u32x2*)(SB + (size_t)part * TOK * 256 + (size_t)row * 256 + 4 * lane) = o; }
        if (lane < 32) { const unsigned w = *(const unsigned*)(a + 512 + 2 * lane); float x1 = __builtin_bit_cast(float, w << 16), x2 = __builtin_bit_cast(float, w & 0xffff0000u);
          int b, key;
          if (row < NLAT) { const int t = row & (SEQ - 1); const float c = rope[(t * 32 + lane) * 2], s = rope[(t * 32 + lane) * 2 + 1]; const float y1 = x1 * c - x2 * s, y2 = x2 * c + x1 * s; x1 = y1; x2 = y2; b = row >> 13; key = LC + t; }
          else { const int r2 = row - NLAT; b = r2 >> 8; key = r2 & 255; }
          const unsigned o = pk2(x1, x2);
#pragma unroll
          for (int h = 0; h < 8; ++h) *(unsigned*)(KB + ((size_t)(b * 8 + h) * MLA_KEYS + key) * 192 + 128 + 2 * lane) = o; }
      }
    } else if (step == 5) {
      float* bias_l = (float*)(lds + 135168);
      if (kind == 0) {
        const int nun = last ? 1024 : 1056;
        for (int id = vcu; id < nun; id += G) { att::UnitP u; u.m0 = -1e30f; u.l0 = 0.f; u.a0 = 0; u.a1 = 0;
          int bh, row0; if (id < 1024) { bh = id >> 5; row0 = (bh >> 3) * SEQ + (id & 31) * 256; u.NT = 4 + SEQ / 64; } else { bh = id - 1024; row0 = NLAT + (bh >> 3) * LC; u.NT = 4; }
          const int h = bh & 7; const bf16_t* Kbh = KB + (size_t)bh * MLA_KEYS * 192; const bf16_t* Vbh = VB + (size_t)bh * MLA_KEYS * 128;
          u.Q = QB + (size_t)row0 * 1536 + h * 192; u.Kc = Kbh; u.Vc = Vbh; u.Kn = Kbh + (size_t)LC * 192; u.Vn = Vbh + (size_t)LC * 128; u.O = XN + (size_t)row0 * DM + h * 128;
#ifndef DBG_NO_ATT0
          att::attn_unit<192, 128, 1536, 192, 128, 0, MLA_SDEPTH, true>(u, (char*)lds, bias_l, tid);
#endif
        }
      } else if (kind == 1) {
        const float* rpb = P.in[19] + (size_t)jl * 16 * 465;
        const int nun = last ? 2048 : 2112;
        for (int id = vcu; id < nun; id += G) { att::UnitP u; u.m0 = -1e30f; u.l0 = 0.f;
          int bh, row0, qb = 0; if (id < 2048) { bh = id >> 5; qb = id & 31; row0 = (bh >> 4) * SEQ + qb * 256; u.NT = 16; } else { bh = id - 2048; row0 = NLAT + (bh >> 4) * LC; u.NT = 4; }
          const int b = bh >> 4, h = bh & 15; const int R0 = qb * 4, KR0 = min(max(R0 - 4, 0), 116); u.a0 = R0; u.a1 = KR0;
          u.Q = QB + (size_t)row0 * 3072 + h * 64; u.Kc = QB + (size_t)(NLAT + b * LC) * 3072 + 1024 + h * 64; u.Vc = u.Kc + 1024;
          u.Kn = QB + (size_t)(b * SEQ + KR0 * 64) * 3072 + 1024 + h * 64; u.Vn = u.Kn + 1024; u.O = XN + (size_t)row0 * DM + h * 64;
          for (int i = tid; i < 465; i += NTHREADS) bias_l[i] = rpb[h * 465 + i] * 8.0f;
          __syncthreads();
#ifndef DBG_NO_ATT1
          att::attn_unit<64, 64, 3072, 3072, 3072, 1, 2, false>(u, (char*)lds, bias_l, tid);
#endif
        }
      } else {
        const float* sink = P.in[22] + (size_t)jl * 16;
        const int nun = last ? 2048 : 2112;
        for (int id = vcu; id < nun; id += G) { att::UnitP u; u.a1 = 0;
          int bh, row0, qb = 0; if (id < 2048) { bh = id >> 5; qb = id & 31; row0 = (bh >> 4) * SEQ + qb * 256; u.NT = 12; } else { bh = id - 2048; row0 = NLAT + (bh >> 4) * LC; u.NT = 4; }
          const int b = bh >> 4, h = bh & 15, kvh = h >> 3; u.a0 = qb * 256; u.m0 = sink[h] * 8.0f; u.l0 = 1.0f;
          u.Q = QB + (size_t)row0 * 1280 + h * 64; u.Kc = QB + (size_t)(NLAT + b * LC) * 1280 + 1024 + kvh * 64; u.Vc = u.Kc + 128;
          u.Kn = QB + (size_t)(b * SEQ) * 1280 + 1024 + kvh * 64; u.Vn = u.Kn + 128; u.O = XN + (size_t)row0 * DM + h * 64;
#ifndef DBG_NO_ATT2
          att::attn_unit<64, 64, 1280, 1280, 1280, 2, 2, false>(u, (char*)lds, bias_l, tid);
#endif
        }
      }
    } else if (step == 7) {
      const int nrows = last ? NLAT : TOK;
      for (int row = gw; row < nrows; row += NGW)
        row_pass<false>(P, row, lane, VB, P.in[7] + l * DM, modvec(P, l, row, 2), true, P.in[8] + l * DM, modvec(P, l, row, 3), modvec(P, l, row, 4));
    } else if (step == 10) {
      const int nrows = last ? NLAT : TOK; const int ln = last ? l : l + 1;
      for (int row = gw; row < nrows; row += NGW)
        row_pass<false>(P, row, lane, VB, P.in[9] + l * DM, modvec(P, l, row, 5), !last, P.in[6] + ln * DM, modvec(P, ln, row, 0), modvec(P, ln, row, 1));
    }
#ifdef PROBE_MASK
    if (((PROBE_MASK >> step) & 1) && (PROBE_REPEAT_KIND < 0 || kind == PROBE_REPEAT_KIND) && rep == 0) { rep = 1; grid.sync(); --ph; continue; }
    rep = 0;
#endif
    if (ph + 1 < ph_hi) { if (ph == ph_lo) grid.sync(); else xcd_barrier(xbar); }
  }
}

#ifndef N_LAUNCH_SPLIT
#define N_LAUNCH_SPLIT 0
#endif
extern "C" void kernel_launch(void* const* d_in, const int* in_sizes, int n_in, void* d_out, int out_size, void* d_ws, size_t ws_size, hipStream_t stream) {
  static int grid = 0;
  if (grid == 0) {
    if (n_in != 24 || out_size != NLAT * DM || ws_size < WS_END) { fprintf(stderr, "kernel_launch: unexpected shapes n_in %d out %d ws %zu (need %zu)\n", n_in, out_size, ws_size, (size_t)WS_END); grid = -1; return; }
    int dev = 0, cus = 0, per_cu = 0;
    hipGetDevice(&dev); hipDeviceGetAttribute(&cus, hipDeviceAttributeMultiprocessorCount, dev);
    if (hipFuncSetAttribute((const void*)fwd_mega, hipFuncAttributeMaxDynamicSharedMemorySize, LDS_BYTES) != hipSuccess) { fprintf(stderr, "kernel_launch: hipFuncSetAttribute failed\n"); grid = -1; return; }
    if (hipOccupancyMaxActiveBlocksPerMultiprocessor(&per_cu, (const void*)fwd_mega, NTHREADS, LDS_BYTES) != hipSuccess || per_cu < 1) { fprintf(stderr, "kernel_launch: occupancy query says %d\n", per_cu); per_cu = 1; }
    (void)hipGetLastError();
    grid = cus * 1;
    fprintf(stderr, "kernel_launch: grid %d (cus %d, per_cu %d)\n", grid, cus, per_cu);
  }
  if (grid < 0) return;
  Params p{};
  for (int i = 0; i < 24; ++i) p.in[i] = (const float*)d_in[i];
  p.out = (float*)d_out; p.ws = (unsigned char*)d_ws;
  int n = 0; p.prog[n++] = 0; p.prog[n++] = 1;
  for (int l = 0; l < DEPTH; ++l) { const int kind = l % 3; const int steps_mla[9] = {2, 3, 4, 5, 6, 7, 8, 9, 10}, steps_o[7] = {2, 5, 6, 7, 8, 9, 10};
    if (kind == 0) for (int s = 0; s < 9; ++s) p.prog[n++] = (unsigned char)((l << 4) | steps_mla[s]); else for (int s = 0; s < 7; ++s) p.prog[n++] = (unsigned char)((l << 4) | steps_o[s]); }
  p.nph = n;
  unsigned char* ws = (unsigned char*)d_ws; int q = 0, first = 0;
  auto add = [&](const float* src, size_t dst_off, int K, int N, int Np, int kind) { WDesc& d = p.wd[q++]; d.src = src; d.dst = (bf16_t*)(ws + dst_off); d.K = K; d.N = N; d.Np = Np; d.kind = kind; d.first = first; d.pad = 0; first += (K / 64) * (Np / 32); };
  for (int l = 0; l < DEPTH; ++l) add(p.in[10] + (size_t)l * DM * 2 * DFF, WS_WFI + (size_t)l * 2 * DFF * DM * 2, DM, 2 * DFF, 2 * DFF, 1);
  for (int l = 0; l < DEPTH; ++l) add(p.in[11] + (size_t)l * DFF * DM, WS_WFO + (size_t)l * DM * DFF * 2, DFF, DM, DM, 0);
  for (int j = 0; j < 2; ++j) { const size_t b = WS_WMLA + j * MLA_W_STRIDE;
    add(p.in[12] + (size_t)j * DM * 576, b, DM, 576, 768, 2); add(p.in[14] + (size_t)j * 256 * 1536, b + MLA_OFF_UQ, 256, 1536, 1536, 3);
    add(p.in[16] + (size_t)j * 256 * 2048, b + MLA_OFF_UKV, 256, 2048, 2048, 0); add(p.in[17] + (size_t)j * DM * DM, b + MLA_OFF_WO, DM, DM, DM, 0); }
  add(p.in[18], WS_WNA, DM, 3072, 3072, 0); add(p.in[20], WS_WNA + (size_t)3072 * 1024 * 2, DM, DM, DM, 0);
  add(p.in[21], WS_WSWA, DM, 1280, 1280, 4); add(p.in[23], WS_WSWA + (size_t)1280 * 1024 * 2, DM, DM, DM, 0);
  p.nitems = first;
#if N_LAUNCH_SPLIT
  for (int ph = 0; ph < n; ++ph) { p.lo = ph; p.hi = ph + 1; hipLaunchKernelGGL(fwd_mega, dim3(grid), dim3(NTHREADS), LDS_BYTES, stream, p); }
#else
  p.lo = 0; p.hi = n;
  if (hipMemsetAsync((char*)d_ws + WS_BAR, 0, BAR_BYTES, stream) != hipSuccess) { fprintf(stderr, "kernel_launch: memset failed\n"); return; }
  void* args[] = {&p};
  hipError_t e = hipLaunchCooperativeKernel((const void*)fwd_mega, dim3(grid), dim3(NTHREADS), args, LDS_BYTES, stream);
  if (e != hipSuccess) fprintf(stderr, "kernel_launch: cooperative launch failed: %s (grid %d)\n", hipGetErrorString(e), grid);
#endif
}
```

```cpp
#include <hip/hip_runtime.h>
#include <hip/hip_cooperative_groups.h>
#include <cstdio>
#include <cstdint>
namespace cg = cooperative_groups;

constexpr int DM = 1024, NBATCH = 4, SEQ = 8192, NLAT = NBATCH * SEQ, LC = 256, NCTX = NBATCH * LC, TOK = NLAT + NCTX, DFF = 2816, DEPTH = 4;
constexpr int MLA_KEYS = SEQ + LC;
#ifndef MLA_SDEPTH
#define MLA_SDEPTH 1
#endif
#ifndef MLA_SERIAL
#define MLA_SERIAL false
#endif
namespace pg8 {
#define PG8_LAS __attribute__((address_space(3)))
typedef unsigned short bf16_t;
typedef short bf16x8 __attribute__((ext_vector_type(8)));
typedef float f32x4 __attribute__((ext_vector_type(4)));
typedef unsigned u32x4 __attribute__((ext_vector_type(4)));
constexpr int BM = 256, BK = 64, HALF = 128, HTB = HALF * BK * 2  , STAGE_BYTES = 8 * HTB, NXCD = 8, WGM = 8;

__host__ __device__ __forceinline__ int lds_byte(int r, int c) { const int st = (r >> 4) * 2 + (c >> 5), rr = r & 15, cc = c & 31, ob = rr * 64 + cc * 2; return st * 1024 + (ob ^ (((ob >> 9) & 1) << 5)); }
__host__ __device__ __forceinline__ void stage_rc(int b, int& R, int& C) { const int st = b / 1024, sb = b % 1024, swz = sb ^ (((sb >> 9) & 1) << 5); R = (st >> 1) * 16 + swz / 64; C = (st & 1) * 32 + (swz % 64) / 2; }
__host__ __device__ __forceinline__ int perm32(int rho) { const int n = rho >> 4, i = rho & 15; return 8 * (i >> 2) + 4 * n + (i & 3); }

struct Unit { int pm, pn; };
struct Gemm { const bf16_t* A; const bf16_t* Bt; int M, N, K; };

struct StaticOrder {
    int nM, nN, nwg, G, c;
    __host__ __device__ void init(int M, int N, int G_, int c_) { nM = M / BM; nN = N / BM; nwg = nM * nN; G = G_; c = c_; }
    __host__ __device__ bool next(int i, Unit& u) const {
        const long L = (long)i * G + c; if (L >= nwg) return false;
        int wgid = (int)L; { const int q = nwg / NXCD, r = nwg % NXCD, xcd = wgid % NXCD, off = wgid / NXCD; wgid = (xcd < r ? xcd * (q + 1) : r * (q + 1) + (xcd - r) * q) + off; }
        const int nig = WGM * nN, gid = wgid / nig, fm = gid * WGM, gsz = (nM - fm) < WGM ? (nM - fm) : WGM;
        u.pm = fm + ((wgid % nig) % gsz); u.pn = (wgid % nig) / gsz; return true;
    }
    __device__ __forceinline__ void a_ready(const Unit&) const {}
    __device__ __forceinline__ void done(const Unit&) const {}
};

__device__ __forceinline__ unsigned cvt_pk_bf16(float lo, float hi) { unsigned r; asm volatile("v_cvt_pk_bf16_f32 %0, %1, %2" : "=v"(r) : "v"(lo), "v"(hi)); return r; }
typedef float f32x2 __attribute__((ext_vector_type(2)));
struct EpiArgs { int kind; int ldc; bf16_t* o0; bf16_t* o1; const float* rope; };
__device__ __forceinline__ u32x4 pack8(const f32x4& v0, const f32x4& v1) { u32x4 w; w.x = cvt_pk_bf16(v0[0], v0[1]); w.y = cvt_pk_bf16(v0[2], v0[3]); w.z = cvt_pk_bf16(v1[0], v1[1]); w.w = cvt_pk_bf16(v1[2], v1[3]); return w; }
__device__ __forceinline__ void rope8(f32x4& v0, f32x4& v1, const float* rp) {
    const f32x4 a = *(const f32x4*)rp, b = *(const f32x4*)(rp + 4);
    const f32x4 x0 = v0, x1 = v1;
    v0[0] = x0[0] * a[0] - x0[1] * a[1]; v0[1] = x0[1] * a[0] + x0[0] * a[1];
    v0[2] = x0[2] * a[2] - x0[3] * a[3]; v0[3] = x0[3] * a[2] + x0[2] * a[3];
    v1[0] = x1[0] * b[0] - x1[1] * b[1]; v1[1] = x1[1] * b[0] + x1[0] * b[1];
    v1[2] = x1[2] * b[2] - x1[3] * b[3]; v1[3] = x1[3] * b[2] + x1[2] * b[3];
}
template <int KIND> __device__ __forceinline__ void emit8(const EpiArgs& a, int row, int col, f32x4 v0, f32x4 v1) {
    if constexpr (KIND == 0) { *(u32x4*)(a.o0 + (size_t)row * a.ldc + col) = pack8(v0, v1); }
    else if constexpr (KIND == 1) {
        float r[4];
#pragma unroll
        for (int i = 0; i < 4; ++i) { const float g = v0[i]; r[i] = g * v1[i] * __builtin_amdgcn_rcpf(1.0f + __builtin_amdgcn_exp2f(-g * 1.4426950408889634f)); }
        typedef unsigned u32x2 __attribute__((ext_vector_type(2))); u32x2 w; w.x = cvt_pk_bf16(r[0], r[1]); w.y = cvt_pk_bf16(r[2], r[3]);
        *(u32x2*)(a.o0 + (size_t)row * DFF + (col >> 1)) = w; }
    else if constexpr (KIND == 2) {
        const int within = col % 192;
        if (within >= 128 && row < NLAT) rope8(v0, v1, a.rope + ((size_t)(row & (SEQ - 1)) * 32 + ((within - 128) >> 1)) * 2);
        *(u32x4*)(a.o0 + (size_t)row * 1536 + col) = pack8(v0, v1); }
    else if constexpr (KIND == 3) {
        const int h = col >> 8, w = col & 255; int b, key;
        if (row < NLAT) { b = row >> 13; key = LC + (row & (SEQ - 1)); } else { const int r2 = row - NLAT; b = r2 >> 8; key = r2 & 255; }
        const size_t base = (size_t)(b * 8 + h) * MLA_KEYS + key;
        if (w < 128) *(u32x4*)(a.o0 + base * 192 + w) = pack8(v0, v1); else *(u32x4*)(a.o1 + base * 128 + (w - 128)) = pack8(v0, v1); }
    else {
        if (col < 1152 && row < NLAT) rope8(v0, v1, a.rope + ((size_t)(row & (SEQ - 1)) * 32 + ((col & 63) >> 1)) * 2);
        *(u32x4*)(a.o0 + (size_t)row * 1280 + col) = pack8(v0, v1); }
}
struct EpiGen {
    static constexpr bool PERM = true, AFTER_DRAIN = false;
    EpiArgs a;
    template <int KIND> __device__ __forceinline__ void run(const f32x4 (&acc)[2][2][4][2], const Unit& u, int wr, int wc, int fr, int fq) const {
        const int row0 = u.pm * BM + wr * 64 + fr, col0 = u.pn * BM + wc * 32 + 8 * fq;
#pragma unroll
        for (int ai = 0; ai < 2; ++ai)
#pragma unroll
            for (int m = 0; m < 4; ++m)
#pragma unroll
                for (int bj = 0; bj < 2; ++bj) { emit8<KIND>(a, row0 + ai * HALF + m * 16, col0 + bj * HALF, acc[ai][bj][m][0], acc[ai][bj][m][1]); asm volatile("" ::: "memory"); }
    }
    __device__ __forceinline__ void operator()(const f32x4 (&acc)[2][2][4][2], const Unit& u, int wr, int wc, int fr, int fq) const {
        switch (a.kind) { case 0: run<0>(acc, u, wr, wc, fr, fq); break; case 1: run<1>(acc, u, wr, wc, fr, fq); break; case 2: run<2>(acc, u, wr, wc, fr, fq); break;
                          case 3: run<3>(acc, u, wr, wc, fr, fq); break; default: run<4>(acc, u, wr, wc, fr, fq); break; }
    }
};
template <class Epi, class Sched, bool ALIGN_EPI = false, bool SP2 = false>
__device__ __forceinline__ void gemm_phase(PG8_LAS unsigned char* lds, const Gemm g, const Sched& S, const Epi& E, const int tid) {
    const int wid = __builtin_amdgcn_readfirstlane(tid >> 6), lane = tid & 63, wr = wid >> 2, wc = wid & 3, fr = lane & 15, fq = lane >> 4;
    const int K = g.K, nt = K / BK;
    unsigned voffA[2], voffB[2];
#pragma unroll
    for (int i = 0; i < 2; ++i) { int R, C; stage_rc(tid * 16 + i * 8192, R, C); const int Rb = Epi::PERM ? ((R & ~31) + perm32(R & 31)) : R;
        voffA[i] = (unsigned)(R * K + C) * 2u; voffB[i] = (unsigned)(Rb * K + C) * 2u; }
    const size_t kstep = (size_t)(BK * 2);
    const size_t hstep = (size_t)HALF * K * 2;
    const size_t tstep = 2 * hstep;
    const unsigned ldsw = (unsigned)wid * 1024u;
    const int aoff = lds_byte(wr * 64 + fr, fq * 8), boff = lds_byte(wc * 32 + fr, fq * 8);
#define PG8_SA(b, h) (((b) * 2 + (h)) * HTB)
#define PG8_SB(b, h) ((4 + (b) * 2 + (h)) * HTB)
#define PG8_STAGE(bufoff, gbase, voff) do { _Pragma("unroll") for (int _i = 0; _i < 2; ++_i) \
        __builtin_amdgcn_global_load_lds((const unsigned*)((const char*)(gbase) + (voff)[_i]), (PG8_LAS unsigned*)(lds + (bufoff) + ldsw + _i * 8192), 16, 0, 0); } while (0)
#define PG8_LDA(dst, b, h) do { _Pragma("unroll") for (int m = 0; m < 4; ++m) _Pragma("unroll") for (int k = 0; k < 2; ++k) dst[m][k] = *(const PG8_LAS bf16x8*)(lds + PG8_SA(b, h) + aoff + m * 2048 + k * 1024); } while (0)
#define PG8_LDB(dst, b, h) do { _Pragma("unroll") for (int n = 0; n < 2; ++n) _Pragma("unroll") for (int k = 0; k < 2; ++k) dst[n][k] = *(const PG8_LAS bf16x8*)(lds + PG8_SB(b, h) + boff + n * 2048 + k * 1024); } while (0)
#define PG8_MMA(ai, bj, At, Bt) do { __builtin_amdgcn_s_setprio(1); _Pragma("unroll") for (int m = 0; m < 4; ++m) _Pragma("unroll") for (int n = 0; n < 2; ++n) _Pragma("unroll") for (int k = 0; k < 2; ++k) \
        acc[ai][bj][m][n] = __builtin_amdgcn_mfma_f32_16x16x32_bf16(Bt[n][k], At[m][k], acc[ai][bj][m][n], 0, 0, 0); __builtin_amdgcn_s_setprio(0); } while (0)
#define PG8_WAIT_V(n) asm volatile("s_waitcnt vmcnt(" #n ")" ::: "memory")
#define PG8_WAIT_L(n) asm volatile("s_waitcnt lgkmcnt(" #n ")" ::: "memory")
#define PG8_BAR __builtin_amdgcn_s_barrier()
#define PG8_SCHED __builtin_amdgcn_sched_barrier(0)
    Unit cur, nxt; int ui = 0;
    if (!S.next(0, cur)) return;
    f32x4 acc[2][2][4][2];
#pragma unroll
    for (int a = 0; a < 2; ++a)
#pragma unroll
        for (int b = 0; b < 2; ++b)
#pragma unroll
            for (int m = 0; m < 4; ++m)
#pragma unroll
                for (int n = 0; n < 2; ++n) acc[a][b][m][n] = (f32x4){0.f, 0.f, 0.f, 0.f};
    bf16x8 At[4][2], B0[2][2], B1[2][2];
    const char* cA = (const char*)g.A + (size_t)cur.pm * tstep; const char* cB = (const char*)g.Bt + (size_t)cur.pn * tstep;
    S.a_ready(cur);
    if constexpr (SP2) {
        PG8_STAGE(PG8_SB(0, 0), cB, voffB); PG8_STAGE(PG8_SB(0, 1), cB + hstep, voffB); PG8_STAGE(PG8_SA(0, 0), cA, voffA); PG8_STAGE(PG8_SA(0, 1), cA + hstep, voffA);
        if (wr == 1) PG8_BAR;
        PG8_WAIT_V(2); PG8_BAR;
        PG8_STAGE(PG8_SB(1, 0), cB + kstep, voffB); PG8_STAGE(PG8_SA(1, 0), cA + kstep, voffA); PG8_STAGE(PG8_SB(1, 1), cB + hstep + kstep, voffB);
        PG8_WAIT_V(6); PG8_BAR;
    } else {
        PG8_STAGE(PG8_SB(0, 0), cB, voffB); PG8_STAGE(PG8_SA(0, 0), cA, voffA); PG8_STAGE(PG8_SB(0, 1), cB + hstep, voffB); PG8_STAGE(PG8_SA(0, 1), cA + hstep, voffA);
        if (wr == 1) PG8_BAR;
        PG8_WAIT_V(4); PG8_BAR;
        PG8_STAGE(PG8_SB(1, 0), cB + kstep, voffB); PG8_STAGE(PG8_SA(1, 0), cA + kstep, voffA); PG8_STAGE(PG8_SB(1, 1), cB + hstep + kstep, voffB);
        PG8_WAIT_V(6); PG8_BAR;
    }
    for (;;) {
        const bool has_next = S.next(ui + 1, nxt);
        const char* nA = has_next ? (const char*)g.A + (size_t)nxt.pm * tstep : cA; const char* nB = has_next ? (const char*)g.Bt + (size_t)nxt.pn * tstep : cB;
        for (int t = 0; t < nt; t += 2) {
            const bool last = (t == nt - 2);
            const char* a1 = cA + (size_t)(t + 1) * kstep;
            const char* a2 = last ? nA : cA + (size_t)(t + 2) * kstep; const char* b2 = last ? nB : cB + (size_t)(t + 2) * kstep;
            const char* a3 = a2 + kstep; const char* b3 = b2 + kstep;
            if (last && has_next) S.a_ready(nxt);
            if constexpr (SP2) {
            PG8_LDB(B0, 0, 0); PG8_LDB(B1, 0, 1); PG8_SCHED; PG8_LDA(At, 0, 0); PG8_STAGE(PG8_SA(1, 1), a1 + hstep, voffA);
            PG8_WAIT_V(8); PG8_WAIT_L(0); PG8_BAR; PG8_MMA(0, 0, At, B0); PG8_MMA(0, 1, At, B1); PG8_BAR; PG8_SCHED;
            PG8_LDA(At, 0, 1); PG8_STAGE(PG8_SB(0, 0), b2, voffB); PG8_STAGE(PG8_SB(0, 1), b2 + hstep, voffB); PG8_STAGE(PG8_SA(0, 0), a2, voffA);
            PG8_WAIT_V(8); PG8_WAIT_L(0); PG8_BAR; PG8_MMA(1, 0, At, B0); PG8_MMA(1, 1, At, B1); PG8_BAR; PG8_SCHED;
            PG8_LDB(B0, 1, 0); PG8_LDB(B1, 1, 1); PG8_SCHED; PG8_LDA(At, 1, 0); PG8_STAGE(PG8_SA(0, 1), a2 + hstep, voffA);
            PG8_WAIT_V(8); PG8_WAIT_L(0); PG8_BAR; PG8_MMA(0, 0, At, B0); PG8_MMA(0, 1, At, B1); PG8_BAR; PG8_SCHED;
            PG8_LDA(At, 1, 1); PG8_STAGE(PG8_SB(1, 0), b3, voffB); PG8_STAGE(PG8_SB(1, 1), b3 + hstep, voffB); PG8_STAGE(PG8_SA(1, 0), a3, voffA);
            PG8_WAIT_V(8); PG8_WAIT_L(0); PG8_BAR; PG8_MMA(1, 0, At, B0); PG8_MMA(1, 1, At, B1); PG8_BAR; PG8_SCHED;
            } else {
            PG8_LDB(B0, 0, 0); PG8_SCHED; PG8_LDA(At, 0, 0); PG8_STAGE(PG8_SA(1, 1), a1 + hstep, voffA);
            PG8_WAIT_L(8); PG8_BAR; PG8_WAIT_L(0); PG8_MMA(0, 0, At, B0); PG8_BAR; PG8_SCHED;
            PG8_LDB(B1, 0, 1); PG8_STAGE(PG8_SB(0, 0), b2, voffB);
            PG8_BAR; PG8_WAIT_L(0); PG8_MMA(0, 1, At, B1); PG8_BAR;
            PG8_LDA(At, 0, 1); PG8_STAGE(PG8_SA(0, 0), a2, voffA);
            PG8_BAR; PG8_WAIT_L(0); PG8_MMA(1, 0, At, B0); PG8_BAR; PG8_SCHED;
            PG8_STAGE(PG8_SB(0, 1), b2 + hstep, voffB);
            PG8_WAIT_V(6); PG8_BAR; PG8_MMA(1, 1, At, B1); PG8_BAR;
            PG8_LDB(B0, 1, 0); PG8_SCHED; PG8_LDA(At, 1, 0); PG8_STAGE(PG8_SA(0, 1), a2 + hstep, voffA);
            PG8_WAIT_L(8); PG8_BAR; PG8_WAIT_L(0); PG8_MMA(0, 0, At, B0); PG8_BAR; PG8_SCHED;
            PG8_LDB(B1, 1, 1); PG8_STAGE(PG8_SB(1, 0), b3, voffB);
            PG8_BAR; PG8_WAIT_L(0); PG8_MMA(0, 1, At, B1); PG8_BAR;
            PG8_LDA(At, 1, 1); PG8_STAGE(PG8_SA(1, 0), a3, voffA);
            PG8_BAR; PG8_WAIT_L(0); PG8_MMA(1, 0, At, B0); PG8_BAR; PG8_SCHED;
            PG8_STAGE(PG8_SB(1, 1), b3 + hstep, voffB);
            PG8_WAIT_V(6); PG8_BAR; PG8_MMA(1, 1, At, B1); PG8_BAR;
            }
        }
        if constexpr (ALIGN_EPI) { if (wr == 0) PG8_BAR; }
        if constexpr (!Epi::AFTER_DRAIN) { E(acc, cur, wr, wc, fr, fq); S.done(cur); }
        if (!has_next) break;
#pragma unroll
        for (int a = 0; a < 2; ++a)
#pragma unroll
            for (int b = 0; b < 2; ++b)
#pragma unroll
                for (int m = 0; m < 4; ++m)
#pragma unroll
                    for (int n = 0; n < 2; ++n) acc[a][b][m][n] = (f32x4){0.f, 0.f, 0.f, 0.f};
        cur = nxt; cA = nA; cB = nB; ++ui;
        if constexpr (ALIGN_EPI) { if (wr == 1) PG8_BAR; }
    }
    PG8_WAIT_V(0);
    if constexpr (!ALIGN_EPI) { if (wr == 0) PG8_BAR; }
    PG8_BAR;
    if constexpr (Epi::AFTER_DRAIN) { E.fused(acc, cur, wr, wc, fr, fq, lds, wid, lane); S.done(cur); }
#undef PG8_SA
#undef PG8_SB
#undef PG8_STAGE
#undef PG8_LDA
#undef PG8_LDB
#undef PG8_MMA
#undef PG8_WAIT_V
#undef PG8_WAIT_L
#undef PG8_BAR
#undef PG8_SCHED
}
}
namespace att {
using bf16x8 = __attribute__((ext_vector_type(8))) short;
using s16x4  = __attribute__((ext_vector_type(4))) short;
using f32x16 = __attribute__((ext_vector_type(16))) float;
using u32x4  = __attribute__((ext_vector_type(4))) unsigned;
typedef unsigned short bf16_t;
#define SBAR() __builtin_amdgcn_sched_barrier(0)
__device__ __forceinline__ int crow(int r, int hi) { return (r & 3) + 8 * (r >> 2) + 4 * hi; }
__device__ __forceinline__ unsigned cvtpk(float lo, float hi) { unsigned r; asm volatile("v_cvt_pk_bf16_f32 %0, %1, %2" : "=v"(r) : "v"(lo), "v"(hi)); return r; }
template <int DK> __device__ __forceinline__ int kswz(int row, int colB) { return row * (DK * 2) + (colB ^ ((row & 7) << 4)); }

__device__ __forceinline__ void partialSM(f32x16& p0, f32x16& p1, float& m_reg, float& mn, float& alpha, const float C, const float THRS) {
  float pmax = p0[0];
#pragma unroll
  for (int r = 1; r < 16; ++r) pmax = fmaxf(pmax, p0[r]);
#pragma unroll
  for (int r = 0; r < 16; ++r) pmax = fmaxf(pmax, p1[r]);
  { auto rr = __builtin_amdgcn_permlane32_swap(__float_as_uint(pmax), __float_as_uint(pmax), false, false);
    pmax = fmaxf(__uint_as_float(rr[0]), __uint_as_float(rr[1])); }
  if (__builtin_expect(__all(pmax - m_reg <= THRS), 1)) { mn = m_reg; alpha = 1.f; }
  else { mn = fmaxf(m_reg, pmax); alpha = __builtin_amdgcn_exp2f((m_reg - mn) * C); m_reg = mn; }
  const float mnC = -mn * C;
#pragma unroll
  for (int r = 0; r < 16; ++r) p0[r] = fmaf(p0[r], C, mnC);
#pragma unroll
  for (int r = 0; r < 16; ++r) p1[r] = fmaf(p1[r], C, mnC);
#pragma unroll
  for (int r = 0; r < 16; ++r) p0[r] = __builtin_amdgcn_exp2f(p0[r]);
}
__device__ __forceinline__ void finishSM(f32x16& p0, f32x16& p1, float alpha, float& l_reg, bf16x8& pa0, bf16x8& pa1, bf16x8& pa2, bf16x8& pa3) {
#pragma unroll
  for (int r = 0; r < 16; ++r) p1[r] = __builtin_amdgcn_exp2f(p1[r]);
  float ps = 0;
#pragma unroll
  for (int r = 0; r < 16; ++r) ps += p0[r];
#pragma unroll
  for (int r = 0; r < 16; ++r) ps += p1[r];
  { auto rr = __builtin_amdgcn_permlane32_swap(__float_as_uint(ps), __float_as_uint(ps), false, false);
    ps = __uint_as_float(rr[0]) + __uint_as_float(rr[1]); }
  l_reg = l_reg * alpha + ps;
#define PK4(P, BASE, OUT) do { unsigned a0 = cvtpk(P[BASE + 0], P[BASE + 1]), a1 = cvtpk(P[BASE + 2], P[BASE + 3]);   \
    unsigned b0 = cvtpk(P[BASE + 4], P[BASE + 5]), b1 = cvtpk(P[BASE + 6], P[BASE + 7]);                              \
    auto r0 = __builtin_amdgcn_permlane32_swap(a0, b0, false, false); auto r1 = __builtin_amdgcn_permlane32_swap(a1, b1, false, false); \
    u32x4 w = {r0[0], r1[0], r0[1], r1[1]}; OUT = *reinterpret_cast<bf16x8*>(&w); } while (0)
  PK4(p0, 0, pa0); PK4(p0, 8, pa1); PK4(p1, 0, pa2); PK4(p1, 8, pa3);
#undef PK4
}
template <int DK> __device__ __forceinline__ void qkt(f32x16& p0, f32x16& p1, const char* Ks, const bf16x8* qr, const unsigned* kb) {
  p0 = f32x16{}; p1 = f32x16{};
#pragma unroll
  for (int d0 = 0; d0 < DK / 16; ++d0) { const char* a = Ks + kb[d0 & 3];
    const bf16x8 b0 = *reinterpret_cast<const bf16x8*>(a + (d0 >> 2) * 128);
    const bf16x8 b1 = *reinterpret_cast<const bf16x8*>(a + (d0 >> 2) * 128 + 32 * DK * 2);
    p0 = __builtin_amdgcn_mfma_f32_32x32x16_bf16(b0, qr[d0], p0, 0, 0, 0);
    p1 = __builtin_amdgcn_mfma_f32_32x32x16_bf16(b1, qr[d0], p1, 0, 0, 0); }
}
template <int DV> __device__ __forceinline__ int v_st(int k, int c) { const int kk = (k & ~0xC) | ((k & 4) << 1) | ((k & 8) >> 1); return ((kk >> 3) * (DV / 32) + (c >> 5)) * 512 + ((kk & 7) * 32 + (c & 31)) * 2; }
__device__ __forceinline__ int v_rd_base(int lane) { return ((lane & 3) << 3) | (((lane >> 2) & 3) << 6) | (((lane >> 4) & 1) << 5) | (((lane >> 5) & 1) << 8); }
template <int DV> constexpr int v_rd_off(int d0, int ks, int half) { return d0 * 512 + ks * (DV / 32) * 1024 + half * (DV / 32) * 512; }
template <int OFF> __device__ __forceinline__ s16x4 tr_read(int vb) { s16x4 r; asm volatile("ds_read_b64_tr_b16 %0, %1 offset:%2" : "=&v"(r) : "v"(vb), "i"(OFF) : "memory"); return r; }
template <int DV, int D0> __device__ __forceinline__ void pv_one(f32x16& od, int vb, bf16x8 pa0, bf16x8 pa1, bf16x8 pa2, bf16x8 pa3) {
  const s16x4 l0 = tr_read<v_rd_off<DV>(D0, 0, 0)>(vb), h0 = tr_read<v_rd_off<DV>(D0, 0, 1)>(vb), l1 = tr_read<v_rd_off<DV>(D0, 1, 0)>(vb), h1 = tr_read<v_rd_off<DV>(D0, 1, 1)>(vb);
  const s16x4 l2 = tr_read<v_rd_off<DV>(D0, 2, 0)>(vb), h2 = tr_read<v_rd_off<DV>(D0, 2, 1)>(vb), l3 = tr_read<v_rd_off<DV>(D0, 3, 0)>(vb), h3 = tr_read<v_rd_off<DV>(D0, 3, 1)>(vb);
  asm volatile("s_waitcnt lgkmcnt(0)" ::: "memory"); SBAR();
#define PK(L, H) (bf16x8){L[0], L[1], L[2], L[3], H[0], H[1], H[2], H[3]}
  od = __builtin_amdgcn_mfma_f32_32x32x16_bf16(pa0, PK(l0, h0), od, 0, 0, 0);
  od = __builtin_amdgcn_mfma_f32_32x32x16_bf16(pa1, PK(l1, h1), od, 0, 0, 0);
  od = __builtin_amdgcn_mfma_f32_32x32x16_bf16(pa2, PK(l2, h2), od, 0, 0, 0);
  od = __builtin_amdgcn_mfma_f32_32x32x16_bf16(pa3, PK(l3, h3), od, 0, 0, 0);
#undef PK
}
template <int DV> __device__ __forceinline__ void pv_all(f32x16* o, int vb, bf16x8 pa0, bf16x8 pa1, bf16x8 pa2, bf16x8 pa3) {
  pv_one<DV, 0>(o[0], vb, pa0, pa1, pa2, pa3); pv_one<DV, 1>(o[1], vb, pa0, pa1, pa2, pa3);
  if constexpr (DV == 128) { pv_one<DV, 2>(o[2], vb, pa0, pa1, pa2, pa3); pv_one<DV, 3>(o[3], vb, pa0, pa1, pa2, pa3); }
}
struct UnitP {
  const bf16_t* Q;
  const bf16_t *Kc, *Vc, *Kn, *Vn;
  bf16_t* O;
  int NT; float m0, l0; int a0, a1;
};
template <int MODE> __device__ __forceinline__ void apply_mask(f32x16& p0, f32x16& p1, int jj, const UnitP& u, int wid, int r32, int hi, const float* bias_l) {
  const float NEG = -1e30f;
  if constexpr (MODE == 2) {
    const int ks = u.a0 - 128 + 64 * jj; const bool tv = (ks >= 0 && ks < SEQ);
    const int rel0 = -128 + 64 * jj - (wid * 32 + r32);
#pragma unroll
    for (int r = 0; r < 16; ++r) { const int rel = rel0 + crow(r, hi);
      const bool ok0 = tv && rel >= -128 && rel <= 128, ok1 = tv && rel + 32 >= -128 && rel + 32 <= 128;
      p0[r] = ok0 ? p0[r] : NEG; p1[r] = ok1 ? p1[r] : NEG; }
  } else if constexpr (MODE == 1) {
    const int r = u.a0 + (wid >> 1), c = (wid & 1) * 32 + r32, kr = u.a1 + jj;
    const int rs = min(max(r - 4, 0), 120), cs = min(max(c - 8, 0), 48); const bool rok = (kr >= rs && kr < rs + 8);
    const int ib = (kr - r + 7) * 31 - c + 15;
#pragma unroll
    for (int q = 0; q < 16; ++q) { const int k0 = crow(q, hi), k1 = k0 + 32;
      const bool ok0 = rok && k0 >= cs && k0 < cs + 16, ok1 = rok && k1 >= cs && k1 < cs + 16;
      const float b0 = bias_l[ok0 ? ib + k0 : 0], b1 = bias_l[ok1 ? ib + k1 : 0];
      p0[q] = ok0 ? p0[q] + b0 : NEG; p1[q] = ok1 ? p1[q] + b1 : NEG; }
  }
}
template <int DK, int DV, int LDQ, int LDK, int LDV, int MODE, int SDEPTH, bool SERIAL>
__device__ __forceinline__ void attn_unit(const UnitP& u, char* lds, const float* bias_l, const int tid) {
  constexpr float SCALE = (DK == 192) ? 0.07216878364870322f : 0.125f;
  constexpr float C = SCALE * 1.4426950408889634f, THRS = 8.f / SCALE;
  constexpr int SHM_V = 64 * DV * 2, SHM_K = 64 * DK * 2, KC = DK / 64, VC = DV / 64, ND = DK / 16, NO = DV / 32;
  const int wid = tid >> 6, lane = tid & 63, r32 = lane & 31, hi = lane >> 5;
  char* V_lds = lds; char* K_lds = lds + 2 * SHM_V;
  float* ws = (float*)(lds + 2 * SHM_V + 2 * SHM_K) + wid * 64; float* li_l = ws; float* al_l = ws + 32;
  float m_reg = u.m0, l_reg = u.l0; f32x16 o[NO]; bf16x8 qr[ND];
#pragma unroll
  for (int d = 0; d < NO; ++d) o[d] = f32x16{};
  const bf16_t* Qw = u.Q + (long)(wid * 32 + r32) * LDQ + hi * 8;
#pragma unroll
  for (int d0 = 0; d0 < ND; ++d0) qr[d0] = *reinterpret_cast<const bf16x8*>(Qw + d0 * 16);
  const unsigned srow = tid >> 3, sch = tid & 7;
  const unsigned kofs0 = srow * LDK + sch * 8, vofs0 = srow * LDV + sch * 8;
  const unsigned kdst0 = srow * (DK * 2) + ((sch * 16) ^ ((srow & 7) << 4)), vdst0 = (unsigned)v_st<DV>((int)srow, (int)sch * 8);
  const int vb0 = (int)(uintptr_t)V_lds + v_rd_base(lane);
  unsigned kb[4];
#pragma unroll
  for (int e = 0; e < 4; ++e) kb[e] = (unsigned)(r32 * (DK * 2) + ((e * 32 + hi * 16) ^ ((r32 & 7) << 4)));
  struct { bf16x8 k[KC]; bf16x8 v[VC]; } sr_[SDEPTH];
#define TILE_PTRS(j, Kt, Vt) do { if ((j) < 4) { Kt = u.Kc + (long)(j) * 64 * LDK; Vt = u.Vc + (long)(j) * 64 * LDV; } \
    else if (MODE == 2) { int ks_ = u.a0 - 128 + 64 * ((j) - 4); if (ks_ < 0 || ks_ >= SEQ) ks_ = 0; Kt = u.Kn + (long)ks_ * LDK; Vt = u.Vn + (long)ks_ * LDV; } \
    else { Kt = u.Kn + (long)((j) - 4) * 64 * LDK; Vt = u.Vn + (long)((j) - 4) * 64 * LDV; } } while (0)
#define SLOAD(i, j) do { const bf16_t *Kt_, *Vt_; TILE_PTRS(j, Kt_, Vt_); \
    _Pragma("unroll") for (int c = 0; c < VC; ++c) sr_[i].v[c] = *reinterpret_cast<const bf16x8*>(Vt_ + vofs0 + 64 * c); \
    _Pragma("unroll") for (int c = 0; c < KC; ++c) sr_[i].k[c] = *reinterpret_cast<const bf16x8*>(Kt_ + kofs0 + 64 * c); } while (0)
#define SWRITE(b, i) do { _Pragma("unroll") for (int c = 0; c < VC; ++c) *(bf16x8*)(V_lds + (b) * SHM_V + vdst0 + 1024 * c) = sr_[i].v[c]; \
    _Pragma("unroll") for (int c = 0; c < KC; ++c) *(bf16x8*)(K_lds + (b) * SHM_K + kdst0 + 128 * c) = sr_[i].k[c]; } while (0)
#define SWAIT() do { if constexpr (SDEPTH == 2) asm volatile("s_waitcnt vmcnt(%0)" :: "n"(KC + VC) : "memory"); else asm volatile("s_waitcnt vmcnt(0)" ::: "memory"); } while (0)
#define RESC(a) do { if (__any((a) < 1.f)) { if (hi == 0) al_l[r32] = (a); asm volatile("s_waitcnt lgkmcnt(0)" ::: "memory"); \
    _Pragma("unroll") for (int d = 0; d < NO; ++d) _Pragma("unroll") for (int r = 0; r < 16; ++r) o[d][r] *= al_l[crow(r, hi)]; } } while (0)
#define MASK(P0, P1, j) do { if (MODE != 0 && (j) >= 4) apply_mask<MODE>(P0, P1, (j) - 4, u, wid, r32, hi, bias_l); } while (0)
  bf16x8 pa0, pa1, pa2, pa3; const int NT = u.NT;
  if constexpr (SERIAL) {
    f32x16 p0, p1; float mn, al;
    SLOAD(0, 0); asm volatile("s_waitcnt vmcnt(0)" ::: "memory"); SWRITE(0, 0); __syncthreads();
    for (int j = 0; j < NT; ++j) {
      const int b = j & 1;
      if (j + 1 < NT) SLOAD(0, j + 1);
      SBAR(); qkt<DK>(p0, p1, K_lds + b * SHM_K, qr, kb); MASK(p0, p1, j);
      partialSM(p0, p1, m_reg, mn, al, C, THRS); RESC(al);
      finishSM(p0, p1, al, l_reg, pa0, pa1, pa2, pa3); SBAR();
      pv_all<DV>(o, vb0 + b * SHM_V, pa0, pa1, pa2, pa3); SBAR();
      if (j + 1 < NT) SWRITE(b ^ 1, 0);
      __syncthreads();
    }
  } else {
  f32x16 pA0, pA1, pB0, pB1; float mnA, mnB, alA, alB;
  constexpr int SE = 0, SO = SDEPTH - 1;
  SLOAD(SE, 0); asm volatile("s_waitcnt vmcnt(0)" ::: "memory"); SWRITE(0, SE); __syncthreads();
  qkt<DK>(pA0, pA1, K_lds, qr, kb); partialSM(pA0, pA1, m_reg, mnA, alA, C, THRS);
  SLOAD(SO, 1); if constexpr (SDEPTH == 2) { if (2 < NT) SLOAD(SE, 2); }
  SWAIT(); SWRITE(1, SO); __syncthreads();
  for (int j = 1; j + 1 < NT; j += 2) {
    SBAR(); qkt<DK>(pB0, pB1, K_lds + SHM_K, qr, kb); finishSM(pA0, pA1, alA, l_reg, pa0, pa1, pa2, pa3); SBAR();
    SLOAD(SO, j + SDEPTH); SBAR();
    pv_all<DV>(o, vb0, pa0, pa1, pa2, pa3); MASK(pB0, pB1, j); partialSM(pB0, pB1, m_reg, mnB, alB, C, THRS);
    __syncthreads(); SWAIT(); SWRITE(0, SE);
    RESC(alB); __syncthreads();
    SBAR(); qkt<DK>(pA0, pA1, K_lds, qr, kb); finishSM(pB0, pB1, alB, l_reg, pa0, pa1, pa2, pa3); SBAR();
    if (SDEPTH == 1 || j + 3 < NT) SLOAD(SE, j + 1 + SDEPTH); SBAR();
    pv_all<DV>(o, vb0 + SHM_V, pa0, pa1, pa2, pa3); MASK(pA0, pA1, j + 1); partialSM(pA0, pA1, m_reg, mnA, alA, C, THRS);
    __syncthreads(); SWAIT(); SWRITE(1, SO);
    RESC(alA); __syncthreads();
  }
  SBAR(); qkt<DK>(pB0, pB1, K_lds + SHM_K, qr, kb); finishSM(pA0, pA1, alA, l_reg, pa0, pa1, pa2, pa3); SBAR();
  pv_all<DV>(o, vb0, pa0, pa1, pa2, pa3); MASK(pB0, pB1, NT - 1); partialSM(pB0, pB1, m_reg, mnB, alB, C, THRS);
  __syncthreads(); RESC(alB);
  finishSM(pB0, pB1, alB, l_reg, pa0, pa1, pa2, pa3); SBAR();
  pv_all<DV>(o, vb0 + SHM_V, pa0, pa1, pa2, pa3);
  }
  { int t2 = tid; asm volatile("" : "+v"(t2)); const int wid2 = t2 >> 6, lane2 = t2 & 63, r32b = lane2 & 31, hib = lane2 >> 5;
    float* li2 = (float*)(lds + 2 * SHM_V + 2 * SHM_K) + wid2 * 64;
    if (hib == 0) li2[r32b] = l_reg; asm volatile("s_waitcnt lgkmcnt(0)" ::: "memory");
    __syncthreads();
    bf16_t* stg = (bf16_t*)lds + wid2 * 32 * DV;
#pragma unroll
    for (int r = 0; r < 16; ++r) { const int orow = crow(r, hib); const float rl = __builtin_amdgcn_rcpf(li2[orow]);
#pragma unroll
      for (int d0 = 0; d0 < NO; ++d0) { const unsigned w = cvtpk(o[d0][r] * rl, 0.f); stg[orow * DV + d0 * 32 + r32b] = (bf16_t)(w & 0xffffu); } }
    asm volatile("s_waitcnt lgkmcnt(0)" ::: "memory");
    bf16_t* Ow = u.O + (long)(wid2 * 32) * DM;
#pragma unroll
    for (int i = 0; i < (32 * DV / 8) / 64; ++i) { const int id = i * 64 + lane2, row = id / (DV / 8), ch = id % (DV / 8);
      const u32x4 v = *(const u32x4*)(stg + row * DV + ch * 8); *(u32x4*)(Ow + (long)row * DM + ch * 8) = v; } }
  __syncthreads();
#undef TILE_PTRS
#undef SLOAD
#undef SWRITE
#undef SWAIT
#undef RESC
#undef MASK
}
#undef SBAR
}
typedef unsigned short bf16_t;
typedef float f32x4 __attribute__((ext_vector_type(4)));
typedef unsigned u32x4 __attribute__((ext_vector_type(4)));
typedef unsigned u32x2 __attribute__((ext_vector_type(2)));
#define LAS __attribute__((address_space(3)))
#define XB_TMO      128
#define XB_XCNT(j)  (256  + 64 * (j))
#define XB_XSUB(j)  (1280 + 64 * (j))
#define XB_XGEN(j)  (2304 + 64 * (j))
#define XB_TOP      3328
#define XB_TOPGEN   3392
#define XCD_BAR_WORDS 3456
#define XB_SPIN_CAP (1u << 18)

__device__ __forceinline__ unsigned xb_ld(unsigned* p)              { return __hip_atomic_load(p, __ATOMIC_RELAXED, __HIP_MEMORY_SCOPE_AGENT); }
__device__ __forceinline__ unsigned xb_add(unsigned* p, unsigned v) { return __hip_atomic_fetch_add(p, v, __ATOMIC_RELAXED, __HIP_MEMORY_SCOPE_AGENT); }
__device__ __forceinline__ unsigned xb_xcc_id() { return (unsigned)__builtin_amdgcn_s_getreg((3 << 11) | 20) & 0xFu; }
#define XB_SPIN(cond, bar) do { unsigned _sp = 0; while (cond) { __builtin_amdgcn_s_sleep(1); \
    if ((++_sp & 255u) == 0u) { if (xb_ld(&(bar)[XB_TMO])) break; if (_sp > XB_SPIN_CAP) { atomicAdd(&(bar)[XB_TMO], 1u); break; } } } } while (0)

struct XcdBarrier {
    unsigned* bar; unsigned x;
    volatile LAS unsigned* st;
};

__device__ __forceinline__ XcdBarrier xcd_barrier_post(unsigned* bar, volatile LAS unsigned* st) {
    XcdBarrier b; b.bar = bar; b.x = xb_xcc_id(); b.st = st;
    if (threadIdx.x == 0) (void)xb_add(&bar[XB_XCNT(b.x)], 1u);
    return b;
}
__device__ __forceinline__ void xcd_barrier_complete(unsigned* bar, unsigned x, unsigned& nloc, unsigned& nx) {
    const unsigned G = gridDim.x * gridDim.y * gridDim.z;
    unsigned sum, cnt, mine, sp = 0u;
    for (;;) {
        sum = 0u; cnt = 0u; mine = 0u;
#pragma unroll
        for (unsigned j = 0; j < 16; ++j) { const unsigned c = xb_ld(&bar[XB_XCNT(j)]); sum += c; cnt += (c > 0u) ? 1u : 0u; mine = (j == x) ? c : mine; }
        if (sum == G) break;
        __builtin_amdgcn_s_sleep(1);
        if ((++sp & 255u) == 0u) { if (xb_ld(&bar[XB_TMO])) break; if (sp > XB_SPIN_CAP) { atomicAdd(&bar[XB_TMO], 1u); break; } }
    }
    nloc = mine > 0u ? mine : 1u; nx = cnt > 0u ? cnt : 1u;
}

__device__ __forceinline__ void xcd_barrier(const XcdBarrier& b, const int tid) {
    asm volatile("s_waitcnt vmcnt(0)" ::: "memory");
    __syncthreads();
    if (tid == 0) {
        unsigned* bar = b.bar;
        __builtin_amdgcn_s_waitcnt(0);
        unsigned nloc = b.st[0], nx = b.st[1];
        if (nloc == 0u) { xcd_barrier_complete(bar, b.x, nloc, nx); b.st[0] = nloc; b.st[1] = nx; }
        const unsigned old = xb_add(&bar[XB_XSUB(b.x)], 1u);
        const unsigned gen = old / nloc;
        if (old + 1u == (gen + 1u) * nloc) {
            __builtin_amdgcn_fence(__ATOMIC_RELEASE, "agent");
            asm volatile("s_waitcnt vmcnt(0)" ::: "memory");
            const unsigned og = xb_add(&bar[XB_TOP], 1u);
            const unsigned tg = og / nx;
            if (og + 1u == (tg + 1u) * nx) xb_add(&bar[XB_TOPGEN], 1u);
            else XB_SPIN(xb_ld(&bar[XB_TOPGEN]) == tg, bar);
            __builtin_amdgcn_fence(__ATOMIC_ACQUIRE, "agent");
            xb_add(&bar[XB_XGEN(b.x)], 1u);
            asm volatile("s_waitcnt vmcnt(0)" ::: "memory");
        } else {
            XB_SPIN(xb_ld(&bar[XB_XGEN(b.x)]) == gen, bar);
            __builtin_amdgcn_fence(__ATOMIC_ACQUIRE, "agent");
            asm volatile("s_waitcnt vmcnt(0)" ::: "memory");
        }
    }
    __syncthreads();
}

constexpr size_t MiB = 1u << 20;
constexpr size_t WS_BAR = 7 * MiB, BAR_BYTES = 16384;
constexpr size_t WS_MOD = 0, WS_ROPE = 1 * MiB, WS_XCTX = 3 * MiB;
constexpr size_t WS_WFI = 8 * MiB, WS_WFO = 52 * MiB, WS_WMLA = 74 * MiB, WS_WNA = 85 * MiB, WS_WSWA = 93 * MiB;
constexpr size_t MLA_W_STRIDE = (size_t)(768 * 1024 + 1536 * 256 + 2048 * 256 + 1024 * 1024) * 2;
constexpr size_t MLA_OFF_UQ = (size_t)768 * 1024 * 2, MLA_OFF_UKV = MLA_OFF_UQ + (size_t)1536 * 256 * 2, MLA_OFF_WO = MLA_OFF_UKV + (size_t)2048 * 256 * 2;
constexpr size_t WS_XN = 98 * MiB, WS_S = 164 * MiB, WS_Q = 197 * MiB, WS_K = 296 * MiB, WS_V = 395 * MiB, WS_END = 461 * MiB;
static_assert(WS_WMLA + 2 * MLA_W_STRIDE <= WS_WNA && WS_XN + (size_t)TOK * DM * 2 <= WS_S && WS_S + (size_t)TOK * 512 * 2 <= WS_Q, "ws map");
static_assert(WS_Q + (size_t)TOK * 1536 * 2 <= WS_K && WS_K + (size_t)TOK * 8 * 192 * 2 <= WS_V && WS_V + (size_t)TOK * DM * 2 <= WS_END, "ws map 2");
static_assert(WS_Q + (size_t)TOK * 3072 * 2 <= WS_V && WS_Q + (size_t)TOK * DFF * 2 <= WS_V, "overlays");
constexpr int LDS_BYTES = 147456, NWAVES = 8, NTHREADS = 512;
constexpr float NORM_EPS = 1e-6f;

struct WDesc { const float* src; bf16_t* dst; int K, N, Np, kind, first, pad; };
constexpr int NWD = 20;
struct Params {
  const float* in[24]; float* out; unsigned char* ws;
  int nph, lo, hi, nitems;
  unsigned char prog[64];
  WDesc wd[NWD];
};

__device__ __forceinline__ unsigned f2bf(float f) { unsigned u = __builtin_bit_cast(unsigned, f); return (u + 0x7fffu + ((u >> 16) & 1u)) >> 16; }
__device__ __forceinline__ unsigned pk2(float lo, float hi) { return f2bf(lo) | (f2bf(hi) << 16); }
__device__ __forceinline__ float bf2f(unsigned short b) { return __builtin_bit_cast(float, (unsigned)b << 16); }
__device__ __forceinline__ float wave_sum(float v, int lane) {
#pragma unroll
  for (int o = 1; o < 64; o <<= 1) v += __builtin_bit_cast(float, __builtin_amdgcn_ds_bpermute((lane ^ o) << 2, __builtin_bit_cast(int, v)));
  return v;
}
__device__ __forceinline__ int srccol(int kind, int np) {
  switch (kind) {
    case 1: { const int grp = np >> 3, w = np & 7; return (w < 4) ? grp * 4 + w : DFF + grp * 4 + (w - 4); }
    case 2: { if (np < 512) return np; if (np < 576) { const int q = np - 512; return 512 + (q >> 1) + 32 * (q & 1); } return -1; }
    case 3: { const int h = np / 192, w = np % 192; if (w < 128) return np; const int q = w - 128; return h * 192 + 128 + (q >> 1) + 32 * (q & 1); }
    case 4: { if (np >= 1152) return np; const int hh = np >> 6, q = np & 63; return hh * 64 + (q >> 1) + 32 * (q & 1); }
    default: return np;
  }
}
__device__ __forceinline__ void transpose_item(const WDesc& d, LAS float* scr, int item, int lane) {
  const int nblk = d.Np / 32, kb = item / nblk, nb = item % nblk, k0 = 64 * kb, n0 = 32 * nb;
  const int sc = srccol(d.kind, n0 + (lane & 31));
#pragma unroll 8
  for (int i = 0; i < 32; ++i) { const int kk = 2 * i + (lane >> 5); scr[kk * 33 + (lane & 31)] = (sc >= 0) ? d.src[(size_t)(k0 + kk) * d.N + sc] : 0.f; }
  asm volatile("s_waitcnt lgkmcnt(0)" ::: "memory");
  const int c = lane & 7;
#pragma unroll
  for (int j = 0; j < 4; ++j) { const int n = (lane >> 3) + 8 * j; const LAS float* s = scr + (8 * c) * 33 + n;
    u32x4 o; o.x = pk2(s[0 * 33], s[1 * 33]); o.y = pk2(s[2 * 33], s[3 * 33]); o.z = pk2(s[4 * 33], s[5 * 33]); o.w = pk2(s[6 * 33], s[7 * 33]);
    *(u32x4*)(d.dst + (size_t)(n0 + n) * d.K + k0 + 8 * c) = o; }
  asm volatile("s_waitcnt lgkmcnt(0)" ::: "memory");
}
__device__ __forceinline__ float* xrow(const Params& P, int row) { return row < NLAT ? P.out + (size_t)row * DM : (float*)(P.ws + WS_XCTX) + (size_t)(row - NLAT) * DM; }
__device__ __forceinline__ const float* modvec(const Params& P, int layer, int row, int which) {
  const int r = row < NLAT ? (row >> 13) : 4; return (const float*)(P.ws + WS_MOD) + ((size_t)(layer * 5 + r) * 6 + which) * DM;
}
template <bool INIT> __device__ __forceinline__ void row_pass(const Params& P, int row, int lane, const bf16_t* src, const float* g_post, const float* gate,
                                                             bool do_norm, const float* g_pre, const float* shift, const float* scale) {
  f32x4 v[4];
  float* xr = xrow(P, row);
  if constexpr (INIT) { const float* s = row < NLAT ? P.in[0] + (size_t)row * DM : P.in[2] + (size_t)(row - NLAT) * DM;
#pragma unroll
    for (int j = 0; j < 4; ++j) { v[j] = *(const f32x4*)(s + 4 * lane + 256 * j); *(f32x4*)(xr + 4 * lane + 256 * j) = v[j]; }
  } else {
    f32x4 a[4]; float ss = 0.f;
#pragma unroll
    for (int j = 0; j < 4; ++j) { const u32x2 w = *(const u32x2*)(src + (size_t)row * DM + 4 * lane + 256 * j);
      a[j][0] = __builtin_bit_cast(float, w.x << 16); a[j][1] = __builtin_bit_cast(float, w.x & 0xffff0000u); a[j][2] = __builtin_bit_cast(float, w.y << 16); a[j][3] = __builtin_bit_cast(float, w.y & 0xffff0000u);
      ss += (a[j][0] * a[j][0] + a[j][1] * a[j][1]) + (a[j][2] * a[j][2] + a[j][3] * a[j][3]); }
    const float rstd = 1.0f / sqrtf(wave_sum(ss, lane) * (1.0f / DM) + NORM_EPS);
#pragma unroll
    for (int j = 0; j < 4; ++j) { const int c = 4 * lane + 256 * j; const f32x4 x = *(const f32x4*)(xr + c), g = *(const f32x4*)(g_post + c), gt = *(const f32x4*)(gate + c);
      v[j] = x + gt * (a[j] * rstd * g); *(f32x4*)(xr + c) = v[j]; }
  }
  if (do_norm) {
    float ss = 0.f;
#pragma unroll
    for (int j = 0; j < 4; ++j) ss += (v[j][0] * v[j][0] + v[j][1] * v[j][1]) + (v[j][2] * v[j][2] + v[j][3] * v[j][3]);
    const float rstd = 1.0f / sqrtf(wave_sum(ss, lane) * (1.0f / DM) + NORM_EPS);
    bf16_t* xn = (bf16_t*)(P.ws + WS_XN) + (size_t)row * DM;
#pragma unroll
    for (int j = 0; j < 4; ++j) { const int c = 4 * lane + 256 * j; const f32x4 g = *(const f32x4*)(g_pre + c), sh = *(const f32x4*)(shift + c), sc = *(const f32x4*)(scale + c);
      const f32x4 h = (v[j] * rstd * g) * (1.0f + sc) + sh; u32x2 w; w.x = pk2(h[0], h[1]); w.y = pk2(h[2], h[3]); *(u32x2*)(xn + c) = w; }
  }
}

typedef const __attribute__((address_space(4))) Params* KargPtr;
__global__ void __launch_bounds__(NTHREADS, 2) fwd_mega(Params Pbyval) {
  extern __shared__ __attribute__((aligned(16))) unsigned char lds[];
  cg::grid_group grid = cg::this_grid();
  volatile LAS unsigned* bst = (volatile LAS unsigned*)((LAS unsigned char*)lds + (LDS_BYTES - 64));
  if (threadIdx.x < 2) bst[threadIdx.x] = 0u;
  __syncthreads();
  XcdBarrier xbar = xcd_barrier_post((unsigned*)(Pbyval.ws + WS_BAR), bst);
  const int G0 = gridDim.x, bx0 = blockIdx.x;
  const int ph_lo = Pbyval.lo, ph_hi = Pbyval.hi;

  const int wave0 = __builtin_amdgcn_readfirstlane(threadIdx.x >> 6);
  int ph_start = ph_lo;
  if (ph_lo == 0) {
    const int tid = threadIdx.x, lane = tid & 63, wave = wave0, G = G0, bx = bx0;
    const int vcu = (G % 8 == 0) ? (bx % 8) * (G / 8) + bx / 8 : bx, NGW = G * NWAVES, gw = vcu * NWAVES + wave;
    const Params& P = Pbyval; unsigned char* ws = P.ws;
      { LAS float* sc_l = (LAS float*)lds;
        LAS float* red = sc_l + 5 * DM;
        for (int i = tid; i < 5 * DM; i += NTHREADS) { const int r = i >> 10, k = i & 1023; const float c = (r < 4) ? P.in[1][r * DM + k] : P.in[3][k]; sc_l[i] = c / (1.0f + __expf(-c)); }
        __syncthreads();
        for (int task = bx; task < DEPTH * 96; task += G) { const int ly = task / 96, n0 = (task % 96) * 64;
          const float* W = P.in[4] + (size_t)ly * DM * 6 * DM + n0 + lane; float acc[5] = {0.f, 0.f, 0.f, 0.f, 0.f};
#pragma unroll 8
          for (int k = wave * 128; k < wave * 128 + 128; ++k) { const float w = W[(size_t)k * 6 * DM];
#pragma unroll
            for (int r = 0; r < 5; ++r) acc[r] += sc_l[r * DM + k] * w; }
#pragma unroll
          for (int r = 0; r < 5; ++r) red[(wave * 5 + r) * 64 + lane] = acc[r];
          __syncthreads();
          if (tid < 320) { const int r = tid >> 6, n = tid & 63; float s = P.in[5][(size_t)ly * 6 * DM + n0 + n];
#pragma unroll
            for (int w = 0; w < 8; ++w) s += red[(w * 5 + r) * 64 + n];
            const int col = n0 + n; ((float*)(ws + WS_MOD))[((size_t)(ly * 5 + r) * 6 + (col >> 10)) * DM + (col & 1023)] = s; }
          __syncthreads(); }
      }
      { LAS float* scr = (LAS float*)lds + wave * (64 * 33);
        for (int it = gw; it < P.nitems; it += NGW) { int m = 0;
#pragma unroll 1
          for (int q = 1; q < NWD; ++q) if (it >= P.wd[q].first) m = q;
          transpose_item(P.wd[m], scr, it - P.wd[m].first, lane); } }
      for (int i = bx * NTHREADS + tid; i < SEQ * 32; i += G * NTHREADS) { const int t = i >> 5, p = i & 31; const float inv = powf(10000.0f, -(float)(p & 15) / 16.0f);
        const float ang = (float)((p < 16) ? (t >> 6) : (t & 63)) * inv; ((float*)(ws + WS_ROPE))[2 * i] = cosf(ang); ((float*)(ws + WS_ROPE))[2 * i + 1] = sinf(ang); }
    ph_start = 1;
    if (ph_hi > 1) grid.sync();
  }
  int rep = 0; (void)rep;
#ifdef PROBE_EXTRA_SYNCS
  for (int i = 0; i < PROBE_EXTRA_SYNCS; ++i) xcd_barrier(xbar, (int)threadIdx.x);
#endif
  for (int ph = ph_start; ph < ph_hi; ++ph) {
    int lane = (int)__builtin_amdgcn_mbcnt_hi(~0u, __builtin_amdgcn_mbcnt_lo(~0u, 0u)); asm volatile("" : "+v"(lane));
    int wave = wave0; asm volatile("" : "+s"(wave));
    const int tid = wave * 64 + lane;
    int G = G0, bx = bx0; asm volatile("" : "+s"(G), "+s"(bx));
    KargPtr Pq = (KargPtr)__builtin_amdgcn_kernarg_segment_ptr(); asm volatile("" : "+s"(Pq));
    const Params& P = *(const Params*)Pq;
    const int vcu = (G % 8 == 0) ? (bx % 8) * (G / 8) + bx / 8 : bx;
    const int NGW = G * NWAVES;
    const int gw = vcu * NWAVES + wave;
    unsigned char* ws = P.ws;
    const float* rope = (const float*)(ws + WS_ROPE);
    bf16_t* XN = (bf16_t*)(ws + WS_XN); bf16_t* SB = (bf16_t*)(ws + WS_S); bf16_t* QB = (bf16_t*)(ws + WS_Q); bf16_t* KB = (bf16_t*)(ws + WS_K); bf16_t* VB = (bf16_t*)(ws + WS_V);
    const int code = P.prog[ph], l = code >> 4, step = code & 15, kind = l % 3, jl = l / 3; const bool last = (l == DEPTH - 1);
    if (step == 1) {
      for (int row = gw; row < TOK; row += NGW)
        row_pass<true>(P, row, lane, nullptr, nullptr, nullptr, true, P.in[6], modvec(P, 0, row, 0), modvec(P, 0, row, 1));
    } else if (step == 2 || step == 4 || step == 6 || step == 8 || step == 9) {
      const int ng = (step == 4) ? 2 : 1;
      for (int gi = 0; gi < ng; ++gi) {
        pg8::Gemm g; pg8::EpiArgs ea; ea.rope = rope; ea.o1 = nullptr; ea.ldc = DM; ea.kind = 0; ea.o0 = nullptr;
        const unsigned char* wm = ws + WS_WMLA + (size_t)jl * MLA_W_STRIDE;
        g.M = (last && step >= 6) ? NLAT : TOK;
        if (step == 2) { g.A = XN; g.K = DM;
          if (kind == 0) { g.Bt = (const bf16_t*)wm; g.N = 768; ea.kind = 0; ea.o0 = VB; ea.ldc = 768; }
          else if (kind == 1) { g.Bt = (const bf16_t*)(ws + WS_WNA); g.N = 3072; ea.kind = 0; ea.o0 = QB; ea.ldc = 3072; }
          else { g.Bt = (const bf16_t*)(ws + WS_WSWA); g.N = 1280; ea.kind = 4; ea.o0 = QB; }
        } else if (step == 4) { g.K = 256;
          if (gi == 0) { g.A = SB; g.Bt = (const bf16_t*)(wm + MLA_OFF_UQ); g.N = 1536; ea.kind = 2; ea.o0 = QB; }
          else { g.A = SB + (size_t)TOK * 256; g.Bt = (const bf16_t*)(wm + MLA_OFF_UKV); g.N = 2048; ea.kind = 3; ea.o0 = KB; ea.o1 = VB; }
        } else if (step == 6) { g.A = XN; g.K = DM; g.N = DM; ea.kind = 0; ea.o0 = VB; ea.ldc = DM;
          g.Bt = (kind == 0) ? (const bf16_t*)(wm + MLA_OFF_WO) : (kind == 1) ? (const bf16_t*)(ws + WS_WNA + (size_t)3072 * 1024 * 2) : (const bf16_t*)(ws + WS_WSWA + (size_t)1280 * 1024 * 2);
        } else if (step == 8) { g.A = XN; g.K = DM; g.N = 2 * DFF; g.Bt = (const bf16_t*)(ws + WS_WFI) + (size_t)l * 2 * DFF * DM; ea.kind = 1; ea.o0 = QB; }
        else { g.A = QB; g.K = DFF; g.N = DM; g.Bt = (const bf16_t*)(ws + WS_WFO) + (size_t)l * DM * DFF; ea.kind = 0; ea.o0 = VB; ea.ldc = DM; }
        pg8::StaticOrder S; S.init(g.M, g.N, G, bx); pg8::EpiGen E{ea};
#ifndef DBG_NO_GEMM
        pg8::gemm_phase<pg8::EpiGen, pg8::StaticOrder, true, true>((LAS unsigned char*)lds, g, S, E, tid);
#endif
        __syncthreads();
      }
    } else if (step == 3) {
      const bf16_t* A1 = VB; const float* gq = P.in[13] + jl * 256; const float* gkv = P.in[15] + jl * 256;
      for (int row = gw; row < TOK; row += NGW) {
        const bf16_t* a = A1 + (size_t)row * 768;
#pragma unroll
        for (int part = 0; part < 2; ++part) { const u32x2 w = *(const u32x2*)(a + part * 256 + 4 * lane);
          float x[4] = {__builtin_bit_cast(float, w.x << 16), __builtin_bit_cast(float, w.x & 0xffff0000u), __builtin_bit_cast(float, w.y << 16), __builtin_bit_cast(float, w.y & 0xffff0000u)};
          const float ss = wave_sum((x[0] * x[0] + x[1] * x[1]) + (x[2] * x[2] + x[3] * x[3]), lane); const float rstd = 1.0f / sqrtf(ss * (1.0f / 256.0f) + NORM_EPS);
          const f32x4 g = *(const f32x4*)((part ? gkv : gq) + 4 * lane); u32x2 o; o.x = pk2(x[0] * rstd * g[0], x[1] * rstd * g[1]); o.y = pk2(x[2] * rstd * g[2], x[3] * rstd * g[3]);
          *(u32x2*)(SB + (size_t)part * TOK * 256 + (size_t)row * 256 + 4 * lane) = o; }
        if (lane < 32) { const unsigned w = *(const unsigned*)(a + 512 + 2 * lane); float x1 = __builtin_bit_cast(float, w << 16), x2 = __builtin_bit_cast(float, w & 0xffff0000u);
          int b, key;
          if (row < NLAT) { const int t = row & (SEQ - 1); const float c = rope[(t * 32 + lane) * 2], s = rope[(t * 32 + lane) * 2 + 1]; const float y1 = x1 * c - x2 * s, y2 = x2 * c + x1 * s; x1 = y1; x2 = y2; b = row >> 13; key = LC + t; }
          else { const int r2 = row - NLAT; b = r2 >> 8; key = r2 & 255; }
          const unsigned o = pk2(x1, x2);
#pragma unroll
          for (int h = 0; h < 8; ++h) *(unsigned*)(KB + ((size_t)(b * 8 + h) * MLA_KEYS + key) * 192 + 128 + 2 * lane) = o; }
      }
    } else if (step == 5) {
      float* bias_l = (float*)(lds + 135168);
      if (kind == 0) {
        const int nun = last ? 1024 : 1056;
        for (int id = vcu; id < nun; id += G) { att::UnitP u; u.m0 = -1e30f; u.l0 = 0.f; u.a0 = 0; u.a1 = 0;
          int bh, row0; if (id < 1024) { bh = id >> 5; row0 = (bh >> 3) * SEQ + (id & 31) * 256; u.NT = 4 + SEQ / 64; } else { bh = id - 1024; row0 = NLAT + (bh >> 3) * LC; u.NT = 4; }
          const int h = bh & 7; const bf16_t* Kbh = KB + (size_t)bh * MLA_KEYS * 192; const bf16_t* Vbh = VB + (size_t)bh * MLA_KEYS * 128;
          u.Q = QB + (size_t)row0 * 1536 + h * 192; u.Kc = Kbh; u.Vc = Vbh; u.Kn = Kbh + (size_t)LC * 192; u.Vn = Vbh + (size_t)LC * 128; u.O = XN + (size_t)row0 * DM + h * 128;
#ifndef DBG_NO_ATT0
          att::attn_unit<192, 128, 1536, 192, 128, 0, MLA_SDEPTH, MLA_SERIAL>(u, (char*)lds, bias_l, tid);
#endif
        }
      } else if (kind == 1) {
        const float* rpb = P.in[19] + (size_t)jl * 16 * 465;
        const int nun = last ? 2048 : 2112;
        for (int id = vcu; id < nun; id += G) { att::UnitP u; u.m0 = -1e30f; u.l0 = 0.f;
          int bh, row0, qb = 0; if (id < 2048) { bh = id >> 5; qb = id & 31; row0 = (bh >> 4) * SEQ + qb * 256; u.NT = 16; } else { bh = id - 2048; row0 = NLAT + (bh >> 4) * LC; u.NT = 4; }
          const int b = bh >> 4, h = bh & 15; const int R0 = qb * 4, KR0 = min(max(R0 - 4, 0), 116); u.a0 = R0; u.a1 = KR0;
          u.Q = QB + (size_t)row0 * 3072 + h * 64; u.Kc = QB + (size_t)(NLAT + b * LC) * 3072 + 1024 + h * 64; u.Vc = u.Kc + 1024;
          u.Kn = QB + (size_t)(b * SEQ + KR0 * 64) * 3072 + 1024 + h * 64; u.Vn = u.Kn + 1024; u.O = XN + (size_t)row0 * DM + h * 64;
          for (int i = tid; i < 465; i += NTHREADS) bias_l[i] = rpb[h * 465 + i] * 8.0f;
          __syncthreads();
#ifndef DBG_NO_ATT1
          att::attn_unit<64, 64, 3072, 3072, 3072, 1, 2, false>(u, (char*)lds, bias_l, tid);
#endif
        }
      } else {
        const float* sink = P.in[22] + (size_t)jl * 16;
        const int nun = last ? 2048 : 2112;
        for (int id = vcu; id < nun; id += G) { att::UnitP u; u.a1 = 0;
          int bh, row0, qb = 0; if (id < 2048) { bh = id >> 5; qb = id & 31; row0 = (bh >> 4) * SEQ + qb * 256; u.NT = 12; } else { bh = id - 2048; row0 = NLAT + (bh >> 4) * LC; u.NT = 4; }
          const int b = bh >> 4, h = bh & 15, kvh = h >> 3; u.a0 = qb * 256; u.m0 = sink[h] * 8.0f; u.l0 = 1.0f;
          u.Q = QB + (size_t)row0 * 1280 + h * 64; u.Kc = QB + (size_t)(NLAT + b * LC) * 1280 + 1024 + kvh * 64; u.Vc = u.Kc + 128;
          u.Kn = QB + (size_t)(b * SEQ) * 1280 + 1024 + kvh * 64; u.Vn = u.Kn + 128; u.O = XN + (size_t)row0 * DM + h * 64;
#ifndef DBG_NO_ATT2
          att::attn_unit<64, 64, 1280, 1280, 1280, 2, 2, false>(u, (char*)lds, bias_l, tid);
#endif
        }
      }
    } else if (step == 7) {
      const int nrows = last ? NLAT : TOK;
      for (int row = gw; row < nrows; row += NGW)
        row_pass<false>(P, row, lane, VB, P.in[7] + l * DM, modvec(P, l, row, 2), true, P.in[8] + l * DM, modvec(P, l, row, 3), modvec(P, l, row, 4));
    } else if (step == 10) {
      const int nrows = last ? NLAT : TOK; const int ln = last ? l : l + 1;
      for (int row = gw; row < nrows; row += NGW)
        row_pass<false>(P, row, lane, VB, P.in[9] + l * DM, modvec(P, l, row, 5), !last, P.in[6] + ln * DM, modvec(P, ln, row, 0), modvec(P, ln, row, 1));
    }
#ifdef PROBE_MASK
    if (((PROBE_MASK >> step) & 1) && (PROBE_REPEAT_KIND < 0 || kind == PROBE_REPEAT_KIND) && rep == 0) { rep = 1; xcd_barrier(xbar, tid); --ph; continue; }
    rep = 0;
#endif
    if (ph + 1 < ph_hi) xcd_barrier(xbar, tid);
  }
}

#ifndef N_LAUNCH_SPLIT
#define N_LAUNCH_SPLIT 0
#endif
extern "C" void kernel_launch(void* const* d_in, const int* in_sizes, int n_in, void* d_out, int out_size, void* d_ws, size_t ws_size, hipStream_t stream) {
  static int grid = 0;
  if (grid == 0) {
    if (n_in != 24 || out_size != NLAT * DM || ws_size < WS_END) { fprintf(stderr, "kernel_launch: unexpected shapes n_in %d out %d ws %zu (need %zu)\n", n_in, out_size, ws_size, (size_t)WS_END); grid = -1; return; }
    int dev = 0, cus = 0, per_cu = 0;
    hipGetDevice(&dev); hipDeviceGetAttribute(&cus, hipDeviceAttributeMultiprocessorCount, dev);
    if (hipFuncSetAttribute((const void*)fwd_mega, hipFuncAttributeMaxDynamicSharedMemorySize, LDS_BYTES) != hipSuccess) { fprintf(stderr, "kernel_launch: hipFuncSetAttribute failed\n"); grid = -1; return; }
    if (hipOccupancyMaxActiveBlocksPerMultiprocessor(&per_cu, (const void*)fwd_mega, NTHREADS, LDS_BYTES) != hipSuccess || per_cu < 1) { fprintf(stderr, "kernel_launch: occupancy query says %d\n", per_cu); per_cu = 1; }
    (void)hipGetLastError();
    grid = cus * 1;
    fprintf(stderr, "kernel_launch: grid %d (cus %d, per_cu %d)\n", grid, cus, per_cu);
  }
  if (grid < 0) return;
  Params p{};
  for (int i = 0; i < 24; ++i) p.in[i] = (const float*)d_in[i];
  p.out = (float*)d_out; p.ws = (unsigned char*)d_ws;
  int n = 0; p.prog[n++] = 0; p.prog[n++] = 1;
  for (int l = 0; l < DEPTH; ++l) { const int kind = l % 3; const int steps_mla[9] = {2, 3, 4, 5, 6, 7, 8, 9, 10}, steps_o[7] = {2, 5, 6, 7, 8, 9, 10};
    if (kind == 0) for (int s = 0; s < 9; ++s) p.prog[n++] = (unsigned char)((l << 4) | steps_mla[s]); else for (int s = 0; s < 7; ++s) p.prog[n++] = (unsigned char)((l << 4) | steps_o[s]); }
  p.nph = n;
  unsigned char* ws = (unsigned char*)d_ws; int q = 0, first = 0;
  auto add = [&](const float* src, size_t dst_off, int K, int N, int Np, int kind) { WDesc& d = p.wd[q++]; d.src = src; d.dst = (bf16_t*)(ws + dst_off); d.K = K; d.N = N; d.Np = Np; d.kind = kind; d.first = first; d.pad = 0; first += (K / 64) * (Np / 32); };
  for (int l = 0; l < DEPTH; ++l) add(p.in[10] + (size_t)l * DM * 2 * DFF, WS_WFI + (size_t)l * 2 * DFF * DM * 2, DM, 2 * DFF, 2 * DFF, 1);
  for (int l = 0; l < DEPTH; ++l) add(p.in[11] + (size_t)l * DFF * DM, WS_WFO + (size_t)l * DM * DFF * 2, DFF, DM, DM, 0);
  for (int j = 0; j < 2; ++j) { const size_t b = WS_WMLA + j * MLA_W_STRIDE;
    add(p.in[12] + (size_t)j * DM * 576, b, DM, 576, 768, 2); add(p.in[14] + (size_t)j * 256 * 1536, b + MLA_OFF_UQ, 256, 1536, 1536, 3);
    add(p.in[16] + (size_t)j * 256 * 2048, b + MLA_OFF_UKV, 256, 2048, 2048, 0); add(p.in[17] + (size_t)j * DM * DM, b + MLA_OFF_WO, DM, DM, DM, 0); }
  add(p.in[18], WS_WNA, DM, 3072, 3072, 0); add(p.in[20], WS_WNA + (size_t)3072 * 1024 * 2, DM, DM, DM, 0);
  add(p.in[21], WS_WSWA, DM, 1280, 1280, 4); add(p.in[23], WS_WSWA + (size_t)1280 * 1024 * 2, DM, DM, DM, 0);
  p.nitems = first;
#if N_LAUNCH_SPLIT
  for (int ph = 0; ph < n; ++ph) { p.lo = ph; p.hi = ph + 1; hipLaunchKernelGGL(fwd_mega, dim3(grid), dim3(NTHREADS), LDS_BYTES, stream, p); }
#else
  p.lo = 0; p.hi = n;
  if (hipMemsetAsync((char*)d_ws + WS_BAR, 0, BAR_BYTES, stream) != hipSuccess) { fprintf(stderr, "kernel_launch: memset failed\n"); return; }
  void* args[] = {&p};
  hipError_t e = hipLaunchCooperativeKernel((const void*)fwd_mega, dim3(grid), dim3(NTHREADS), args, LDS_BYTES, stream);
  if (e != hipSuccess) fprintf(stderr, "kernel_launch: cooperative launch failed: %s (grid %d)\n", hipGetErrorString(e), grid);
#endif
}
```

```cpp
#include <hip/hip_runtime.h>
#include <hip/hip_cooperative_groups.h>
#include <cstdio>
#include <cstdint>
namespace cg = cooperative_groups;

constexpr int DM = 1024, NBATCH = 4, SEQ = 8192, NLAT = NBATCH * SEQ, LC = 256, NCTX = NBATCH * LC, TOK = NLAT + NCTX, DFF = 2816, DEPTH = 4;
constexpr int MLA_KEYS = SEQ + LC;
#ifndef MLA_SDEPTH
#define MLA_SDEPTH 1
#endif
#ifndef FUSED_NORM
#define FUSED_NORM 0
#endif
#ifndef MLA_EARLY
#define MLA_EARLY false
#endif
#ifndef SPLIT_CTX
#define SPLIT_CTX 0
#endif
#ifndef NS_SDEPTH
#define NS_SDEPTH 1
#endif
#ifndef FUSE_LAT
#define FUSE_LAT 1
#endif
#ifndef MLA_SERIAL
#define MLA_SERIAL false
#endif
namespace pg8 {
#define PG8_LAS __attribute__((address_space(3)))
typedef unsigned short bf16_t;
typedef short bf16x8 __attribute__((ext_vector_type(8)));
typedef float f32x4 __attribute__((ext_vector_type(4)));
typedef unsigned u32x4 __attribute__((ext_vector_type(4)));
constexpr int BM = 256, BK = 64, HALF = 128, HTB = HALF * BK * 2  , STAGE_BYTES = 8 * HTB, NXCD = 8, WGM = 8;

__host__ __device__ __forceinline__ int lds_byte(int r, int c) { const int st = (r >> 4) * 2 + (c >> 5), rr = r & 15, cc = c & 31, ob = rr * 64 + cc * 2; return st * 1024 + (ob ^ (((ob >> 9) & 1) << 5)); }
__host__ __device__ __forceinline__ void stage_rc(int b, int& R, int& C) { const int st = b / 1024, sb = b % 1024, swz = sb ^ (((sb >> 9) & 1) << 5); R = (st >> 1) * 16 + swz / 64; C = (st & 1) * 32 + (swz % 64) / 2; }
__host__ __device__ __forceinline__ int perm32(int rho) { const int n = rho >> 4, i = rho & 15; return 8 * (i >> 2) + 4 * n + (i & 3); }

struct Unit { int pm, pn, ks; };
struct Gemm { const bf16_t* A; const bf16_t* Bt; int M, N, K, nts; };

struct StaticOrder {
    int nM, nN, nwg, G, c, S;
    __host__ __device__ void init(int M, int N, int G_, int c_, int S_ = 1) { nM = M / BM; nN = N / BM; nwg = nM * nN; G = G_; c = c_; S = S_; }
    __host__ __device__ bool next(int i, Unit& u) const {
        if (S > 1) { const int L = i * G + c; if (L >= nwg * S) return false; u.ks = L % S; const int t = L / S; u.pm = t / nN; u.pn = t % nN; return true; }
        u.ks = 0;
        const long L = (long)i * G + c; if (L >= nwg) return false;
        int wgid = (int)L; { const int q = nwg / NXCD, r = nwg % NXCD, xcd = wgid % NXCD, off = wgid / NXCD; wgid = (xcd < r ? xcd * (q + 1) : r * (q + 1) + (xcd - r) * q) + off; }
        const int nig = WGM * nN, gid = wgid / nig, fm = gid * WGM, gsz = (nM - fm) < WGM ? (nM - fm) : WGM;
        u.pm = fm + ((wgid % nig) % gsz); u.pn = (wgid % nig) / gsz; return true;
    }
    __device__ __forceinline__ void a_ready(const Unit&) const {}
    __device__ __forceinline__ void done(const Unit&) const {}
};

__device__ __forceinline__ unsigned cvt_pk_bf16(float lo, float hi) { unsigned r; asm volatile("v_cvt_pk_bf16_f32 %0, %1, %2" : "=v"(r) : "v"(lo), "v"(hi)); return r; }
typedef float f32x2 __attribute__((ext_vector_type(2)));
struct EpiArgs { int kind; int ldc; bf16_t* o0; bf16_t* o1; const float* rope; const float* g0; const float* g1; PG8_LAS unsigned char* xl; };
__device__ __forceinline__ u32x4 pack8(const f32x4& v0, const f32x4& v1) { u32x4 w; w.x = cvt_pk_bf16(v0[0], v0[1]); w.y = cvt_pk_bf16(v0[2], v0[3]); w.z = cvt_pk_bf16(v1[0], v1[1]); w.w = cvt_pk_bf16(v1[2], v1[3]); return w; }
__device__ __forceinline__ void rope8(f32x4& v0, f32x4& v1, const float* rp) {
    const f32x4 a = *(const f32x4*)rp, b = *(const f32x4*)(rp + 4);
    const f32x4 x0 = v0, x1 = v1;
    v0[0] = x0[0] * a[0] - x0[1] * a[1]; v0[1] = x0[1] * a[0] + x0[0] * a[1];
    v0[2] = x0[2] * a[2] - x0[3] * a[3]; v0[3] = x0[3] * a[2] + x0[2] * a[3];
    v1[0] = x1[0] * b[0] - x1[1] * b[1]; v1[1] = x1[1] * b[0] + x1[0] * b[1];
    v1[2] = x1[2] * b[2] - x1[3] * b[3]; v1[3] = x1[3] * b[2] + x1[2] * b[3];
}
template <int KIND> __device__ __forceinline__ void emit8(const EpiArgs& a, int row, int col, f32x4 v0, f32x4 v1, int ks) {
    if constexpr (KIND == 5) { float* o = (float*)a.o0 + ((size_t)ks * NCTX + row) * DM + col; *(f32x4*)o = v0; *(f32x4*)(o + 4) = v1; }
    else if constexpr (KIND == 0) { *(u32x4*)(a.o0 + (size_t)row * a.ldc + col) = pack8(v0, v1); }
    else if constexpr (KIND == 1) {
        float r[4];
#pragma unroll
        for (int i = 0; i < 4; ++i) { const float g = v0[i]; r[i] = g * v1[i] * __builtin_amdgcn_rcpf(1.0f + __builtin_amdgcn_exp2f(-g * 1.4426950408889634f)); }
        typedef unsigned u32x2 __attribute__((ext_vector_type(2))); u32x2 w; w.x = cvt_pk_bf16(r[0], r[1]); w.y = cvt_pk_bf16(r[2], r[3]);
        *(u32x2*)(a.o0 + (size_t)row * DFF + (col >> 1)) = w; }
    else if constexpr (KIND == 2) {
        const int within = col % 192;
        if (within >= 128 && row < NLAT) rope8(v0, v1, a.rope + ((size_t)(row & (SEQ - 1)) * 32 + ((within - 128) >> 1)) * 2);
        *(u32x4*)(a.o0 + (size_t)row * 1536 + col) = pack8(v0, v1); }
    else if constexpr (KIND == 3) {
        const int h = col >> 8, w = col & 255; int b, key;
        if (row < NLAT) { b = row >> 13; key = LC + (row & (SEQ - 1)); } else { const int r2 = row - NLAT; b = r2 >> 8; key = r2 & 255; }
        const size_t base = (size_t)(b * 8 + h) * MLA_KEYS + key;
        if (w < 128) *(u32x4*)(a.o0 + base * 128 + w) = pack8(v0, v1); else *(u32x4*)(a.o1 + base * 128 + (w - 128)) = pack8(v0, v1); }
    else {
        if (col < 1152 && row < NLAT) rope8(v0, v1, a.rope + ((size_t)(row & (SEQ - 1)) * 32 + ((col & 63) >> 1)) * 2);
        *(u32x4*)(a.o0 + (size_t)row * 1280 + col) = pack8(v0, v1); }
}
struct EpiGen {
    static constexpr bool PERM = true, AFTER_DRAIN = false;
    EpiArgs a;
    template <int KIND> __device__ __forceinline__ void run(const f32x4 (&acc)[2][2][4][2], const Unit& u, int wr, int wc, int fr, int fq) const {
        const int row0 = u.pm * BM + wr * 64 + fr, col0 = u.pn * BM + wc * 32 + 8 * fq;
#pragma unroll
        for (int ai = 0; ai < 2; ++ai)
#pragma unroll
            for (int m = 0; m < 4; ++m)
#pragma unroll
                for (int bj = 0; bj < 2; ++bj) { emit8<KIND>(a, row0 + ai * HALF + m * 16, col0 + bj * HALF, acc[ai][bj][m][0], acc[ai][bj][m][1], u.ks); asm volatile("" ::: "memory"); }
    }
    __device__ __forceinline__ void run_lat(const f32x4 (&acc)[2][2][4][2], const Unit& u, int wr, int wc) const {
        int lane; asm volatile("v_mbcnt_lo_u32_b32 %0, -1, 0\n\tv_mbcnt_hi_u32_b32 %0, -1, %0" : "=v"(lane));
        const int fr = lane & 15, fq = lane >> 4;
        const int row0 = u.pm * BM + wr * 64 + fr, tc0 = wc * 32 + 8 * fq;
        if (u.pn < 2) {
            PG8_LAS float* P = (PG8_LAS float*)a.xl;
#pragma unroll
            for (int ai = 0; ai < 2; ++ai)
#pragma unroll
                for (int m = 0; m < 4; ++m) { float s = 0.f;
#pragma unroll
                    for (int bj = 0; bj < 2; ++bj)
#pragma unroll
                        for (int n = 0; n < 2; ++n) { const f32x4 x = acc[ai][bj][m][n]; s += (x[0] * x[0] + x[1] * x[1]) + (x[2] * x[2] + x[3] * x[3]); }
                    s += __builtin_bit_cast(float, __builtin_amdgcn_ds_bpermute((lane ^ 16) << 2, __builtin_bit_cast(int, s)));
                    s += __builtin_bit_cast(float, __builtin_amdgcn_ds_bpermute((lane ^ 32) << 2, __builtin_bit_cast(int, s)));
                    if (fq == 0) P[(ai * HALF + wr * 64 + m * 16 + fr) * 4 + wc] = s; }
            asm volatile("s_waitcnt lgkmcnt(0)" ::: "memory"); __builtin_amdgcn_s_barrier(); asm volatile("" ::: "memory");
            const float* g = u.pn ? a.g1 : a.g0; bf16_t* out = a.o0 + (size_t)u.pn * TOK * 256;
#pragma unroll
            for (int ai = 0; ai < 2; ++ai)
#pragma unroll
                for (int m = 0; m < 4; ++m) { const int rl = ai * HALF + wr * 64 + m * 16 + fr; const f32x4 pp = *(const PG8_LAS f32x4*)(P + rl * 4);
                    const float rstd = 1.0f / sqrtf(((pp[0] + pp[1]) + (pp[2] + pp[3])) * (1.0f / 256.0f) + 1e-6f);
#pragma unroll
                    for (int bj = 0; bj < 2; ++bj) { const int c = tc0 + bj * HALF; const f32x4 g0 = *(const f32x4*)(g + c), g1 = *(const f32x4*)(g + c + 4);
                        *(u32x4*)(out + (size_t)(row0 + ai * HALF + m * 16) * 256 + c) = pack8(acc[ai][bj][m][0] * rstd * g0, acc[ai][bj][m][1] * rstd * g1); }
                    asm volatile("" ::: "memory"); }
            asm volatile("s_waitcnt lgkmcnt(0)" ::: "memory"); __builtin_amdgcn_s_barrier(); asm volatile("" ::: "memory");
        } else if (tc0 < 64) {
#pragma unroll
            for (int ai = 0; ai < 2; ++ai)
#pragma unroll
                for (int m = 0; m < 4; ++m) { const int row = row0 + ai * HALF + m * 16; f32x4 v0 = acc[ai][0][m][0], v1 = acc[ai][0][m][1]; int b, key;
                    if (row < NLAT) { rope8(v0, v1, a.rope + ((size_t)(row & (SEQ - 1)) * 32 + (tc0 >> 1)) * 2); b = row >> 13; key = LC + (row & (SEQ - 1)); }
                    else { const int r2 = row - NLAT; b = r2 >> 8; key = r2 & 255; }
                    *(u32x4*)(a.o1 + ((size_t)b * MLA_KEYS + key) * 64 + tc0) = pack8(v0, v1);
                    asm volatile("" ::: "memory"); }
        }
    }
    __device__ __forceinline__ void run_swiglu(const f32x4 (&acc)[2][2][4][2], const Unit& u, int wr, int wc, int fr, int fq) const {
        const int row0 = u.pm * BM + wr * 64 + fr;
        const bool odd = (fq & 1) != 0;
        const int ocol = u.pn * (BM / 2) + wc * 16 + (odd ? 64 + 4 * (fq - 1) : 4 * fq);
#pragma unroll
        for (int ai = 0; ai < 2; ++ai)
#pragma unroll
            for (int m = 0; m < 4; ++m) { unsigned w[2][2];
#pragma unroll
                for (int bj = 0; bj < 2; ++bj) { const f32x4 g4 = acc[ai][bj][m][0], u4 = acc[ai][bj][m][1]; float r[4];
#pragma unroll
                    for (int i = 0; i < 4; ++i) { const float g = g4[i]; r[i] = g * u4[i] * __builtin_amdgcn_rcpf(1.0f + __builtin_amdgcn_exp2f(-g * 1.4426950408889634f)); }
                    w[bj][0] = cvt_pk_bf16(r[0], r[1]); w[bj][1] = cvt_pk_bf16(r[2], r[3]); }
                const auto s0 = __builtin_amdgcn_permlane16_swap(w[0][0], w[1][0], false, false); const auto s1 = __builtin_amdgcn_permlane16_swap(w[0][1], w[1][1], false, false);
                u32x4 o; o.x = s0[0]; o.y = s1[0]; o.z = s0[1]; o.w = s1[1];
                *(u32x4*)(a.o0 + (size_t)(row0 + ai * HALF + m * 16) * DFF + ocol) = o;
                asm volatile("" ::: "memory"); }
    }
    __device__ __forceinline__ void operator()(const f32x4 (&acc)[2][2][4][2], const Unit& u, int wr, int wc, int fr, int fq) const {
        if (a.kind == 6) { run_lat(acc, u, wr, wc); return; }
        if (a.kind == 1) { run_swiglu(acc, u, wr, wc, fr, fq); return; }
        switch (a.kind) { case 0: run<0>(acc, u, wr, wc, fr, fq); break; case 1: run<1>(acc, u, wr, wc, fr, fq); break; case 2: run<2>(acc, u, wr, wc, fr, fq); break;
                          case 3: run<3>(acc, u, wr, wc, fr, fq); break; case 5: run<5>(acc, u, wr, wc, fr, fq); break; default: run<4>(acc, u, wr, wc, fr, fq); break; }
    }
};
struct PanelOrder {
    int nwg, G, c;
    __device__ __forceinline__ void init(int M, int G_, int c_) { nwg = (M / BM) * 4; G = G_; c = c_; }
    __device__ __forceinline__ bool next(int i, Unit& u) const { const int L = i * G + c; if (L >= nwg) return false; u.pm = L >> 2; u.pn = L & 3; u.ks = 0; return true; }
    __device__ __forceinline__ void a_ready(const Unit&) const {}
    __device__ __forceinline__ void done(const Unit&) const {}
};
struct NormArgs {
    float* xlat; float* xctx; bf16_t* xn;
    const float* g_post; const float* g_pre; const float* modl; const float* modn;
    int wgate, wshift, wscale, do_norm;
    float* slot1; float* slot2; unsigned* cnt1; unsigned* cnt2;
};
struct EpiNorm {
    static constexpr bool PERM = true, AFTER_DRAIN = false;
    NormArgs a; PG8_LAS unsigned char* xl;
    __device__ __forceinline__ static float xor_add(float v, int lane, int o) { return v + __builtin_bit_cast(float, __builtin_amdgcn_ds_bpermute((lane ^ o) << 2, __builtin_bit_cast(int, v))); }
    __device__ __forceinline__ bool stats(const float (&part)[2][4], float* slot, unsigned* cnt, const Unit& u, int wr, int wc, int fr, int fq, int wid, int lane) const {
        PG8_LAS float* P = (PG8_LAS float*)xl; PG8_LAS float* S = (PG8_LAS float*)(xl + 4096); PG8_LAS unsigned* flag = (PG8_LAS unsigned*)(xl + 4096 + 1024);
#pragma unroll
        for (int ai = 0; ai < 2; ++ai)
#pragma unroll
            for (int m = 0; m < 4; ++m) if (fq == 0) P[(ai * HALF + wr * 64 + m * 16 + fr) * 4 + wc] = part[ai][m];
        asm volatile("s_waitcnt lgkmcnt(0)" ::: "memory"); __builtin_amdgcn_s_barrier(); asm volatile("" ::: "memory");
        const int row = wid * 32 + (lane & 31);
        if (lane < 32) { const float t = (P[row * 4 + 0] + P[row * 4 + 1]) + (P[row * 4 + 2] + P[row * 4 + 3]);
            __hip_atomic_store((unsigned*)slot + ((size_t)(u.pm * BM + row) * 4 + u.pn), __float_as_uint(t), __ATOMIC_RELAXED, __HIP_MEMORY_SCOPE_AGENT); }
        asm volatile("s_waitcnt vmcnt(0)" ::: "memory");
        if (lane == 0) __hip_atomic_fetch_add(cnt + 64 * u.pm, 1u, __ATOMIC_RELAXED, __HIP_MEMORY_SCOPE_AGENT);
        if (wid == 0) {
            bool dead = false; const unsigned long long t0 = __builtin_amdgcn_s_memrealtime();
            for (;;) {
                if ((unsigned)__builtin_amdgcn_readfirstlane(__hip_atomic_load(cnt + 64 * u.pm, __ATOMIC_RELAXED, __HIP_MEMORY_SCOPE_AGENT)) >= 32u) break;
                if (__builtin_amdgcn_s_memrealtime() - t0 > 5000000ull) { dead = true; break; }
                __builtin_amdgcn_s_sleep(2);
            }
            __builtin_amdgcn_fence(__ATOMIC_ACQUIRE, "agent");
            if (lane == 0) flag[0] = dead ? 1u : 0u;
        }
        asm volatile("s_waitcnt vmcnt(0) lgkmcnt(0)" ::: "memory"); __builtin_amdgcn_s_barrier(); asm volatile("" ::: "memory");
        const bool bad = flag[0] != 0u;
        if (lane < 32) { const unsigned* sl = (const unsigned*)slot + (size_t)(u.pm * BM + row) * 4; float t = 0.f;
#pragma unroll
            for (int q = 0; q < 4; ++q) t += __uint_as_float(__hip_atomic_load(sl + q, __ATOMIC_RELAXED, __HIP_MEMORY_SCOPE_AGENT));
            S[row] = 1.0f / sqrtf(t * (1.0f / 1024.0f) + 1e-6f); }
        asm volatile("s_waitcnt lgkmcnt(0)" ::: "memory"); __builtin_amdgcn_s_barrier(); asm volatile("" ::: "memory");
        return bad;
    }
    __device__ __forceinline__ void rowsq(const f32x4 (&acc)[2][2][4][2], float (&part)[2][4], int lane) const {
#pragma unroll
        for (int ai = 0; ai < 2; ++ai)
#pragma unroll
            for (int m = 0; m < 4; ++m) { float s = 0.f;
#pragma unroll
                for (int bj = 0; bj < 2; ++bj)
#pragma unroll
                    for (int n = 0; n < 2; ++n) { const f32x4 x = acc[ai][bj][m][n]; s += (x[0] * x[0] + x[1] * x[1]) + (x[2] * x[2] + x[3] * x[3]); }
                s = xor_add(s, lane, 16); s = xor_add(s, lane, 32); part[ai][m] = s; }
    }
    __device__ __forceinline__ void operator()(f32x4 (&acc)[2][2][4][2], const Unit& u, int wr, int wc, int fr_, int fq_) const {
        int lane; asm volatile("v_mbcnt_lo_u32_b32 %0, -1, 0\n\tv_mbcnt_hi_u32_b32 %0, -1, %0" : "=v"(lane));
        const int fr = lane & 15, fq = lane >> 4, wid = wr * 4 + wc; (void)fr_; (void)fq_;
        const PG8_LAS float* S = (const PG8_LAS float*)(xl + 4096);
        const int rmod = u.pm < 128 ? (u.pm >> 5) : 4;
        float* xu = (u.pm < 128 ? a.xlat + (size_t)u.pm * BM * DM : a.xctx + (size_t)(u.pm - 128) * BM * DM);
        const int col0 = u.pn * BM + wc * 32 + 8 * fq;
        const unsigned xoff = (unsigned)((wr * 64 + fr) * DM + col0);
        float part[2][4];
        rowsq(acc, part, lane);
        bool bad = stats(part, a.slot1, a.cnt1, u, wr, wc, fr, fq, wid, lane);
        { float rs[2][4];
#pragma unroll
          for (int ai = 0; ai < 2; ++ai)
#pragma unroll
            for (int m = 0; m < 4; ++m) rs[ai][m] = S[ai * HALF + wr * 64 + m * 16 + fr];
          const float* gate = a.modl + (size_t)(rmod * 6 + a.wgate) * DM;
#pragma unroll
          for (int bj = 0; bj < 2; ++bj)
#pragma unroll
            for (int n = 0; n < 2; ++n) { const int c = col0 + bj * HALF + 4 * n; const f32x4 gg = *(const f32x4*)(gate + c) * *(const f32x4*)(a.g_post + c);
#pragma unroll
              for (int ai = 0; ai < 2; ++ai)
#pragma unroll
                for (int m = 0; m < 4; ++m) { const f32x4 x = *(const f32x4*)(xu + (xoff + (unsigned)((ai * HALF + m * 16) * DM + bj * HALF + 4 * n))); acc[ai][bj][m][n] = x + gg * (acc[ai][bj][m][n] * rs[ai][m]);
                  if (m == 3) asm volatile("" ::: "memory"); } } }
        const float qnan = __builtin_nanf("");
        unsigned xoff2 = xoff; asm volatile("" : "+v"(xoff2));
        if (a.do_norm) {
            rowsq(acc, part, lane);
            bad = stats(part, a.slot2, a.cnt2, u, wr, wc, fr, fq, wid, lane) || bad;
            float rs[2][4];
#pragma unroll
            for (int ai = 0; ai < 2; ++ai)
#pragma unroll
              for (int m = 0; m < 4; ++m) rs[ai][m] = S[ai * HALF + wr * 64 + m * 16 + fr];
            const float* shift = a.modn + (size_t)(rmod * 6 + a.wshift) * DM; const float* scale = a.modn + (size_t)(rmod * 6 + a.wscale) * DM;
            bf16_t* xnu = a.xn + (size_t)u.pm * BM * DM;
#pragma unroll
            for (int bj = 0; bj < 2; ++bj)
#pragma unroll
              for (int n = 0; n < 2; ++n) { const int c = col0 + bj * HALF + 4 * n; const f32x4 g = *(const f32x4*)(a.g_pre + c), sh = *(const f32x4*)(shift + c), sc = *(const f32x4*)(scale + c) + 1.0f;
#pragma unroll
                for (int ai = 0; ai < 2; ++ai)
#pragma unroll
                  for (int m = 0; m < 4; ++m) { f32x4 x = acc[ai][bj][m][n]; if (bad) x = (f32x4){qnan, qnan, qnan, qnan};
                    const unsigned o = xoff2 + (unsigned)((ai * HALF + m * 16) * DM + bj * HALF + 4 * n);
                    *(f32x4*)(xu + o) = x;
                    const f32x4 h = (x * rs[ai][m] * g) * sc + sh; typedef unsigned u32x2 __attribute__((ext_vector_type(2))); u32x2 w; w.x = cvt_pk_bf16(h[0], h[1]); w.y = cvt_pk_bf16(h[2], h[3]);
                    *(u32x2*)(xnu + o) = w; }
                asm volatile("" ::: "memory"); }
        } else {
#pragma unroll
            for (int bj = 0; bj < 2; ++bj)
#pragma unroll
              for (int n = 0; n < 2; ++n) { const int c = col0 + bj * HALF + 4 * n;
#pragma unroll
                for (int ai = 0; ai < 2; ++ai)
#pragma unroll
                  for (int m = 0; m < 4; ++m) { f32x4 x = acc[ai][bj][m][n]; if (bad) x = (f32x4){qnan, qnan, qnan, qnan}; *(f32x4*)(xu + (xoff2 + (unsigned)((ai * HALF + m * 16) * DM + bj * HALF + 4 * n))) = x; } (void)c; }
        }
    }
};
template <class Epi, class Sched, bool ALIGN_EPI = false, bool SP2 = false>
__device__ __forceinline__ void gemm_phase(PG8_LAS unsigned char* lds, const Gemm g, const Sched& S, const Epi& E, const int tid) {
    const int wid = __builtin_amdgcn_readfirstlane(tid >> 6), lane = tid & 63, wr = wid >> 2, wc = wid & 3, fr = lane & 15, fq = lane >> 4;
    const int K = g.K, nt = g.nts ? g.nts : K / BK; const size_t sstep = (size_t)g.nts * BK * 2;
    unsigned voffA[2], voffB[2];
#pragma unroll
    for (int i = 0; i < 2; ++i) { int R, C; stage_rc(tid * 16 + i * 8192, R, C); const int Rb = Epi::PERM ? ((R & ~31) + perm32(R & 31)) : R;
        voffA[i] = (unsigned)(R * K + C) * 2u; voffB[i] = (unsigned)(Rb * K + C) * 2u; }
    const size_t kstep = (size_t)(BK * 2);
    const size_t hstep = (size_t)HALF * K * 2;
    const size_t tstep = 2 * hstep;
    const unsigned ldsw = (unsigned)wid * 1024u;
    const int aoff = lds_byte(wr * 64 + fr, fq * 8), boff = lds_byte(wc * 32 + fr, fq * 8);
#define PG8_SA(b, h) (((b) * 2 + (h)) * HTB)
#define PG8_SB(b, h) ((4 + (b) * 2 + (h)) * HTB)
#define PG8_STAGE(bufoff, gbase, voff) do { _Pragma("unroll") for (int _i = 0; _i < 2; ++_i) \
        __builtin_amdgcn_global_load_lds((const unsigned*)((const char*)(gbase) + (voff)[_i]), (PG8_LAS unsigned*)(lds + (bufoff) + ldsw + _i * 8192), 16, 0, 0); } while (0)
#define PG8_LDA(dst, b, h) do { _Pragma("unroll") for (int m = 0; m < 4; ++m) _Pragma("unroll") for (int k = 0; k < 2; ++k) dst[m][k] = *(const PG8_LAS bf16x8*)(lds + PG8_SA(b, h) + aoff + m * 2048 + k * 1024); } while (0)
#define PG8_LDB(dst, b, h) do { _Pragma("unroll") for (int n = 0; n < 2; ++n) _Pragma("unroll") for (int k = 0; k < 2; ++k) dst[n][k] = *(const PG8_LAS bf16x8*)(lds + PG8_SB(b, h) + boff + n * 2048 + k * 1024); } while (0)
#define PG8_MMA(ai, bj, At, Bt) do { __builtin_amdgcn_s_setprio(1); _Pragma("unroll") for (int m = 0; m < 4; ++m) _Pragma("unroll") for (int n = 0; n < 2; ++n) _Pragma("unroll") for (int k = 0; k < 2; ++k) \
        acc[ai][bj][m][n] = __builtin_amdgcn_mfma_f32_16x16x32_bf16(Bt[n][k], At[m][k], acc[ai][bj][m][n], 0, 0, 0); __builtin_amdgcn_s_setprio(0); } while (0)
#define PG8_WAIT_V(n) asm volatile("s_waitcnt vmcnt(" #n ")" ::: "memory")
#define PG8_WAIT_L(n) asm volatile("s_waitcnt lgkmcnt(" #n ")" ::: "memory")
#define PG8_BAR __builtin_amdgcn_s_barrier()
#define PG8_SCHED __builtin_amdgcn_sched_barrier(0)
    Unit cur, nxt; int ui = 0;
    if (!S.next(0, cur)) return;
    f32x4 acc[2][2][4][2];
#pragma unroll
    for (int a = 0; a < 2; ++a)
#pragma unroll
        for (int b = 0; b < 2; ++b)
#pragma unroll
            for (int m = 0; m < 4; ++m)
#pragma unroll
                for (int n = 0; n < 2; ++n) acc[a][b][m][n] = (f32x4){0.f, 0.f, 0.f, 0.f};
    bf16x8 At[4][2], B0[2][2], B1[2][2];
    const char* cA = (const char*)g.A + (size_t)cur.pm * tstep + (size_t)cur.ks * sstep; const char* cB = (const char*)g.Bt + (size_t)cur.pn * tstep + (size_t)cur.ks * sstep;
    S.a_ready(cur);
    if constexpr (SP2) {
        PG8_STAGE(PG8_SB(0, 0), cB, voffB); PG8_STAGE(PG8_SB(0, 1), cB + hstep, voffB); PG8_STAGE(PG8_SA(0, 0), cA, voffA); PG8_STAGE(PG8_SA(0, 1), cA + hstep, voffA);
        if (wr == 1) PG8_BAR;
        PG8_WAIT_V(2); PG8_BAR;
        PG8_STAGE(PG8_SB(1, 0), cB + kstep, voffB); PG8_STAGE(PG8_SA(1, 0), cA + kstep, voffA); PG8_STAGE(PG8_SB(1, 1), cB + hstep + kstep, voffB);
        PG8_WAIT_V(6); PG8_BAR;
    } else {
        PG8_STAGE(PG8_SB(0, 0), cB, voffB); PG8_STAGE(PG8_SA(0, 0), cA, voffA); PG8_STAGE(PG8_SB(0, 1), cB + hstep, voffB); PG8_STAGE(PG8_SA(0, 1), cA + hstep, voffA);
        if (wr == 1) PG8_BAR;
        PG8_WAIT_V(4); PG8_BAR;
        PG8_STAGE(PG8_SB(1, 0), cB + kstep, voffB); PG8_STAGE(PG8_SA(1, 0), cA + kstep, voffA); PG8_STAGE(PG8_SB(1, 1), cB + hstep + kstep, voffB);
        PG8_WAIT_V(6); PG8_BAR;
    }
    for (;;) {
        const bool has_next = S.next(ui + 1, nxt);
        const char* nA = has_next ? (const char*)g.A + (size_t)nxt.pm * tstep + (size_t)nxt.ks * sstep : cA; const char* nB = has_next ? (const char*)g.Bt + (size_t)nxt.pn * tstep + (size_t)nxt.ks * sstep : cB;
        for (int t = 0; t < nt; t += 2) {
            const bool last = (t == nt - 2);
            const char* a1 = cA + (size_t)(t + 1) * kstep;
            const char* a2 = last ? nA : cA + (size_t)(t + 2) * kstep; const char* b2 = last ? nB : cB + (size_t)(t + 2) * kstep;
            const char* a3 = a2 + kstep; const char* b3 = b2 + kstep;
            if (last && has_next) S.a_ready(nxt);
            if constexpr (SP2) {
            PG8_LDB(B0, 0, 0); PG8_LDB(B1, 0, 1); PG8_SCHED; PG8_LDA(At, 0, 0); PG8_STAGE(PG8_SA(1, 1), a1 + hstep, voffA);
            PG8_WAIT_V(8); PG8_WAIT_L(0); PG8_BAR; PG8_MMA(0, 0, At, B0); PG8_MMA(0, 1, At, B1); PG8_BAR; PG8_SCHED;
            PG8_LDA(At, 0, 1); PG8_STAGE(PG8_SB(0, 0), b2, voffB); PG8_STAGE(PG8_SB(0, 1), b2 + hstep, voffB); PG8_STAGE(PG8_SA(0, 0), a2, voffA);
            PG8_WAIT_V(8); PG8_WAIT_L(0); PG8_BAR; PG8_MMA(1, 0, At, B0); PG8_MMA(1, 1, At, B1); PG8_BAR; PG8_SCHED;
            PG8_LDB(B0, 1, 0); PG8_LDB(B1, 1, 1); PG8_SCHED; PG8_LDA(At, 1, 0); PG8_STAGE(PG8_SA(0, 1), a2 + hstep, voffA);
            PG8_WAIT_V(8); PG8_WAIT_L(0); PG8_BAR; PG8_MMA(0, 0, At, B0); PG8_MMA(0, 1, At, B1); PG8_BAR; PG8_SCHED;
            PG8_LDA(At, 1, 1); PG8_STAGE(PG8_SB(1, 0), b3, voffB); PG8_STAGE(PG8_SB(1, 1), b3 + hstep, voffB); PG8_STAGE(PG8_SA(1, 0), a3, voffA);
            PG8_WAIT_V(8); PG8_WAIT_L(0); PG8_BAR; PG8_MMA(1, 0, At, B0); PG8_MMA(1, 1, At, B1); PG8_BAR; PG8_SCHED;
            } else {
            PG8_LDB(B0, 0, 0); PG8_SCHED; PG8_LDA(At, 0, 0); PG8_STAGE(PG8_SA(1, 1), a1 + hstep, voffA);
            PG8_WAIT_L(8); PG8_BAR; PG8_WAIT_L(0); PG8_MMA(0, 0, At, B0); PG8_BAR; PG8_SCHED;
            PG8_LDB(B1, 0, 1); PG8_STAGE(PG8_SB(0, 0), b2, voffB);
            PG8_BAR; PG8_WAIT_L(0); PG8_MMA(0, 1, At, B1); PG8_BAR;
            PG8_LDA(At, 0, 1); PG8_STAGE(PG8_SA(0, 0), a2, voffA);
            PG8_BAR; PG8_WAIT_L(0); PG8_MMA(1, 0, At, B0); PG8_BAR; PG8_SCHED;
            PG8_STAGE(PG8_SB(0, 1), b2 + hstep, voffB);
            PG8_WAIT_V(6); PG8_BAR; PG8_MMA(1, 1, At, B1); PG8_BAR;
            PG8_LDB(B0, 1, 0); PG8_SCHED; PG8_LDA(At, 1, 0); PG8_STAGE(PG8_SA(0, 1), a2 + hstep, voffA);
            PG8_WAIT_L(8); PG8_BAR; PG8_WAIT_L(0); PG8_MMA(0, 0, At, B0); PG8_BAR; PG8_SCHED;
            PG8_LDB(B1, 1, 1); PG8_STAGE(PG8_SB(1, 0), b3, voffB);
            PG8_BAR; PG8_WAIT_L(0); PG8_MMA(0, 1, At, B1); PG8_BAR;
            PG8_LDA(At, 1, 1); PG8_STAGE(PG8_SA(1, 0), a3, voffA);
            PG8_BAR; PG8_WAIT_L(0); PG8_MMA(1, 0, At, B0); PG8_BAR; PG8_SCHED;
            PG8_STAGE(PG8_SB(1, 1), b3 + hstep, voffB);
            PG8_WAIT_V(6); PG8_BAR; PG8_MMA(1, 1, At, B1); PG8_BAR;
            }
        }
        if constexpr (ALIGN_EPI) { if (wr == 0) PG8_BAR; }
        if constexpr (!Epi::AFTER_DRAIN) { E(acc, cur, wr, wc, fr, fq); S.done(cur); }
        if (!has_next) break;
#pragma unroll
        for (int a = 0; a < 2; ++a)
#pragma unroll
            for (int b = 0; b < 2; ++b)
#pragma unroll
                for (int m = 0; m < 4; ++m)
#pragma unroll
                    for (int n = 0; n < 2; ++n) acc[a][b][m][n] = (f32x4){0.f, 0.f, 0.f, 0.f};
        cur = nxt; cA = nA; cB = nB; ++ui;
        if constexpr (ALIGN_EPI) { if (wr == 1) PG8_BAR; }
    }
    PG8_WAIT_V(0);
    if constexpr (!ALIGN_EPI) { if (wr == 0) PG8_BAR; }
    PG8_BAR;
    if constexpr (Epi::AFTER_DRAIN) { E.fused(acc, cur, wr, wc, fr, fq, lds, wid, lane); S.done(cur); }
#undef PG8_SA
#undef PG8_SB
#undef PG8_STAGE
#undef PG8_LDA
#undef PG8_LDB
#undef PG8_MMA
#undef PG8_WAIT_V
#undef PG8_WAIT_L
#undef PG8_BAR
#undef PG8_SCHED
}
}
namespace att {
using bf16x8 = __attribute__((ext_vector_type(8))) short;
using s16x4  = __attribute__((ext_vector_type(4))) short;
using f32x16 = __attribute__((ext_vector_type(16))) float;
using u32x4  = __attribute__((ext_vector_type(4))) unsigned;
typedef unsigned short bf16_t;
#define SBAR() __builtin_amdgcn_sched_barrier(0)
__device__ __forceinline__ int crow(int r, int hi) { return (r & 3) + 8 * (r >> 2) + 4 * hi; }
__device__ __forceinline__ unsigned cvtpk(float lo, float hi) { unsigned r; asm volatile("v_cvt_pk_bf16_f32 %0, %1, %2" : "=v"(r) : "v"(lo), "v"(hi)); return r; }
template <int DK> __device__ __forceinline__ int kswz(int row, int colB) { return row * (DK * 2) + (colB ^ ((row & 7) << 4)); }

__device__ __forceinline__ void partialSM(f32x16& p0, f32x16& p1, float& m_reg, float& mn, float& alpha, const float C, const float THRS) {
  float pmax = p0[0];
#pragma unroll
  for (int r = 1; r < 16; ++r) pmax = fmaxf(pmax, p0[r]);
#pragma unroll
  for (int r = 0; r < 16; ++r) pmax = fmaxf(pmax, p1[r]);
  { auto rr = __builtin_amdgcn_permlane32_swap(__float_as_uint(pmax), __float_as_uint(pmax), false, false);
    pmax = fmaxf(__uint_as_float(rr[0]), __uint_as_float(rr[1])); }
  if (__builtin_expect(__all(pmax - m_reg <= THRS), 1)) { mn = m_reg; alpha = 1.f; }
  else { mn = fmaxf(m_reg, pmax); alpha = __builtin_amdgcn_exp2f((m_reg - mn) * C); m_reg = mn; }
  const float mnC = -mn * C;
#pragma unroll
  for (int r = 0; r < 16; ++r) p0[r] = fmaf(p0[r], C, mnC);
#pragma unroll
  for (int r = 0; r < 16; ++r) p1[r] = fmaf(p1[r], C, mnC);
#pragma unroll
  for (int r = 0; r < 16; ++r) p0[r] = __builtin_amdgcn_exp2f(p0[r]);
}
__device__ __forceinline__ void finishSM(f32x16& p0, f32x16& p1, float alpha, float& l_reg, bf16x8& pa0, bf16x8& pa1, bf16x8& pa2, bf16x8& pa3) {
#pragma unroll
  for (int r = 0; r < 16; ++r) p1[r] = __builtin_amdgcn_exp2f(p1[r]);
  float ps = 0;
#pragma unroll
  for (int r = 0; r < 16; ++r) ps += p0[r];
#pragma unroll
  for (int r = 0; r < 16; ++r) ps += p1[r];
  { auto rr = __builtin_amdgcn_permlane32_swap(__float_as_uint(ps), __float_as_uint(ps), false, false);
    ps = __uint_as_float(rr[0]) + __uint_as_float(rr[1]); }
  l_reg = l_reg * alpha + ps;
#define PK4(P, BASE, OUT) do { unsigned a0 = cvtpk(P[BASE + 0], P[BASE + 1]), a1 = cvtpk(P[BASE + 2], P[BASE + 3]);   \
    unsigned b0 = cvtpk(P[BASE + 4], P[BASE + 5]), b1 = cvtpk(P[BASE + 6], P[BASE + 7]);                              \
    auto r0 = __builtin_amdgcn_permlane32_swap(a0, b0, false, false); auto r1 = __builtin_amdgcn_permlane32_swap(a1, b1, false, false); \
    u32x4 w = {r0[0], r1[0], r0[1], r1[1]}; OUT = *reinterpret_cast<bf16x8*>(&w); } while (0)
  PK4(p0, 0, pa0); PK4(p0, 8, pa1); PK4(p1, 0, pa2); PK4(p1, 8, pa3);
#undef PK4
}
template <int DK> __device__ __forceinline__ void qkt(f32x16& p0, f32x16& p1, const char* Ks, const bf16x8* qr, const unsigned kb) {
  constexpr int KROW = DK * 2 + 16;
  p0 = f32x16{}; p1 = f32x16{};
  const char* a = Ks + kb;
#pragma unroll
  for (int d0 = 0; d0 < DK / 16; ++d0) {
    const bf16x8 b0 = *reinterpret_cast<const bf16x8*>(a + d0 * 32);
    const bf16x8 b1 = *reinterpret_cast<const bf16x8*>(a + d0 * 32 + 32 * KROW);
    p0 = __builtin_amdgcn_mfma_f32_32x32x16_bf16(b0, qr[d0], p0, 0, 0, 0);
    p1 = __builtin_amdgcn_mfma_f32_32x32x16_bf16(b1, qr[d0], p1, 0, 0, 0); }
}
template <int DV> __device__ __forceinline__ int v_st(int k, int c) { const int kk = (k & ~0xC) | ((k & 4) << 1) | ((k & 8) >> 1); return ((kk >> 3) * (DV / 32) + (c >> 5)) * 512 + ((kk & 7) * 32 + (c & 31)) * 2; }
__device__ __forceinline__ int v_rd_base(int lane) { return ((lane & 3) << 3) | (((lane >> 2) & 3) << 6) | (((lane >> 4) & 1) << 5) | (((lane >> 5) & 1) << 8); }
template <int DV> constexpr int v_rd_off(int d0, int ks, int half) { return d0 * 512 + ks * (DV / 32) * 1024 + half * (DV / 32) * 512; }
template <int OFF> __device__ __forceinline__ s16x4 tr_read(int vb) { s16x4 r; asm volatile("ds_read_b64_tr_b16 %0, %1 offset:%2" : "=&v"(r) : "v"(vb), "i"(OFF) : "memory"); return r; }
template <int DV, int D0> __device__ __forceinline__ void pv_one(f32x16& od, int vb, bf16x8 pa0, bf16x8 pa1, bf16x8 pa2, bf16x8 pa3) {
  const s16x4 l0 = tr_read<v_rd_off<DV>(D0, 0, 0)>(vb), h0 = tr_read<v_rd_off<DV>(D0, 0, 1)>(vb), l1 = tr_read<v_rd_off<DV>(D0, 1, 0)>(vb), h1 = tr_read<v_rd_off<DV>(D0, 1, 1)>(vb);
  const s16x4 l2 = tr_read<v_rd_off<DV>(D0, 2, 0)>(vb), h2 = tr_read<v_rd_off<DV>(D0, 2, 1)>(vb), l3 = tr_read<v_rd_off<DV>(D0, 3, 0)>(vb), h3 = tr_read<v_rd_off<DV>(D0, 3, 1)>(vb);
  asm volatile("s_waitcnt lgkmcnt(0)" ::: "memory"); SBAR();
#define PK(L, H) (bf16x8){L[0], L[1], L[2], L[3], H[0], H[1], H[2], H[3]}
  od = __builtin_amdgcn_mfma_f32_32x32x16_bf16(pa0, PK(l0, h0), od, 0, 0, 0);
  od = __builtin_amdgcn_mfma_f32_32x32x16_bf16(pa1, PK(l1, h1), od, 0, 0, 0);
  od = __builtin_amdgcn_mfma_f32_32x32x16_bf16(pa2, PK(l2, h2), od, 0, 0, 0);
  od = __builtin_amdgcn_mfma_f32_32x32x16_bf16(pa3, PK(l3, h3), od, 0, 0, 0);
#undef PK
}
template <int DV> __device__ __forceinline__ void pv_all(f32x16* o, int vb, bf16x8 pa0, bf16x8 pa1, bf16x8 pa2, bf16x8 pa3) {
  pv_one<DV, 0>(o[0], vb, pa0, pa1, pa2, pa3); pv_one<DV, 1>(o[1], vb, pa0, pa1, pa2, pa3);
  if constexpr (DV == 128) { pv_one<DV, 2>(o[2], vb, pa0, pa1, pa2, pa3); pv_one<DV, 3>(o[3], vb, pa0, pa1, pa2, pa3); }
}
struct UnitP {
  const bf16_t* Q;
  const bf16_t *Kc, *Vc, *Kn, *Vn;
  const bf16_t *Pc, *Pn;
  bf16_t* O;
  int NT; float m0, l0; int a0, a1;
};
template <int MODE> __device__ __forceinline__ void apply_mask(f32x16& p0, f32x16& p1, int jj, const UnitP& u, int wid, int r32, int hi, const float* bias_l) {
  const float NEG = -1e30f;
  if constexpr (MODE == 2) {
    const int ks = u.a0 - 128 + 64 * jj; const bool tv = (ks >= 0 && ks < SEQ);
    const int lo = 64 * jj - 128 - (wid * 32 + 31), hi_ = 64 * jj - 128 + 63 - wid * 32;
    if (!tv || lo > 128 || hi_ < -128) {
#pragma unroll
      for (int r = 0; r < 16; ++r) { p0[r] = NEG; p1[r] = NEG; }
    } else if (!(lo >= -128 && hi_ <= 128)) {
      const int rel0 = -128 + 64 * jj - (wid * 32 + r32);
#pragma unroll
      for (int r = 0; r < 16; ++r) { const int rel = rel0 + crow(r, hi);
        const bool ok0 = (unsigned)(rel + 128) <= 256u, ok1 = (unsigned)(rel + 160) <= 256u;
        p0[r] = ok0 ? p0[r] : NEG; p1[r] = ok1 ? p1[r] : NEG; }
    }
  } else if constexpr (MODE == 1) {
    int r32o = r32; asm volatile("" : "+v"(r32o));
    const int r = u.a0 + (wid >> 1), c = (wid & 1) * 32 + r32o, kr = u.a1 + jj;
    const int rs = min(max(r - 4, 0), 120), cs = min(max(c - 8, 0), 48); const bool rok = (kr >= rs && kr < rs + 8);
    if (!rok) {
#pragma unroll
      for (int q = 0; q < 16; ++q) { p0[q] = NEG; p1[q] = NEG; }
    } else {
      const int xb = 4 * hi - c + 15, xlo = cs - c + 15; const float* brow = bias_l + (kr - r + 7) * 31 + xb;
#pragma unroll
      for (int q = 0; q < 16; ++q) { const int kq = (q & 3) + 8 * (q >> 2);
        const bool ok0 = (unsigned)(xb + kq - xlo) < 16u, ok1 = (unsigned)(xb + kq + 32 - xlo) < 16u;
        const float b0 = brow[kq], b1 = brow[kq + 32];
        p0[q] = ok0 ? p0[q] + b0 : NEG; p1[q] = ok1 ? p1[q] + b1 : NEG;
        if ((q & 3) == 3) asm volatile("" ::: "memory"); }
    }
  }
}
template <int MODE> __device__ __forceinline__ bool tile_active(const UnitP& u, int j, int wid) {
  if (MODE == 0 || j < 4) return true;
  const int jj = j - 4;
  if (MODE == 1) { const int r = u.a0 + (wid >> 1), kr = u.a1 + jj, rs = min(max(r - 4, 0), 120); return kr >= rs && kr < rs + 8; }
  const int ks = u.a0 - 128 + 64 * jj; const int lo = 64 * jj - 128 - (wid * 32 + 31), hi_ = 64 * jj - 128 + 63 - wid * 32;
  return ks >= 0 && ks < SEQ && lo <= 128 && hi_ >= -128;
}
template <int DK, int DV, int LDQ, int LDK, int LDV, int MODE, int SDEPTH, bool SERIAL, bool EARLY>
__device__ __forceinline__ void attn_unit(const UnitP& u, char* lds, const float* bias_l, const int tid) {
  constexpr float SCALE = (DK == 192) ? 0.07216878364870322f : 0.125f;
  constexpr float C = SCALE * 1.4426950408889634f, THRS = 8.f / SCALE;
  constexpr int KROW = DK * 2 + 16, SHM_V = 64 * DV * 2, SHM_K = 64 * KROW, KC = DK / 64, VC = DV / 64, ND = DK / 16, NO = DV / 32;
  const int wid = __builtin_amdgcn_readfirstlane(tid >> 6), lane = tid & 63, r32 = lane & 31, hi = lane >> 5;
  constexpr int NSL = EARLY ? 3 : 2;
  char* V_lds = lds; char* K_lds = lds + NSL * SHM_V;
  float* ws = (float*)(lds + NSL * SHM_V + NSL * SHM_K) + wid * 64; float* li_l = ws; float* al_l = ws + 32;
  float m_reg = u.m0, l_reg = u.l0; f32x16 o[NO]; bf16x8 qr[ND];
#pragma unroll
  for (int d = 0; d < NO; ++d) o[d] = f32x16{};
  const bf16_t* Qw = u.Q + (long)(wid * 32 + r32) * LDQ + hi * 8;
#pragma unroll
  for (int d0 = 0; d0 < ND; ++d0) qr[d0] = *reinterpret_cast<const bf16x8*>(Qw + d0 * 16);
  const unsigned srow = tid >> 3, sch = tid & 7;
  const unsigned kofs0 = srow * LDK + sch * 8, vofs0 = srow * LDV + sch * 8, pofs0 = srow * 64 + sch * 8;
  const unsigned kdst0 = srow * KROW + sch * 16, vdst0 = (unsigned)v_st<DV>((int)srow, (int)sch * 8);
  const int vb0 = (int)(uintptr_t)V_lds + v_rd_base(lane);
  const unsigned kb = (unsigned)(r32 * KROW + hi * 16);
  struct { bf16x8 k[KC]; bf16x8 v[VC]; } sr_[SDEPTH];
#define LBAR() asm volatile("s_waitcnt lgkmcnt(0)\n\ts_barrier" ::: "memory")
#define TILE_PTRS(j, Kt, Vt) do { if ((j) < 4) { Kt = u.Kc + (long)(j) * 64 * LDK; Vt = u.Vc + (long)(j) * 64 * LDV; } \
    else if (MODE == 2) { int ks_ = u.a0 - 128 + 64 * ((j) - 4); if (ks_ < 0 || ks_ >= SEQ) ks_ = 0; Kt = u.Kn + (long)ks_ * LDK; Vt = u.Vn + (long)ks_ * LDV; } \
    else { Kt = u.Kn + (long)((j) - 4) * 64 * LDK; Vt = u.Vn + (long)((j) - 4) * 64 * LDV; } } while (0)
#define SLOAD(i, j) do { const bf16_t *Kt_, *Vt_; TILE_PTRS(j, Kt_, Vt_); \
    _Pragma("unroll") for (int c = 0; c < VC; ++c) sr_[i].v[c] = *reinterpret_cast<const bf16x8*>(Vt_ + vofs0 + 64 * c); \
    _Pragma("unroll") for (int c = 0; c < KC; ++c) { if (DK == 192 && c == 2) { const bf16_t* Pt_ = ((j) < 4) ? u.Pc + (long)(j) * 64 * 64 : u.Pn + (long)((j) - 4) * 64 * 64; \
        sr_[i].k[c] = *reinterpret_cast<const bf16x8*>(Pt_ + pofs0); } else sr_[i].k[c] = *reinterpret_cast<const bf16x8*>(Kt_ + kofs0 + 64 * c); } } while (0)
#define SWRITE(b, i) do { _Pragma("unroll") for (int c = 0; c < VC; ++c) *(bf16x8*)(V_lds + (b) * SHM_V + vdst0 + 1024 * c) = sr_[i].v[c]; \
    _Pragma("unroll") for (int c = 0; c < KC; ++c) *(bf16x8*)(K_lds + (b) * SHM_K + kdst0 + 128 * c) = sr_[i].k[c]; } while (0)
#define SWAIT() do { if constexpr (SDEPTH == 2) asm volatile("s_waitcnt vmcnt(%0)" :: "n"(KC + VC) : "memory"); else asm volatile("s_waitcnt vmcnt(0)" ::: "memory"); } while (0)
#define RESC(a) do { if (__any((a) < 1.f)) { if (hi == 0) al_l[r32] = (a); asm volatile("s_waitcnt lgkmcnt(0)" ::: "memory"); \
    _Pragma("unroll") for (int d = 0; d < NO; ++d) _Pragma("unroll") for (int r = 0; r < 16; ++r) o[d][r] *= al_l[crow(r, hi)]; } } while (0)
#define MASK(P0, P1, j) do { if (MODE != 0 && (j) >= 4) apply_mask<MODE>(P0, P1, (j) - 4, u, wid, r32, hi, bias_l); } while (0)
  bf16x8 pa0, pa1, pa2, pa3; const int NT = u.NT;
  if constexpr (SERIAL) {
    f32x16 p0, p1; float mn, al;
    SLOAD(0, 0); asm volatile("s_waitcnt vmcnt(0)" ::: "memory"); SWRITE(0, 0); LBAR();
    for (int j = 0; j < NT; ++j) {
      const int b = j & 1;
      if (j + 1 < NT) SLOAD(0, j + 1);
      SBAR(); qkt<DK>(p0, p1, K_lds + b * SHM_K, qr, kb); MASK(p0, p1, j);
      partialSM(p0, p1, m_reg, mn, al, C, THRS); RESC(al);
      finishSM(p0, p1, al, l_reg, pa0, pa1, pa2, pa3); SBAR();
      pv_all<DV>(o, vb0 + b * SHM_V, pa0, pa1, pa2, pa3); SBAR();
      if (j + 1 < NT) SWRITE(b ^ 1, 0);
      LBAR();
    }
  } else {
  f32x16 pA0, pA1, pB0, pB1; float mnA, mnB, alA, alB;
  constexpr int SE = 0, SO = SDEPTH - 1;
  if constexpr (EARLY) {
  static_assert(!EARLY || SDEPTH == 1, "RING3 is an SDEPTH == 1 schedule");
  int s_prev = 0, s_cur = 0, s_next = 1;
#define ROT3() do { s_prev = s_cur; s_cur = s_next; s_next = (s_next == 2) ? 0 : s_next + 1; } while (0)
  SLOAD(0, 0); asm volatile("s_waitcnt vmcnt(0)" ::: "memory"); SWRITE(0, 0); LBAR();
  SLOAD(0, 1);
  qkt<DK>(pA0, pA1, K_lds, qr, kb); SBAR();
  asm volatile("s_waitcnt vmcnt(0)" ::: "memory"); SWRITE(1, 0); SBAR(); if (2 < NT) SLOAD(0, 2); SBAR();
  partialSM(pA0, pA1, m_reg, mnA, alA, C, THRS); LBAR(); ROT3();
  for (int t = 1; t + 1 < NT; t += 2) {
    asm volatile("s_waitcnt vmcnt(0)" ::: "memory"); SWRITE(s_next, 0); SBAR();
    qkt<DK>(pB0, pB1, K_lds + s_cur * SHM_K, qr, kb); finishSM(pA0, pA1, alA, l_reg, pa0, pa1, pa2, pa3); SBAR();
    if (t + 2 < NT) SLOAD(0, t + 2); SBAR();
    pv_all<DV>(o, vb0 + s_prev * SHM_V, pa0, pa1, pa2, pa3); MASK(pB0, pB1, t); partialSM(pB0, pB1, m_reg, mnB, alB, C, THRS);
    RESC(alB); LBAR(); ROT3();
    asm volatile("s_waitcnt vmcnt(0)" ::: "memory"); SWRITE(s_next, 0); SBAR();
    qkt<DK>(pA0, pA1, K_lds + s_cur * SHM_K, qr, kb); finishSM(pB0, pB1, alB, l_reg, pa0, pa1, pa2, pa3); SBAR();
    if (t + 3 < NT) SLOAD(0, t + 3); SBAR();
    pv_all<DV>(o, vb0 + s_prev * SHM_V, pa0, pa1, pa2, pa3); MASK(pA0, pA1, t + 1); partialSM(pA0, pA1, m_reg, mnA, alA, C, THRS);
    RESC(alA); LBAR(); ROT3();
  }
  SBAR(); qkt<DK>(pB0, pB1, K_lds + s_cur * SHM_K, qr, kb); finishSM(pA0, pA1, alA, l_reg, pa0, pa1, pa2, pa3); SBAR();
  pv_all<DV>(o, vb0 + s_prev * SHM_V, pa0, pa1, pa2, pa3); MASK(pB0, pB1, NT - 1); partialSM(pB0, pB1, m_reg, mnB, alB, C, THRS);
  RESC(alB);
  finishSM(pB0, pB1, alB, l_reg, pa0, pa1, pa2, pa3); SBAR();
  pv_all<DV>(o, vb0 + s_cur * SHM_V, pa0, pa1, pa2, pa3);
#undef ROT3
  } else {
  if constexpr (MODE == 0) {
  SLOAD(SE, 0); asm volatile("s_waitcnt vmcnt(0)" ::: "memory"); SWRITE(0, SE); LBAR();
  qkt<DK>(pA0, pA1, K_lds, qr, kb); partialSM(pA0, pA1, m_reg, mnA, alA, C, THRS);
  SLOAD(SO, 1); if constexpr (SDEPTH == 2) { if (2 < NT) SLOAD(SE, 2); }
  SWAIT(); SWRITE(1, SO); LBAR();
  for (int j = 1; j + 1 < NT; j += 2) {
    SBAR(); qkt<DK>(pB0, pB1, K_lds + SHM_K, qr, kb); finishSM(pA0, pA1, alA, l_reg, pa0, pa1, pa2, pa3); SBAR();
    SLOAD(SO, j + SDEPTH); SBAR();
    pv_all<DV>(o, vb0, pa0, pa1, pa2, pa3); MASK(pB0, pB1, j); partialSM(pB0, pB1, m_reg, mnB, alB, C, THRS);
    LBAR(); SWAIT(); SWRITE(0, SE);
    RESC(alB); LBAR();
    SBAR(); qkt<DK>(pA0, pA1, K_lds, qr, kb); finishSM(pB0, pB1, alB, l_reg, pa0, pa1, pa2, pa3); SBAR();
    if (SDEPTH == 1 || j + 3 < NT) SLOAD(SE, j + 1 + SDEPTH); SBAR();
    pv_all<DV>(o, vb0 + SHM_V, pa0, pa1, pa2, pa3); MASK(pA0, pA1, j + 1); partialSM(pA0, pA1, m_reg, mnA, alA, C, THRS);
    LBAR(); SWAIT(); SWRITE(1, SO);
    RESC(alA); LBAR();
  }
  SBAR(); qkt<DK>(pB0, pB1, K_lds + SHM_K, qr, kb); finishSM(pA0, pA1, alA, l_reg, pa0, pa1, pa2, pa3); SBAR();
  pv_all<DV>(o, vb0, pa0, pa1, pa2, pa3); MASK(pB0, pB1, NT - 1); partialSM(pB0, pB1, m_reg, mnB, alB, C, THRS);
  LBAR(); RESC(alB);
  finishSM(pB0, pB1, alB, l_reg, pa0, pa1, pa2, pa3); SBAR();
  pv_all<DV>(o, vb0 + SHM_V, pa0, pa1, pa2, pa3);
  } else {
  SLOAD(SE, 0); asm volatile("s_waitcnt vmcnt(0)" ::: "memory"); SWRITE(0, SE); LBAR();
  qkt<DK>(pA0, pA1, K_lds, qr, kb); partialSM(pA0, pA1, m_reg, mnA, alA, C, THRS);
  SLOAD(SO, 1); if constexpr (SDEPTH == 2) { if (2 < NT) SLOAD(SE, 2); }
  SWAIT(); SWRITE(1, SO); LBAR();
  bool actA = true, actB = true;
  for (int j = 1; j + 1 < NT; j += 2) {
    actB = tile_active<MODE>(u, j, wid);
    SBAR();
    if (actA && actB) { qkt<DK>(pB0, pB1, K_lds + SHM_K, qr, kb); finishSM(pA0, pA1, alA, l_reg, pa0, pa1, pa2, pa3); }
    else { if (actB) qkt<DK>(pB0, pB1, K_lds + SHM_K, qr, kb); if (actA) finishSM(pA0, pA1, alA, l_reg, pa0, pa1, pa2, pa3); }
    SBAR(); SLOAD(SO, j + SDEPTH); SBAR();
    alB = 1.f;
    if (actA && actB) { pv_all<DV>(o, vb0, pa0, pa1, pa2, pa3); MASK(pB0, pB1, j); partialSM(pB0, pB1, m_reg, mnB, alB, C, THRS); }
    else { if (actA) pv_all<DV>(o, vb0, pa0, pa1, pa2, pa3); if (actB) { MASK(pB0, pB1, j); partialSM(pB0, pB1, m_reg, mnB, alB, C, THRS); } }
    LBAR(); SWAIT(); SWRITE(0, SE);
    RESC(alB); LBAR();
    actA = tile_active<MODE>(u, j + 1, wid);
    SBAR();
    if (actA && actB) { qkt<DK>(pA0, pA1, K_lds, qr, kb); finishSM(pB0, pB1, alB, l_reg, pa0, pa1, pa2, pa3); }
    else { if (actA) qkt<DK>(pA0, pA1, K_lds, qr, kb); if (actB) finishSM(pB0, pB1, alB, l_reg, pa0, pa1, pa2, pa3); }
    SBAR(); if (SDEPTH == 1 || j + 3 < NT) SLOAD(SE, j + 1 + SDEPTH); SBAR();
    alA = 1.f;
    if (actA && actB) { pv_all<DV>(o, vb0 + SHM_V, pa0, pa1, pa2, pa3); MASK(pA0, pA1, j + 1); partialSM(pA0, pA1, m_reg, mnA, alA, C, THRS); }
    else { if (actB) pv_all<DV>(o, vb0 + SHM_V, pa0, pa1, pa2, pa3); if (actA) { MASK(pA0, pA1, j + 1); partialSM(pA0, pA1, m_reg, mnA, alA, C, THRS); } }
    LBAR(); SWAIT(); SWRITE(1, SO);
    RESC(alA); LBAR();
  }
  actB = tile_active<MODE>(u, NT - 1, wid);
  SBAR(); if (actB) qkt<DK>(pB0, pB1, K_lds + SHM_K, qr, kb); if (actA) finishSM(pA0, pA1, alA, l_reg, pa0, pa1, pa2, pa3); SBAR();
  alB = 1.f;
  if (actA) pv_all<DV>(o, vb0, pa0, pa1, pa2, pa3);
  if (actB) { MASK(pB0, pB1, NT - 1); partialSM(pB0, pB1, m_reg, mnB, alB, C, THRS); }
  LBAR(); RESC(alB);
  if (actB) { finishSM(pB0, pB1, alB, l_reg, pa0, pa1, pa2, pa3); SBAR(); pv_all<DV>(o, vb0 + SHM_V, pa0, pa1, pa2, pa3); }
  }
  }
  }
  { int lane2; asm volatile("v_mbcnt_lo_u32_b32 %0, -1, 0\n\tv_mbcnt_hi_u32_b32 %0, -1, %0" : "=v"(lane2)); const int wid2 = wid, r32b = lane2 & 31, hib = lane2 >> 5;
    float* li2 = (float*)(lds + NSL * SHM_V + NSL * SHM_K) + wid2 * 64;
    if (hib == 0) li2[r32b] = l_reg; asm volatile("s_waitcnt lgkmcnt(0)" ::: "memory");
    LBAR();
    bf16_t* stg = (bf16_t*)lds + wid2 * 32 * DV;
#pragma unroll
    for (int r = 0; r < 16; ++r) { const int orow = crow(r, hib); const float rl = __builtin_amdgcn_rcpf(li2[orow]);
#pragma unroll
      for (int d0 = 0; d0 < NO; ++d0) { const unsigned w = cvtpk(o[d0][r] * rl, 0.f); stg[orow * DV + d0 * 32 + r32b] = (bf16_t)(w & 0xffffu); } }
    asm volatile("s_waitcnt lgkmcnt(0)" ::: "memory");
    bf16_t* Ow = u.O + (long)(wid2 * 32) * DM;
#pragma unroll
    for (int i = 0; i < (32 * DV / 8) / 64; ++i) { const int id = i * 64 + lane2, row = id / (DV / 8), ch = id % (DV / 8);
      const u32x4 v = *(const u32x4*)(stg + row * DV + ch * 8); *(u32x4*)(Ow + (long)row * DM + ch * 8) = v; } }
  LBAR();
#undef LBAR
#undef TILE_PTRS
#undef SLOAD
#undef SWRITE
#undef SWAIT
#undef RESC
#undef MASK
}
#undef SBAR
}
typedef unsigned short bf16_t;
typedef float f32x4 __attribute__((ext_vector_type(4)));
typedef unsigned u32x4 __attribute__((ext_vector_type(4)));
typedef unsigned u32x2 __attribute__((ext_vector_type(2)));
#define LAS __attribute__((address_space(3)))
#define XB_TMO      128
#define XB_XCNT(j)  (256  + 64 * (j))
#define XB_XSUB(j)  (1280 + 64 * (j))
#define XB_XGEN(j)  (2304 + 64 * (j))
#define XB_TOP      3328
#define XB_TOPGEN   3392
#define XCD_BAR_WORDS 3456
#define XB_SPIN_CAP (1u << 18)

__device__ __forceinline__ unsigned xb_ld(unsigned* p)              { return __hip_atomic_load(p, __ATOMIC_RELAXED, __HIP_MEMORY_SCOPE_AGENT); }
__device__ __forceinline__ unsigned xb_add(unsigned* p, unsigned v) { return __hip_atomic_fetch_add(p, v, __ATOMIC_RELAXED, __HIP_MEMORY_SCOPE_AGENT); }
__device__ __forceinline__ unsigned xb_xcc_id() { return (unsigned)__builtin_amdgcn_s_getreg((3 << 11) | 20) & 0xFu; }
#define XB_SPIN(cond, bar) do { unsigned _sp = 0; while (cond) { __builtin_amdgcn_s_sleep(1); \
    if ((++_sp & 255u) == 0u) { if (xb_ld(&(bar)[XB_TMO])) break; if (_sp > XB_SPIN_CAP) { atomicAdd(&(bar)[XB_TMO], 1u); break; } } } } while (0)

struct XcdBarrier {
    unsigned* bar; unsigned x;
    volatile LAS unsigned* st;
};

__device__ __forceinline__ XcdBarrier xcd_barrier_post(unsigned* bar, volatile LAS unsigned* st) {
    XcdBarrier b; b.bar = bar; b.x = xb_xcc_id(); b.st = st;
    if (threadIdx.x == 0) (void)xb_add(&bar[XB_XCNT(b.x)], 1u);
    return b;
}
__device__ __forceinline__ void xcd_barrier_complete(unsigned* bar, unsigned x, unsigned& nloc, unsigned& nx) {
    const unsigned G = gridDim.x * gridDim.y * gridDim.z;
    unsigned sum, cnt, mine, sp = 0u;
    for (;;) {
        sum = 0u; cnt = 0u; mine = 0u;
#pragma unroll
        for (unsigned j = 0; j < 16; ++j) { const unsigned c = xb_ld(&bar[XB_XCNT(j)]); sum += c; cnt += (c > 0u) ? 1u : 0u; mine = (j == x) ? c : mine; }
        if (sum == G) break;
        __builtin_amdgcn_s_sleep(1);
        if ((++sp & 255u) == 0u) { if (xb_ld(&bar[XB_TMO])) break; if (sp > XB_SPIN_CAP) { atomicAdd(&bar[XB_TMO], 1u); break; } }
    }
    nloc = mine > 0u ? mine : 1u; nx = cnt > 0u ? cnt : 1u;
}

__device__ __forceinline__ void xcd_barrier(const XcdBarrier& b, const int tid) {
    asm volatile("s_waitcnt vmcnt(0)" ::: "memory");
    __syncthreads();
    if (tid == 0) {
        unsigned* bar = b.bar;
        __builtin_amdgcn_s_waitcnt(0);
        unsigned nloc = b.st[0], nx = b.st[1];
        if (nloc == 0u) { xcd_barrier_complete(bar, b.x, nloc, nx); b.st[0] = nloc; b.st[1] = nx; }
        const unsigned old = xb_add(&bar[XB_XSUB(b.x)], 1u);
        const unsigned gen = old / nloc;
        if (old + 1u == (gen + 1u) * nloc) {
            __builtin_amdgcn_fence(__ATOMIC_RELEASE, "agent");
            asm volatile("s_waitcnt vmcnt(0)" ::: "memory");
            const unsigned og = xb_add(&bar[XB_TOP], 1u);
            const unsigned tg = og / nx;
            if (og + 1u == (tg + 1u) * nx) xb_add(&bar[XB_TOPGEN], 1u);
            else XB_SPIN(xb_ld(&bar[XB_TOPGEN]) == tg, bar);
            __builtin_amdgcn_fence(__ATOMIC_ACQUIRE, "agent");
            xb_add(&bar[XB_XGEN(b.x)], 1u);
            asm volatile("s_waitcnt vmcnt(0)" ::: "memory");
        } else {
            XB_SPIN(xb_ld(&bar[XB_XGEN(b.x)]) == gen, bar);
            __builtin_amdgcn_fence(__ATOMIC_ACQUIRE, "agent");
            asm volatile("s_waitcnt vmcnt(0)" ::: "memory");
        }
    }
    __syncthreads();
}

constexpr size_t MiB = 1u << 20;
constexpr size_t WS_BAR = 7 * MiB, BAR_BYTES = FUSED_NORM ? 1 * MiB : 16384;
constexpr size_t WS_MOD = 0, WS_ROPE = 1 * MiB, WS_XCTX = 3 * MiB;
constexpr size_t WS_WFI = 8 * MiB, WS_WFO = 52 * MiB, WS_WMLA = 74 * MiB, WS_WNA = 85 * MiB, WS_WSWA = 93 * MiB;
constexpr size_t MLA_W_STRIDE = (size_t)(768 * 1024 + 1536 * 256 + 2048 * 256 + 1024 * 1024) * 2;
constexpr size_t MLA_OFF_UQ = (size_t)768 * 1024 * 2, MLA_OFF_UKV = MLA_OFF_UQ + (size_t)1536 * 256 * 2, MLA_OFF_WO = MLA_OFF_UKV + (size_t)2048 * 256 * 2;
constexpr size_t WS_XN = 98 * MiB, WS_S = 164 * MiB, WS_Q = 197 * MiB, WS_K = 296 * MiB, WS_V = 395 * MiB, WS_SLOT = 461 * MiB, WS_PART = 463 * MiB, WS_END = 507 * MiB, WS_KPE = 463 * MiB, WS_NEED = 468 * MiB;
constexpr size_t SLOT_BYTES = (size_t)TOK * 4 * 4;
constexpr size_t WS_CNT = 7 * MiB + 65536, CNT_BANK = 132 * 256;
static_assert(WS_SLOT + 2 * SLOT_BYTES <= WS_PART && WS_PART + (size_t)11 * NCTX * DM * 4 <= WS_END && WS_CNT + 16 * CNT_BANK <= 8 * MiB, "slots/counters");
static_assert(WS_WMLA + 2 * MLA_W_STRIDE <= WS_WNA && WS_XN + (size_t)TOK * DM * 2 <= WS_S && WS_S + (size_t)TOK * 512 * 2 <= WS_Q, "ws map");
static_assert(WS_Q + (size_t)TOK * 1536 * 2 <= WS_K && WS_K + (size_t)TOK * 8 * 192 * 2 <= WS_V && WS_V + (size_t)TOK * DM * 2 <= WS_SLOT, "ws map 2");
static_assert(WS_Q + (size_t)TOK * 3072 * 2 <= WS_V && WS_Q + (size_t)TOK * DFF * 2 <= WS_V, "overlays");
static_assert(FUSE_LAT && !SPLIT_CTX && WS_KPE + (size_t)NBATCH * MLA_KEYS * 64 * 2 <= WS_NEED, "the shared rotary-key buffer is written by the fused latent epilogue and overlays WS_PART");
constexpr int LDS_BYTES = 147456, NWAVES = 8, NTHREADS = 512;
constexpr float NORM_EPS = 1e-6f;

struct WDesc { const float* src; bf16_t* dst; int K, N, Np, kind, first, pad; };
constexpr int NWD = 20;
struct Params {
  const float* in[24]; float* out; unsigned char* ws;
  int nph, lo, hi, nitems;
  unsigned char prog[64];
  WDesc wd[NWD];
};

__device__ __forceinline__ unsigned f2bf(float f) { unsigned u = __builtin_bit_cast(unsigned, f); return (u + 0x7fffu + ((u >> 16) & 1u)) >> 16; }
__device__ __forceinline__ unsigned pk2(float lo, float hi) { return f2bf(lo) | (f2bf(hi) << 16); }
__device__ __forceinline__ float bf2f(unsigned short b) { return __builtin_bit_cast(float, (unsigned)b << 16); }
__device__ __forceinline__ float wave_sum(float v, int lane) {
#pragma unroll
  for (int o = 1; o < 64; o <<= 1) v += __builtin_bit_cast(float, __builtin_amdgcn_ds_bpermute((lane ^ o) << 2, __builtin_bit_cast(int, v)));
  return v;
}
__device__ __forceinline__ int srccol(int kind, int np) {
  switch (kind) {
    case 1: { const int grp = np >> 3, w = np & 7; return (w < 4) ? grp * 4 + w : DFF + grp * 4 + (w - 4); }
    case 2: { if (np < 512) return np; if (np < 576) { const int q = np - 512; return 512 + (q >> 1) + 32 * (q & 1); } return -1; }
    case 3: { const int h = np / 192, w = np % 192; if (w < 128) return np; const int q = w - 128; return h * 192 + 128 + (q >> 1) + 32 * (q & 1); }
    case 4: { if (np >= 1152) return np; const int hh = np >> 6, q = np & 63; return hh * 64 + (q >> 1) + 32 * (q & 1); }
    default: return np;
  }
}
__device__ __forceinline__ void transpose_item(const WDesc& d, LAS float* scr, int item, int lane) {
  const int nblk = d.Np / 32, kb = item / nblk, nb = item % nblk, k0 = 64 * kb, n0 = 32 * nb;
  const int sc = srccol(d.kind, n0 + (lane & 31));
  float tv[32];
#pragma unroll
  for (int i = 0; i < 32; ++i) { const int kk = 2 * i + (lane >> 5); tv[i] = (sc >= 0) ? __builtin_nontemporal_load(d.src + (size_t)(k0 + kk) * d.N + sc) : 0.f; }
#pragma unroll
  for (int i = 0; i < 32; ++i) { const int kk = 2 * i + (lane >> 5); scr[kk * 33 + (lane & 31)] = tv[i]; }
  asm volatile("s_waitcnt lgkmcnt(0)" ::: "memory");
  const int c = lane & 7;
#pragma unroll
  for (int j = 0; j < 4; ++j) { const int n = (lane >> 3) + 8 * j; const LAS float* s = scr + (8 * c) * 33 + n;
    u32x4 o; o.x = pk2(s[0 * 33], s[1 * 33]); o.y = pk2(s[2 * 33], s[3 * 33]); o.z = pk2(s[4 * 33], s[5 * 33]); o.w = pk2(s[6 * 33], s[7 * 33]);
    *(u32x4*)(d.dst + (size_t)(n0 + n) * d.K + k0 + 8 * c) = o; }
  asm volatile("s_waitcnt lgkmcnt(0)" ::: "memory");
}
__device__ __forceinline__ float* xrow(const Params& P, int row) { return row < NLAT ? P.out + (size_t)row * DM : (float*)(P.ws + WS_XCTX) + (size_t)(row - NLAT) * DM; }
__device__ __forceinline__ const float* modvec(const Params& P, int layer, int row, int which) {
  const int r = row < NLAT ? (row >> 13) : 4; return (const float*)(P.ws + WS_MOD) + ((size_t)(layer * 5 + r) * 6 + which) * DM;
}
template <int NR> __device__ __forceinline__ void wave_sum_n(float (&s)[NR], int lane) {
#pragma unroll
  for (int o = 1; o < 64; o <<= 1) {
#pragma unroll
    for (int i = 0; i < NR; ++i) s[i] += __builtin_bit_cast(float, __builtin_amdgcn_ds_bpermute((lane ^ o) << 2, __builtin_bit_cast(int, s[i]))); }
}
__device__ __forceinline__ void row_pass_ctx(const Params& P, int gw, int NGW, int lane, const float* xs_ctx, const float* part, int nsplit, const float* g_post, int l_gate, int w_gate,
    const float* g_pre, int l_norm, int w_shift, int w_scale, float gscale) {
  for (int r = gw; r < NCTX; r += NGW) { const int row = NLAT + r;
    f32x4 a[4], v[4];
#pragma unroll
    for (int j = 0; j < 4; ++j) { a[j] = (f32x4){0.f, 0.f, 0.f, 0.f}; v[j] = *(const f32x4*)(xs_ctx + (size_t)r * DM + 4 * lane + 256 * j); }
    for (int s = 0; s < nsplit; ++s) {
#pragma unroll
      for (int j = 0; j < 4; ++j) a[j] += *(const f32x4*)(part + ((size_t)s * NCTX + r) * DM + 4 * lane + 256 * j); }
    float ss = 0.f;
#pragma unroll
    for (int j = 0; j < 4; ++j) ss += (a[j][0] * a[j][0] + a[j][1] * a[j][1]) + (a[j][2] * a[j][2] + a[j][3] * a[j][3]);
    float rstd = 1.0f / sqrtf(wave_sum(ss, lane) * (1.0f / DM) + NORM_EPS);
    const float* gate = modvec(P, l_gate, row, w_gate); float* xd = xrow(P, row);
#pragma unroll
    for (int j = 0; j < 4; ++j) { const int c = 4 * lane + 256 * j; const f32x4 g = *(const f32x4*)(g_post + c), gt = *(const f32x4*)(gate + c) * gscale; v[j] = v[j] + gt * (a[j] * rstd * g); *(f32x4*)(xd + c) = v[j]; }
    ss = 0.f;
#pragma unroll
    for (int j = 0; j < 4; ++j) ss += (v[j][0] * v[j][0] + v[j][1] * v[j][1]) + (v[j][2] * v[j][2] + v[j][3] * v[j][3]);
    rstd = 1.0f / sqrtf(wave_sum(ss, lane) * (1.0f / DM) + NORM_EPS);
    const float* shift = modvec(P, l_norm, row, w_shift); const float* scale = modvec(P, l_norm, row, w_scale); bf16_t* xn = (bf16_t*)(P.ws + WS_XN) + (size_t)row * DM;
#pragma unroll
    for (int j = 0; j < 4; ++j) { const int c = 4 * lane + 256 * j; const f32x4 g = *(const f32x4*)(g_pre + c), sh = *(const f32x4*)(shift + c), sc = *(const f32x4*)(scale + c);
      const f32x4 h = (v[j] * rstd * g) * (1.0f + sc) + sh; u32x2 w; w.x = pk2(h[0], h[1]); w.y = pk2(h[2], h[3]); *(u32x2*)(xn + c) = w; }
  }
}
template <int NR> __device__ __forceinline__ void row_pass_multi(const Params& P, int gw, int NGW, int nrows, int lane, const float* xs_lat, const float* xs_ctx,
    bool has_res, const bf16_t* src, const float* g_post, int l_gate, int w_gate, bool do_norm, const float* g_pre, int l_norm, int w_shift, int w_scale, float gscale = 1.0f) {
  f32x4 gp[4], gq[4], gtv[4], shv[4], scv[4]; int cur_g = -1, cur_n = -1;
#pragma unroll
  for (int j = 0; j < 4; ++j) { gp[j] = has_res ? *(const f32x4*)(g_post + 4 * lane + 256 * j) : (f32x4){0.f, 0.f, 0.f, 0.f}; gq[j] = do_norm ? *(const f32x4*)(g_pre + 4 * lane + 256 * j) : (f32x4){0.f, 0.f, 0.f, 0.f};
    gtv[j] = shv[j] = scv[j] = (f32x4){0.f, 0.f, 0.f, 0.f}; }
  for (int base = gw * NR; base < nrows; base += NR * NGW) {
    u32x2 raw[NR][4]; f32x4 v[NR][4];
#pragma unroll
    for (int i = 0; i < NR; ++i) { const int row = base + i;
      if (row < nrows) { const float* xs = row < NLAT ? xs_lat + (size_t)row * DM : xs_ctx + (size_t)(row - NLAT) * DM;
#pragma unroll
        for (int j = 0; j < 4; ++j) v[i][j] = __builtin_nontemporal_load((const f32x4*)(xs + 4 * lane + 256 * j));
        if (has_res) {
#pragma unroll
          for (int j = 0; j < 4; ++j) raw[i][j] = __builtin_nontemporal_load((const u32x2*)(src + (size_t)row * DM + 4 * lane + 256 * j)); }
      } else {
#pragma unroll
        for (int j = 0; j < 4; ++j) { v[i][j] = (f32x4){0.f, 0.f, 0.f, 0.f}; raw[i][j] = (u32x2){0u, 0u}; } } }
    if (has_res) {
      float ss[NR];
#pragma unroll
      for (int i = 0; i < NR; ++i) { ss[i] = 0.f;
#pragma unroll
        for (int j = 0; j < 4; ++j) { const float a0 = __builtin_bit_cast(float, raw[i][j].x << 16), a1 = __builtin_bit_cast(float, raw[i][j].x & 0xffff0000u), a2 = __builtin_bit_cast(float, raw[i][j].y << 16), a3 = __builtin_bit_cast(float, raw[i][j].y & 0xffff0000u);
          ss[i] += (a0 * a0 + a1 * a1) + (a2 * a2 + a3 * a3); } }
      wave_sum_n<NR>(ss, lane);
#pragma unroll
      for (int i = 0; i < NR; ++i) { const int row = base + i;
        if (row < nrows) { const float rstd = 1.0f / sqrtf(ss[i] * (1.0f / DM) + NORM_EPS); float* xd = xrow(P, row);
          const int rm = row < NLAT ? (row >> 13) : 4;
          if (rm != cur_g) { const float* gate = modvec(P, l_gate, row, w_gate); cur_g = rm;
#pragma unroll
            for (int j = 0; j < 4; ++j) gtv[j] = *(const f32x4*)(gate + 4 * lane + 256 * j) * gscale; }
#pragma unroll
          for (int j = 0; j < 4; ++j) { const int c = 4 * lane + 256 * j; const f32x4 g = gp[j], gt = gtv[j];
            f32x4 a; a[0] = __builtin_bit_cast(float, raw[i][j].x << 16); a[1] = __builtin_bit_cast(float, raw[i][j].x & 0xffff0000u); a[2] = __builtin_bit_cast(float, raw[i][j].y << 16); a[3] = __builtin_bit_cast(float, raw[i][j].y & 0xffff0000u);
            v[i][j] = v[i][j] + gt * (a * rstd * g); __builtin_nontemporal_store(v[i][j], (f32x4*)(xd + c)); } } }
    }
    if (do_norm) {
      float ss[NR];
#pragma unroll
      for (int i = 0; i < NR; ++i) { ss[i] = 0.f;
#pragma unroll
        for (int j = 0; j < 4; ++j) ss[i] += (v[i][j][0] * v[i][j][0] + v[i][j][1] * v[i][j][1]) + (v[i][j][2] * v[i][j][2] + v[i][j][3] * v[i][j][3]); }
      wave_sum_n<NR>(ss, lane);
#pragma unroll
      for (int i = 0; i < NR; ++i) { const int row = base + i;
        if (row < nrows) { const float rstd = 1.0f / sqrtf(ss[i] * (1.0f / DM) + NORM_EPS);
          const int rm = row < NLAT ? (row >> 13) : 4;
          if (rm != cur_n) { const float* shift = modvec(P, l_norm, row, w_shift); const float* scale = modvec(P, l_norm, row, w_scale); cur_n = rm;
#pragma unroll
            for (int j = 0; j < 4; ++j) { shv[j] = *(const f32x4*)(shift + 4 * lane + 256 * j); scv[j] = *(const f32x4*)(scale + 4 * lane + 256 * j); } }
          bf16_t* xn = (bf16_t*)(P.ws + WS_XN) + (size_t)row * DM;
#pragma unroll
          for (int j = 0; j < 4; ++j) { const int c = 4 * lane + 256 * j; const f32x4 g = gq[j], sh = shv[j], sc = scv[j];
            const f32x4 h = (v[i][j] * rstd * g) * (1.0f + sc) + sh; u32x2 w; w.x = pk2(h[0], h[1]); w.y = pk2(h[2], h[3]); *(u32x2*)(xn + c) = w; } } }
    }
  }
}

typedef const __attribute__((address_space(4))) Params* KargPtr;
__global__ void __launch_bounds__(NTHREADS, 2) fwd_mega(Params Pbyval) {
  extern __shared__ __attribute__((aligned(16))) unsigned char lds[];
  cg::grid_group grid = cg::this_grid();
  volatile LAS unsigned* bst = (volatile LAS unsigned*)((LAS unsigned char*)lds + (LDS_BYTES - 64));
  if (threadIdx.x < 2) bst[threadIdx.x] = 0u;
  __syncthreads();
  XcdBarrier xbar = xcd_barrier_post((unsigned*)(Pbyval.ws + WS_BAR), bst);
  const int G0 = gridDim.x, bx0 = blockIdx.x;
  const int ph_lo = Pbyval.lo, ph_hi = Pbyval.hi;

  const int wave0 = __builtin_amdgcn_readfirstlane(threadIdx.x >> 6);
  int ph_start = ph_lo;
  if (ph_lo == 0) {
    const int tid = threadIdx.x, lane = tid & 63, wave = wave0, G = G0, bx = bx0;
    const int vcu = (G % 8 == 0) ? (bx % 8) * (G / 8) + bx / 8 : bx, NGW = G * NWAVES, gw = vcu * NWAVES + wave;
    const Params& P = Pbyval; unsigned char* ws = P.ws;
      { LAS float* sc_l = (LAS float*)lds;
        LAS float* red = sc_l + 5 * DM;
        for (int i = tid; i < 5 * DM; i += NTHREADS) { const int r = i >> 10, k = i & 1023; const float c = (r < 4) ? P.in[1][r * DM + k] : P.in[3][k]; sc_l[i] = c / (1.0f + __expf(-c)); }
        __syncthreads();
        for (int task = bx; task < DEPTH * 96; task += G) { const int ly = task / 96, n0 = (task % 96) * 64;
          const float* W = P.in[4] + (size_t)ly * DM * 6 * DM + n0 + lane; float acc[5] = {0.f, 0.f, 0.f, 0.f, 0.f};
#pragma unroll 16
          for (int k = wave * 128; k < wave * 128 + 128; ++k) { const float w = __builtin_nontemporal_load(W + (size_t)k * 6 * DM);
#pragma unroll
            for (int r = 0; r < 5; ++r) acc[r] += sc_l[r * DM + k] * w; }
#pragma unroll
          for (int r = 0; r < 5; ++r) red[(wave * 5 + r) * 64 + lane] = acc[r];
          __syncthreads();
          if (tid < 320) { const int r = tid >> 6, n = tid & 63; float s = P.in[5][(size_t)ly * 6 * DM + n0 + n];
#pragma unroll
            for (int w = 0; w < 8; ++w) s += red[(w * 5 + r) * 64 + n];
            const int col = n0 + n; ((float*)(ws + WS_MOD))[((size_t)(ly * 5 + r) * 6 + (col >> 10)) * DM + (col & 1023)] = s; }
          __syncthreads(); }
      }
    ph_start = 1;
    if (ph_hi > 1) grid.sync();
  }
  int rep = 0; (void)rep;
#ifdef PROBE_EXTRA_SYNCS
  for (int i = 0; i < PROBE_EXTRA_SYNCS; ++i) xcd_barrier(xbar, (int)threadIdx.x);
#endif
  for (int ph = ph_start; ph < ph_hi; ++ph) {
#define FRESH_LANE(v) int v; asm volatile("v_mbcnt_lo_u32_b32 %0, -1, 0\n\tv_mbcnt_hi_u32_b32 %0, -1, %0" : "=v"(v))
    int wave = wave0; asm volatile("" : "+s"(wave));
    int G = G0, bx = bx0; asm volatile("" : "+s"(G), "+s"(bx));
    KargPtr Pq = (KargPtr)__builtin_amdgcn_kernarg_segment_ptr(); asm volatile("" : "+s"(Pq));
    const Params& P = *(const Params*)Pq;
    const int vcu = (G % 8 == 0) ? (bx % 8) * (G / 8) + bx / 8 : bx;
    const int NGW = G * NWAVES;
    const int gw = vcu * NWAVES + wave;
    unsigned char* ws = P.ws;
    const float* rope = (const float*)(ws + WS_ROPE);
    bf16_t* XN = (bf16_t*)(ws + WS_XN); bf16_t* SB = (bf16_t*)(ws + WS_S); bf16_t* QB = (bf16_t*)(ws + WS_Q); bf16_t* KB = (bf16_t*)(ws + WS_K); bf16_t* VB = (bf16_t*)(ws + WS_V);
    const int code = P.prog[ph], l = code >> 4, step = code & 15, kind = l % 3, jl = l / 3; const bool last = (l == DEPTH - 1);
    if (step == 1) {
      FRESH_LANE(lane); const int tid = wave * 64 + lane;
      { LAS float* scr = (LAS float*)lds + wave * (64 * 33);
        for (int it = gw; it < P.nitems; it += NGW) { int m = 0;
#pragma unroll 1
          for (int q = 1; q < NWD; ++q) if (it >= P.wd[q].first) m = q;
          transpose_item(P.wd[m], scr, it - P.wd[m].first, lane); } }
      for (int i = bx * NTHREADS + tid; i < SEQ * 32; i += G * NTHREADS) { const int t = i >> 5, p = i & 31; const float inv = powf(10000.0f, -(float)(p & 15) / 16.0f);
        const float ang = (float)((p < 16) ? (t >> 6) : (t & 63)) * inv; ((float*)(ws + WS_ROPE))[2 * i] = cosf(ang); ((float*)(ws + WS_ROPE))[2 * i + 1] = sinf(ang); }
      row_pass_multi<4>(P, gw, NGW, TOK, lane, P.in[0], P.in[2], false, nullptr, nullptr, 0, 0, true, P.in[6], 0, 0, 1);
#if FUSED_NORM
    } else if (step == 6 || step == 9) {
      pg8::Gemm g; g.M = last ? NLAT : TOK; g.N = DM;
      const unsigned char* wm = ws + WS_WMLA + (size_t)jl * MLA_W_STRIDE;
      pg8::NormArgs na; na.xlat = P.out; na.xctx = (float*)(ws + WS_XCTX); na.xn = XN; na.modl = (const float*)(ws + WS_MOD) + (size_t)l * 30 * DM;
      na.slot1 = (float*)(ws + WS_SLOT); na.slot2 = (float*)(ws + WS_SLOT + SLOT_BYTES);
      const int bank = (l * 2 + (step == 9 ? 1 : 0)) * 2; na.cnt1 = (unsigned*)(ws + WS_CNT + (size_t)bank * CNT_BANK); na.cnt2 = (unsigned*)(ws + WS_CNT + (size_t)(bank + 1) * CNT_BANK);
      if (step == 6) { g.A = XN; g.K = DM;
        g.Bt = (kind == 0) ? (const bf16_t*)(wm + MLA_OFF_WO) : (kind == 1) ? (const bf16_t*)(ws + WS_WNA + (size_t)3072 * 1024 * 2) : (const bf16_t*)(ws + WS_WSWA + (size_t)1280 * 1024 * 2);
        na.g_post = P.in[7] + l * DM; na.wgate = 2; na.do_norm = 1; na.g_pre = P.in[8] + l * DM; na.modn = na.modl; na.wshift = 3; na.wscale = 4;
      } else { g.A = QB; g.K = DFF; g.Bt = (const bf16_t*)(ws + WS_WFO) + (size_t)l * DM * DFF;
        const int ln = last ? l : l + 1;
        na.g_post = P.in[9] + l * DM; na.wgate = 5; na.do_norm = last ? 0 : 1; na.g_pre = P.in[6] + ln * DM; na.modn = (const float*)(ws + WS_MOD) + (size_t)ln * 30 * DM; na.wshift = 0; na.wscale = 1; }
      pg8::PanelOrder S; S.init(g.M, G, vcu); pg8::EpiNorm E{na, (LAS unsigned char*)lds + 131072};
#ifndef DBG_NO_GEMM
      FRESH_LANE(lane_f);
      pg8::gemm_phase<pg8::EpiNorm, pg8::PanelOrder, true, true>((LAS unsigned char*)lds, g, S, E, wave * 64 + lane_f);
#endif
      __syncthreads();
#endif
    } else if (step == 2 || step == 4 || step == 8 || ((step == 6 || step == 9) && !FUSED_NORM)) {
      const bool splitctx = SPLIT_CTX && (step == 6 || step == 9) && !last;
      const int ng = (step == 4 || splitctx) ? 2 : 1;
      for (int gi = 0; gi < ng; ++gi) {
        int nsplit = 1;
        pg8::Gemm g; g.nts = 0; pg8::EpiArgs ea; ea.rope = rope; ea.o1 = nullptr; ea.ldc = DM; ea.kind = 0; ea.o0 = nullptr; ea.g0 = nullptr; ea.g1 = nullptr; ea.xl = (LAS unsigned char*)lds + 131072;
        const unsigned char* wm = ws + WS_WMLA + (size_t)jl * MLA_W_STRIDE;
        g.M = (step >= 6 && (last || splitctx)) ? NLAT : TOK;
        if (step == 2) { g.A = XN; g.K = DM;
#if FUSE_LAT
          if (kind == 0) { g.Bt = (const bf16_t*)wm; g.N = 768; ea.kind = 6; ea.o0 = SB; ea.o1 = (bf16_t*)(ws + WS_KPE); ea.g0 = P.in[13] + jl * 256; ea.g1 = P.in[15] + jl * 256; }
#else
          if (kind == 0) { g.Bt = (const bf16_t*)wm; g.N = 768; ea.kind = 0; ea.o0 = VB; ea.ldc = 768; }
#endif
          else if (kind == 1) { g.Bt = (const bf16_t*)(ws + WS_WNA); g.N = 3072; ea.kind = 0; ea.o0 = QB; ea.ldc = 3072; }
          else { g.Bt = (const bf16_t*)(ws + WS_WSWA); g.N = 1280; ea.kind = 4; ea.o0 = QB; }
        } else if (step == 4) { g.K = 256;
          if (gi == 0) { g.A = SB; g.Bt = (const bf16_t*)(wm + MLA_OFF_UQ); g.N = 1536; ea.kind = 2; ea.o0 = QB; }
          else { g.A = SB + (size_t)TOK * 256; g.Bt = (const bf16_t*)(wm + MLA_OFF_UKV); g.N = 2048; ea.kind = 3; ea.o0 = KB; ea.o1 = VB; }
        } else if (step == 6) { g.A = XN; g.K = DM; g.N = DM; ea.kind = 0; ea.o0 = VB; ea.ldc = DM;
          g.Bt = (kind == 0) ? (const bf16_t*)(wm + MLA_OFF_WO) : (kind == 1) ? (const bf16_t*)(ws + WS_WNA + (size_t)3072 * 1024 * 2) : (const bf16_t*)(ws + WS_WSWA + (size_t)1280 * 1024 * 2);
        } else if (step == 8) { g.A = XN; g.K = DM; g.N = 2 * DFF; g.Bt = (const bf16_t*)(ws + WS_WFI) + (size_t)l * 2 * DFF * DM; ea.kind = 1; ea.o0 = QB; }
        else { g.A = QB; g.K = DFF; g.N = DM; g.Bt = (const bf16_t*)(ws + WS_WFO) + (size_t)l * DM * DFF; ea.kind = 0; ea.o0 = VB; ea.ldc = DM; }
        if (splitctx && gi == 1) {
          g.A += (size_t)NLAT * g.K; g.M = NCTX; g.nts = (step == 6) ? 2 : 4; nsplit = g.K / (g.nts * 64); ea.kind = 5; ea.o0 = (bf16_t*)(ws + WS_PART); }
        pg8::StaticOrder S; S.init(g.M, g.N, G, bx, nsplit); pg8::EpiGen E{ea};
#ifndef DBG_NO_GEMM
        int lane_g; asm volatile("v_mbcnt_lo_u32_b32 %0, -1, 0\n\tv_mbcnt_hi_u32_b32 %0, -1, %0" : "=v"(lane_g));
        pg8::gemm_phase<pg8::EpiGen, pg8::StaticOrder, true, true>((LAS unsigned char*)lds, g, S, E, wave * 64 + lane_g);
#endif
        __syncthreads();
      }
    } else if (step == 3) {
      FRESH_LANE(lane);
      const bf16_t* A1 = VB; const float* gq = P.in[13] + jl * 256; const float* gkv = P.in[15] + jl * 256;
      constexpr int NR = 4;
      for (int base = gw; base < TOK; base += NR * NGW) {
        u32x2 w[NR][2]; unsigned wk[NR]; float ss[2 * NR];
#pragma unroll
        for (int i = 0; i < NR; ++i) { const int row = base + i * NGW; const bf16_t* a = A1 + (size_t)(row < TOK ? row : 0) * 768;
          w[i][0] = __builtin_nontemporal_load((const u32x2*)(a + 4 * lane)); w[i][1] = __builtin_nontemporal_load((const u32x2*)(a + 256 + 4 * lane)); wk[i] = __builtin_nontemporal_load((const unsigned*)(a + 512 + 2 * (lane & 31))); }
#pragma unroll
        for (int i = 0; i < NR; ++i)
#pragma unroll
          for (int part = 0; part < 2; ++part) { const float x0 = __builtin_bit_cast(float, w[i][part].x << 16), x1 = __builtin_bit_cast(float, w[i][part].x & 0xffff0000u), x2 = __builtin_bit_cast(float, w[i][part].y << 16), x3 = __builtin_bit_cast(float, w[i][part].y & 0xffff0000u);
            ss[2 * i + part] = (x0 * x0 + x1 * x1) + (x2 * x2 + x3 * x3); }
        wave_sum_n<2 * NR>(ss, lane);
#pragma unroll
        for (int i = 0; i < NR; ++i) { const int row = base + i * NGW; if (row >= TOK) continue;
#pragma unroll
          for (int part = 0; part < 2; ++part) { const float x0 = __builtin_bit_cast(float, w[i][part].x << 16), x1 = __builtin_bit_cast(float, w[i][part].x & 0xffff0000u), x2 = __builtin_bit_cast(float, w[i][part].y << 16), x3 = __builtin_bit_cast(float, w[i][part].y & 0xffff0000u);
            const float rstd = 1.0f / sqrtf(ss[2 * i + part] * (1.0f / 256.0f) + NORM_EPS);
            const f32x4 g = *(const f32x4*)((part ? gkv : gq) + 4 * lane); u32x2 o; o.x = pk2(x0 * rstd * g[0], x1 * rstd * g[1]); o.y = pk2(x2 * rstd * g[2], x3 * rstd * g[3]);
            *(u32x2*)(SB + (size_t)part * TOK * 256 + (size_t)row * 256 + 4 * lane) = o; }
          if (lane < 32) { float x1 = __builtin_bit_cast(float, wk[i] << 16), x2 = __builtin_bit_cast(float, wk[i] & 0xffff0000u);
            int b, key;
            if (row < NLAT) { const int t = row & (SEQ - 1); const float c = rope[(t * 32 + lane) * 2], s = rope[(t * 32 + lane) * 2 + 1]; const float y1 = x1 * c - x2 * s, y2 = x2 * c + x1 * s; x1 = y1; x2 = y2; b = row >> 13; key = LC + t; }
            else { const int r2 = row - NLAT; b = r2 >> 8; key = r2 & 255; }
            const unsigned o = pk2(x1, x2);
#pragma unroll
            for (int h = 0; h < 8; ++h) *(unsigned*)(KB + ((size_t)(b * 8 + h) * MLA_KEYS + key) * 192 + 128 + 2 * lane) = o; } }
      }
    } else if (step == 5) {
      float* bias_l = (float*)(lds + 135168);
      if (kind == 0) {
        const int nun = last ? 1024 : 1056;
        for (int id = vcu; id < nun; id += G) { int lane_u; asm volatile("v_mbcnt_lo_u32_b32 %0, -1, 0\n\tv_mbcnt_hi_u32_b32 %0, -1, %0" : "=v"(lane_u)); const int tid_u = wave * 64 + lane_u;     att::UnitP u; u.m0 = -1e30f; u.l0 = 0.f; u.a0 = 0; u.a1 = 0;
          int bh, row0; if (id < 1024) { bh = id >> 5; row0 = (bh >> 3) * SEQ + (id & 31) * 256; u.NT = 4 + SEQ / 64; } else { bh = id - 1024; row0 = NLAT + (bh >> 3) * LC; u.NT = 4; }
          const int h = bh & 7; const bf16_t* Kbh = KB + (size_t)bh * MLA_KEYS * 128; const bf16_t* Vbh = VB + (size_t)bh * MLA_KEYS * 128;
          u.Pc = (const bf16_t*)(ws + WS_KPE) + (size_t)(bh >> 3) * MLA_KEYS * 64; u.Pn = u.Pc + (size_t)LC * 64;
          u.Q = QB + (size_t)row0 * 1536 + h * 192; u.Kc = Kbh; u.Vc = Vbh; u.Kn = Kbh + (size_t)LC * 128; u.Vn = Vbh + (size_t)LC * 128; u.O = XN + (size_t)row0 * DM + h * 128;
#ifndef DBG_NO_ATT0
          att::attn_unit<192, 128, 1536, 128, 128, 0, MLA_SDEPTH, MLA_SERIAL, MLA_EARLY>(u, (char*)lds, bias_l, tid_u);
#endif
        }
      } else if (kind == 1) {
        const float* rpb = P.in[19] + (size_t)jl * 16 * 465;
        const int nun = last ? 2048 : 2112;
        for (int id = vcu; id < nun; id += G) { int lane_u; asm volatile("v_mbcnt_lo_u32_b32 %0, -1, 0\n\tv_mbcnt_hi_u32_b32 %0, -1, %0" : "=v"(lane_u)); const int tid_u = wave * 64 + lane_u;     att::UnitP u; u.m0 = -1e30f; u.l0 = 0.f;
          int bh, row0, qb = 0; if (id < 2048) { bh = id >> 5; qb = id & 31; row0 = (bh >> 4) * SEQ + qb * 256; u.NT = 16; } else { bh = id - 2048; row0 = NLAT + (bh >> 4) * LC; u.NT = 4; }
          const int b = bh >> 4, h = bh & 15; const int R0 = qb * 4, KR0 = min(max(R0 - 4, 0), 116); u.a0 = R0; u.a1 = KR0;
          u.Q = QB + (size_t)row0 * 3072 + h * 64; u.Kc = QB + (size_t)(NLAT + b * LC) * 3072 + 1024 + h * 64; u.Vc = u.Kc + 1024;
          u.Kn = QB + (size_t)(b * SEQ + KR0 * 64) * 3072 + 1024 + h * 64; u.Vn = u.Kn + 1024; u.O = XN + (size_t)row0 * DM + h * 64;
          if (tid_u < 465) bias_l[tid_u] = rpb[h * 465 + tid_u] * 8.0f;
          __syncthreads();
#ifndef DBG_NO_ATT1
          att::attn_unit<64, 64, 3072, 3072, 3072, 1, NS_SDEPTH, false, false>(u, (char*)lds, bias_l, tid_u);
#endif
        }
      } else {
        const float* sink = P.in[22] + (size_t)jl * 16;
        const int nun = last ? 2048 : 2112;
        for (int id = vcu; id < nun; id += G) { int lane_u; asm volatile("v_mbcnt_lo_u32_b32 %0, -1, 0\n\tv_mbcnt_hi_u32_b32 %0, -1, %0" : "=v"(lane_u)); const int tid_u = wave * 64 + lane_u;     att::UnitP u; u.a1 = 0;
          int bh, row0, qb = 0; if (id < 2048) { bh = id >> 5; qb = id & 31; row0 = (bh >> 4) * SEQ + qb * 256; u.NT = 12; } else { bh = id - 2048; row0 = NLAT + (bh >> 4) * LC; u.NT = 4; }
          const int b = bh >> 4, h = bh & 15, kvh = h >> 3; u.a0 = qb * 256; u.m0 = sink[h] * 8.0f; u.l0 = 1.0f;
          u.Q = QB + (size_t)row0 * 1280 + h * 64; u.Kc = QB + (size_t)(NLAT + b * LC) * 1280 + 1024 + kvh * 64; u.Vc = u.Kc + 128;
          u.Kn = QB + (size_t)(b * SEQ) * 1280 + 1024 + kvh * 64; u.Vn = u.Kn + 128; u.O = XN + (size_t)row0 * DM + h * 64;
#ifndef DBG_NO_ATT2
          att::attn_unit<64, 64, 1280, 1280, 1280, 2, NS_SDEPTH, false, false>(u, (char*)lds, bias_l, tid_u);
#endif
        }
      }
    } else if (step == 7) {
      FRESH_LANE(lane);
      const float gsc = rep ? 0.0f : 1.0f; const bool first = (l == 0 && !rep);
      row_pass_multi<4>(P, gw, NGW, (SPLIT_CTX || last) ? NLAT : TOK, lane, first ? P.in[0] : P.out, first ? P.in[2] : (const float*)(ws + WS_XCTX), true, VB, P.in[7] + l * DM, l, 2, true, P.in[8] + l * DM, l, 3, 4, gsc);
      if (SPLIT_CTX && !last) row_pass_ctx(P, gw, NGW, lane, first ? P.in[2] : (const float*)(ws + WS_XCTX), (const float*)(ws + WS_PART), 8, P.in[7] + l * DM, l, 2, P.in[8] + l * DM, l, 3, 4, gsc);
    } else if (step == 10) {
      FRESH_LANE(lane);
      const int ln = last ? l : l + 1; const float gsc = rep ? 0.0f : 1.0f;
      row_pass_multi<4>(P, gw, NGW, (SPLIT_CTX || last) ? NLAT : TOK, lane, P.out, (const float*)(ws + WS_XCTX), true, VB, P.in[9] + l * DM, l, 5, !last, P.in[6] + ln * DM, ln, 0, 1, gsc);
      if (SPLIT_CTX && !last) row_pass_ctx(P, gw, NGW, lane, (const float*)(ws + WS_XCTX), (const float*)(ws + WS_PART), 11, P.in[9] + l * DM, l, 5, P.in[6] + ln * DM, ln, 0, 1, gsc);
    }
#ifdef PROBE_MASK
    if (((PROBE_MASK >> step) & 1) && (PROBE_REPEAT_KIND < 0 || kind == PROBE_REPEAT_KIND) && rep == 0) { rep = 1; int lane_b; asm volatile("v_mbcnt_lo_u32_b32 %0, -1, 0\n\tv_mbcnt_hi_u32_b32 %0, -1, %0" : "=v"(lane_b)); xcd_barrier(xbar, wave * 64 + lane_b); --ph; continue; }
    rep = 0;
#endif
    if (ph + 1 < ph_hi) { int lane_b; asm volatile("v_mbcnt_lo_u32_b32 %0, -1, 0\n\tv_mbcnt_hi_u32_b32 %0, -1, %0" : "=v"(lane_b)); xcd_barrier(xbar, wave * 64 + lane_b); }
  }
}

#ifndef N_LAUNCH_SPLIT
#define N_LAUNCH_SPLIT 0
#endif
extern "C" void kernel_launch(void* const* d_in, const int* in_sizes, int n_in, void* d_out, int out_size, void* d_ws, size_t ws_size, hipStream_t stream) {
  static int grid = 0;
  if (grid == 0) {
    if (n_in != 24 || out_size != NLAT * DM || ws_size < ((FUSED_NORM || SPLIT_CTX) ? WS_END : WS_NEED)) { fprintf(stderr, "kernel_launch: unexpected shapes n_in %d out %d ws %zu (need %zu)\n", n_in, out_size, ws_size, (size_t)((FUSED_NORM || SPLIT_CTX) ? WS_END : WS_NEED)); grid = -1; return; }
    int dev = 0, cus = 0, per_cu = 0;
    hipGetDevice(&dev); hipDeviceGetAttribute(&cus, hipDeviceAttributeMultiprocessorCount, dev);
    if (hipFuncSetAttribute((const void*)fwd_mega, hipFuncAttributeMaxDynamicSharedMemorySize, LDS_BYTES) != hipSuccess) { fprintf(stderr, "kernel_launch: hipFuncSetAttribute failed\n"); grid = -1; return; }
    if (hipOccupancyMaxActiveBlocksPerMultiprocessor(&per_cu, (const void*)fwd_mega, NTHREADS, LDS_BYTES) != hipSuccess || per_cu < 1) { fprintf(stderr, "kernel_launch: occupancy query says %d\n", per_cu); per_cu = 1; }
    (void)hipGetLastError();
    grid = cus * 1;
    fprintf(stderr, "kernel_launch: grid %d (cus %d, per_cu %d)\n", grid, cus, per_cu);
  }
  if (grid < 0) return;
  Params p{};
  for (int i = 0; i < 24; ++i) p.in[i] = (const float*)d_in[i];
  p.out = (float*)d_out; p.ws = (unsigned char*)d_ws;
  int n = 0; p.prog[n++] = 0; p.prog[n++] = 1;
  for (int l = 0; l < DEPTH; ++l) { const int kind = l % 3;
#if FUSED_NORM
    const int NS_MLA = 7, NS_O = 5; const int steps_mla[9] = {2, 3, 4, 5, 6, 8, 9, 0, 0}, steps_o[7] = {2, 5, 6, 8, 9, 0, 0};
#else
#if FUSE_LAT
    const int NS_MLA = 8, NS_O = 7; const int steps_mla[9] = {2, 4, 5, 6, 7, 8, 9, 10, 0}, steps_o[7] = {2, 5, 6, 7, 8, 9, 10};
#else
    const int NS_MLA = 9, NS_O = 7; const int steps_mla[9] = {2, 3, 4, 5, 6, 7, 8, 9, 10}, steps_o[7] = {2, 5, 6, 7, 8, 9, 10};
#endif
#endif

    if (kind == 0) for (int s = 0; s < NS_MLA; ++s) p.prog[n++] = (unsigned char)((l << 4) | steps_mla[s]); else for (int s = 0; s < NS_O; ++s) p.prog[n++] = (unsigned char)((l << 4) | steps_o[s]); }
  p.nph = n;
  unsigned char* ws = (unsigned char*)d_ws; int q = 0, first = 0;
  auto add = [&](const float* src, size_t dst_off, int K, int N, int Np, int kind) { WDesc& d = p.wd[q++]; d.src = src; d.dst = (bf16_t*)(ws + dst_off); d.K = K; d.N = N; d.Np = Np; d.kind = kind; d.first = first; d.pad = 0; first += (K / 64) * (Np / 32); };
  for (int l = 0; l < DEPTH; ++l) add(p.in[10] + (size_t)l * DM * 2 * DFF, WS_WFI + (size_t)l * 2 * DFF * DM * 2, DM, 2 * DFF, 2 * DFF, 1);
  for (int l = 0; l < DEPTH; ++l) add(p.in[11] + (size_t)l * DFF * DM, WS_WFO + (size_t)l * DM * DFF * 2, DFF, DM, DM, 0);
  for (int j = 0; j < 2; ++j) { const size_t b = WS_WMLA + j * MLA_W_STRIDE;
    add(p.in[12] + (size_t)j * DM * 576, b, DM, 576, 768, 2); add(p.in[14] + (size_t)j * 256 * 1536, b + MLA_OFF_UQ, 256, 1536, 1536, 3);
    add(p.in[16] + (size_t)j * 256 * 2048, b + MLA_OFF_UKV, 256, 2048, 2048, 0); add(p.in[17] + (size_t)j * DM * DM, b + MLA_OFF_WO, DM, DM, DM, 0); }
  add(p.in[18], WS_WNA, DM, 3072, 3072, 0); add(p.in[20], WS_WNA + (size_t)3072 * 1024 * 2, DM, DM, DM, 0);
  add(p.in[21], WS_WSWA, DM, 1280, 1280, 4); add(p.in[23], WS_WSWA + (size_t)1280 * 1024 * 2, DM, DM, DM, 0);
  p.nitems = first;
#if N_LAUNCH_SPLIT
  for (int ph = 0; ph < n; ++ph) { p.lo = ph; p.hi = ph + 1; hipLaunchKernelGGL(fwd_mega, dim3(grid), dim3(NTHREADS), LDS_BYTES, stream, p); }
#else
  p.lo = 0; p.hi = n;
  if (hipMemsetAsync((char*)d_ws + WS_BAR, 0, BAR_BYTES, stream) != hipSuccess) { fprintf(stderr, "kernel_launch: memset failed\n"); return; }
  void* args[] = {&p};
  hipError_t e = hipLaunchCooperativeKernel((const void*)fwd_mega, dim3(grid), dim3(NTHREADS), args, LDS_BYTES, stream);
  if (e != hipSuccess) fprintf(stderr, "kernel_launch: cooperative launch failed: %s (grid %d)\n", hipGetErrorString(e), grid);
#endif
}
```

```cpp
#include <hip/hip_runtime.h>
#include <hip/hip_cooperative_groups.h>
#include <cstdio>
#include <cstdint>
namespace cg = cooperative_groups;

constexpr int DM = 1024, NBATCH = 4, SEQ = 8192, NLAT = NBATCH * SEQ, LC = 256, NCTX = NBATCH * LC, TOK = NLAT + NCTX, DFF = 2816, DEPTH = 4;
constexpr int MLA_KEYS = SEQ + LC;
#ifndef MLA_SDEPTH
#define MLA_SDEPTH 1
#endif
#ifndef FUSED_NORM
#define FUSED_NORM 0
#endif
#ifndef MLA_EARLY
#define MLA_EARLY false
#endif
#ifndef SPLIT_CTX
#define SPLIT_CTX 0
#endif
#ifndef NS_SDEPTH
#define NS_SDEPTH 1
#endif
#ifndef FUSE_LAT
#define FUSE_LAT 1
#endif
#ifndef MLA_SERIAL
#define MLA_SERIAL false
#endif
namespace pg8 {
#define PG8_LAS __attribute__((address_space(3)))
typedef unsigned short bf16_t;
typedef short bf16x8 __attribute__((ext_vector_type(8)));
typedef float f32x4 __attribute__((ext_vector_type(4)));
typedef unsigned u32x4 __attribute__((ext_vector_type(4)));
constexpr int BM = 256, BK = 64, HALF = 128, HTB = HALF * BK * 2  , STAGE_BYTES = 8 * HTB, NXCD = 8, WGM = 8;

__host__ __device__ __forceinline__ int lds_byte(int r, int c) { const int st = (r >> 4) * 2 + (c >> 5), rr = r & 15, cc = c & 31, ob = rr * 64 + cc * 2; return st * 1024 + (ob ^ (((ob >> 9) & 1) << 5)); }
__host__ __device__ __forceinline__ void stage_rc(int b, int& R, int& C) { const int st = b / 1024, sb = b % 1024, swz = sb ^ (((sb >> 9) & 1) << 5); R = (st >> 1) * 16 + swz / 64; C = (st & 1) * 32 + (swz % 64) / 2; }
__host__ __device__ __forceinline__ int perm32(int rho) { const int n = rho >> 4, i = rho & 15; return 8 * (i >> 2) + 4 * n + (i & 3); }

struct Unit { int pm, pn, ks; };
struct Gemm { const bf16_t* A; const bf16_t* Bt; int M, N, K, nts; };

struct StaticOrder {
    int nM, nN, nwg, G, c, S;
    __host__ __device__ void init(int M, int N, int G_, int c_, int S_ = 1) { nM = M / BM; nN = N / BM; nwg = nM * nN; G = G_; c = c_; S = S_; }
    __host__ __device__ bool next(int i, Unit& u) const {
        if (S > 1) { const int L = i * G + c; if (L >= nwg * S) return false; u.ks = L % S; const int t = L / S; u.pm = t / nN; u.pn = t % nN; return true; }
        u.ks = 0;
        const long L = (long)i * G + c; if (L >= nwg) return false;
        int wgid = (int)L; { const int q = nwg / NXCD, r = nwg % NXCD, xcd = wgid % NXCD, off = wgid / NXCD; wgid = (xcd < r ? xcd * (q + 1) : r * (q + 1) + (xcd - r) * q) + off; }
        const int nig = WGM * nN, gid = wgid / nig, fm = gid * WGM, gsz = (nM - fm) < WGM ? (nM - fm) : WGM;
        u.pm = fm + ((wgid % nig) % gsz); u.pn = (wgid % nig) / gsz; return true;
    }
    __device__ __forceinline__ void a_ready(const Unit&) const {}
    __device__ __forceinline__ void done(const Unit&) const {}
};

__device__ __forceinline__ unsigned cvt_pk_bf16(float lo, float hi) { unsigned r; asm volatile("v_cvt_pk_bf16_f32 %0, %1, %2" : "=v"(r) : "v"(lo), "v"(hi)); return r; }
typedef float f32x2 __attribute__((ext_vector_type(2)));
struct EpiArgs { int kind; int ldc; bf16_t* o0; bf16_t* o1; const float* rope; const float* g0; const float* g1; PG8_LAS unsigned char* xl; };
__device__ __forceinline__ u32x4 pack8(const f32x4& v0, const f32x4& v1) { u32x4 w; w.x = cvt_pk_bf16(v0[0], v0[1]); w.y = cvt_pk_bf16(v0[2], v0[3]); w.z = cvt_pk_bf16(v1[0], v1[1]); w.w = cvt_pk_bf16(v1[2], v1[3]); return w; }
__device__ __forceinline__ void rope8(f32x4& v0, f32x4& v1, const float* rp) {
    const f32x4 a = *(const f32x4*)rp, b = *(const f32x4*)(rp + 4);
    const f32x4 x0 = v0, x1 = v1;
    v0[0] = x0[0] * a[0] - x0[1] * a[1]; v0[1] = x0[1] * a[0] + x0[0] * a[1];
    v0[2] = x0[2] * a[2] - x0[3] * a[3]; v0[3] = x0[3] * a[2] + x0[2] * a[3];
    v1[0] = x1[0] * b[0] - x1[1] * b[1]; v1[1] = x1[1] * b[0] + x1[0] * b[1];
    v1[2] = x1[2] * b[2] - x1[3] * b[3]; v1[3] = x1[3] * b[2] + x1[2] * b[3];
}
template <int KIND> __device__ __forceinline__ void emit8(const EpiArgs& a, int row, int col, f32x4 v0, f32x4 v1, int ks) {
    if constexpr (KIND == 5) { float* o = (float*)a.o0 + ((size_t)ks * NCTX + row) * DM + col; *(f32x4*)o = v0; *(f32x4*)(o + 4) = v1; }
    else if constexpr (KIND == 0) { *(u32x4*)(a.o0 + (unsigned)(row * a.ldc + col)) = pack8(v0, v1); }
    else if constexpr (KIND == 1) {
        float r[4];
#pragma unroll
        for (int i = 0; i < 4; ++i) { const float g = v0[i]; r[i] = g * v1[i] * __builtin_amdgcn_rcpf(1.0f + __builtin_amdgcn_exp2f(-g * 1.4426950408889634f)); }
        typedef unsigned u32x2 __attribute__((ext_vector_type(2))); u32x2 w; w.x = cvt_pk_bf16(r[0], r[1]); w.y = cvt_pk_bf16(r[2], r[3]);
        *(u32x2*)(a.o0 + (size_t)row * DFF + (col >> 1)) = w; }
    else if constexpr (KIND == 2) {
        const int within = col % 192;
        if (within >= 128 && row < NLAT) rope8(v0, v1, a.rope + ((size_t)(row & (SEQ - 1)) * 32 + ((within - 128) >> 1)) * 2);
        *(u32x4*)(a.o0 + (size_t)row * 1536 + col) = pack8(v0, v1); }
    else if constexpr (KIND == 3) {
        const int h = col >> 8, w = col & 255; int b, key;
        if (row < NLAT) { b = row >> 13; key = LC + (row & (SEQ - 1)); } else { const int r2 = row - NLAT; b = r2 >> 8; key = r2 & 255; }
        const size_t base = (size_t)(b * 8 + h) * MLA_KEYS + key;
        if (w < 128) *(u32x4*)(a.o0 + base * 128 + w) = pack8(v0, v1); else *(u32x4*)(a.o1 + base * 128 + (w - 128)) = pack8(v0, v1); }
    else {
        if (col < 1152 && row < NLAT) rope8(v0, v1, a.rope + ((size_t)(row & (SEQ - 1)) * 32 + ((col & 63) >> 1)) * 2);
        *(u32x4*)(a.o0 + (size_t)row * 1280 + col) = pack8(v0, v1); }
}
struct EpiGen {
    static constexpr bool PERM = true, AFTER_DRAIN = false;
    EpiArgs a;
    template <int KIND> __device__ __forceinline__ void run(const f32x4 (&acc)[2][2][4][2], const Unit& u, int wr, int wc, int fr, int fq) const {
        const int row0 = u.pm * BM + wr * 64 + fr, col0 = u.pn * BM + wc * 32 + 8 * fq;
#pragma unroll
        for (int ai = 0; ai < 2; ++ai)
#pragma unroll
            for (int m = 0; m < 4; ++m)
#pragma unroll
                for (int bj = 0; bj < 2; ++bj) { emit8<KIND>(a, row0 + ai * HALF + m * 16, col0 + bj * HALF, acc[ai][bj][m][0], acc[ai][bj][m][1], u.ks); asm volatile("" ::: "memory"); }
    }
    __device__ __forceinline__ void run_lat(const f32x4 (&acc)[2][2][4][2], const Unit& u, int wr, int wc) const {
        int lane; asm volatile("v_mbcnt_lo_u32_b32 %0, -1, 0\n\tv_mbcnt_hi_u32_b32 %0, -1, %0" : "=v"(lane));
        const int fr = lane & 15, fq = lane >> 4;
        const int row0 = u.pm * BM + wr * 64 + fr, tc0 = wc * 32 + 8 * fq;
        if (u.pn < 2) {
            PG8_LAS float* P = (PG8_LAS float*)a.xl;
#pragma unroll
            for (int ai = 0; ai < 2; ++ai)
#pragma unroll
                for (int m = 0; m < 4; ++m) { float s = 0.f;
#pragma unroll
                    for (int bj = 0; bj < 2; ++bj)
#pragma unroll
                        for (int n = 0; n < 2; ++n) { const f32x4 x = acc[ai][bj][m][n]; s += (x[0] * x[0] + x[1] * x[1]) + (x[2] * x[2] + x[3] * x[3]); }
                    s += __builtin_bit_cast(float, __builtin_amdgcn_ds_bpermute((lane ^ 16) << 2, __builtin_bit_cast(int, s)));
                    s += __builtin_bit_cast(float, __builtin_amdgcn_ds_bpermute((lane ^ 32) << 2, __builtin_bit_cast(int, s)));
                    if (fq == 0) P[(ai * HALF + wr * 64 + m * 16 + fr) * 4 + wc] = s; }
            asm volatile("s_waitcnt lgkmcnt(0)" ::: "memory"); __builtin_amdgcn_s_barrier(); asm volatile("" ::: "memory");
            const float* g = u.pn ? a.g1 : a.g0; bf16_t* out = a.o0 + (size_t)u.pn * TOK * 256;
            f32x4 gv[2][2];
#pragma unroll
            for (int bj = 0; bj < 2; ++bj) { gv[bj][0] = *(const f32x4*)(g + tc0 + bj * HALF); gv[bj][1] = *(const f32x4*)(g + tc0 + bj * HALF + 4); }
#pragma unroll
            for (int ai = 0; ai < 2; ++ai)
#pragma unroll
                for (int m = 0; m < 4; ++m) { const int rl = ai * HALF + wr * 64 + m * 16 + fr; const f32x4 pp = *(const PG8_LAS f32x4*)(P + rl * 4);
                    const float rstd = 1.0f / sqrtf(((pp[0] + pp[1]) + (pp[2] + pp[3])) * (1.0f / 256.0f) + 1e-6f);
#pragma unroll
                    for (int bj = 0; bj < 2; ++bj) { const int c = tc0 + bj * HALF; const f32x4 g0 = gv[bj][0], g1 = gv[bj][1];
                        *(u32x4*)(out + (size_t)(row0 + ai * HALF + m * 16) * 256 + c) = pack8(acc[ai][bj][m][0] * rstd * g0, acc[ai][bj][m][1] * rstd * g1); }
                    asm volatile("" ::: "memory"); }
            asm volatile("s_waitcnt lgkmcnt(0)" ::: "memory"); __builtin_amdgcn_s_barrier(); asm volatile("" ::: "memory");
        } else if (tc0 < 64) {
#pragma unroll
            for (int ai = 0; ai < 2; ++ai)
#pragma unroll
                for (int m = 0; m < 4; ++m) { const int row = row0 + ai * HALF + m * 16; f32x4 v0 = acc[ai][0][m][0], v1 = acc[ai][0][m][1]; int b, key;
                    if (row < NLAT) { rope8(v0, v1, a.rope + ((size_t)(row & (SEQ - 1)) * 32 + (tc0 >> 1)) * 2); b = row >> 13; key = LC + (row & (SEQ - 1)); }
                    else { const int r2 = row - NLAT; b = r2 >> 8; key = r2 & 255; }
                    *(u32x4*)(a.o1 + ((size_t)b * MLA_KEYS + key) * 64 + tc0) = pack8(v0, v1);
                    asm volatile("" ::: "memory"); }
        }
    }
    __device__ __forceinline__ void run_swiglu(const f32x4 (&acc)[2][2][4][2], const Unit& u, int wr, int wc, int fr, int fq) const {
        const int row0 = u.pm * BM + wr * 64 + fr;
        const bool odd = (fq & 1) != 0;
        const int ocol = u.pn * (BM / 2) + wc * 16 + (odd ? 64 + 4 * (fq - 1) : 4 * fq);
#pragma unroll
        for (int ai = 0; ai < 2; ++ai)
#pragma unroll
            for (int m = 0; m < 4; ++m) { unsigned w[2][2];
#pragma unroll
                for (int bj = 0; bj < 2; ++bj) { const f32x4 g4 = acc[ai][bj][m][0], u4 = acc[ai][bj][m][1]; float r[4];
#pragma unroll
                    for (int i = 0; i < 4; ++i) { const float g = g4[i]; r[i] = g * u4[i] * __builtin_amdgcn_rcpf(1.0f + __builtin_amdgcn_exp2f(-g * 1.4426950408889634f)); }
                    w[bj][0] = cvt_pk_bf16(r[0], r[1]); w[bj][1] = cvt_pk_bf16(r[2], r[3]); }
                const auto s0 = __builtin_amdgcn_permlane16_swap(w[0][0], w[1][0], false, false); const auto s1 = __builtin_amdgcn_permlane16_swap(w[0][1], w[1][1], false, false);
                u32x4 o; o.x = s0[0]; o.y = s1[0]; o.z = s0[1]; o.w = s1[1];
                *(u32x4*)(a.o0 + (size_t)(row0 + ai * HALF + m * 16) * DFF + ocol) = o;
                asm volatile("" ::: "memory"); }
    }
    __device__ __forceinline__ void operator()(const f32x4 (&acc)[2][2][4][2], const Unit& u, int wr, int wc, int fr, int fq) const {
        if (a.kind == 6) { run_lat(acc, u, wr, wc); return; }
        if (a.kind == 1) { run_swiglu(acc, u, wr, wc, fr, fq); return; }
        switch (a.kind) { case 0: run<0>(acc, u, wr, wc, fr, fq); break; case 1: run<1>(acc, u, wr, wc, fr, fq); break; case 2: run<2>(acc, u, wr, wc, fr, fq); break;
                          case 3: run<3>(acc, u, wr, wc, fr, fq); break; case 5: run<5>(acc, u, wr, wc, fr, fq); break; default: run<4>(acc, u, wr, wc, fr, fq); break; }
    }
};
struct PanelOrder {
    int nwg, G, c;
    __device__ __forceinline__ void init(int M, int G_, int c_) { nwg = (M / BM) * 4; G = G_; c = c_; }
    __device__ __forceinline__ bool next(int i, Unit& u) const { const int L = i * G + c; if (L >= nwg) return false; u.pm = L >> 2; u.pn = L & 3; u.ks = 0; return true; }
    __device__ __forceinline__ void a_ready(const Unit&) const {}
    __device__ __forceinline__ void done(const Unit&) const {}
};
struct NormArgs {
    float* xlat; float* xctx; bf16_t* xn;
    const float* g_post; const float* g_pre; const float* modl; const float* modn;
    int wgate, wshift, wscale, do_norm;
    float* slot1; float* slot2; unsigned* cnt1; unsigned* cnt2;
};
struct EpiNorm {
    static constexpr bool PERM = true, AFTER_DRAIN = false;
    NormArgs a; PG8_LAS unsigned char* xl;
    __device__ __forceinline__ static float xor_add(float v, int lane, int o) { return v + __builtin_bit_cast(float, __builtin_amdgcn_ds_bpermute((lane ^ o) << 2, __builtin_bit_cast(int, v))); }
    __device__ __forceinline__ bool stats(const float (&part)[2][4], float* slot, unsigned* cnt, const Unit& u, int wr, int wc, int fr, int fq, int wid, int lane) const {
        PG8_LAS float* P = (PG8_LAS float*)xl; PG8_LAS float* S = (PG8_LAS float*)(xl + 4096); PG8_LAS unsigned* flag = (PG8_LAS unsigned*)(xl + 4096 + 1024);
#pragma unroll
        for (int ai = 0; ai < 2; ++ai)
#pragma unroll
            for (int m = 0; m < 4; ++m) if (fq == 0) P[(ai * HALF + wr * 64 + m * 16 + fr) * 4 + wc] = part[ai][m];
        asm volatile("s_waitcnt lgkmcnt(0)" ::: "memory"); __builtin_amdgcn_s_barrier(); asm volatile("" ::: "memory");
        const int row = wid * 32 + (lane & 31);
        if (lane < 32) { const float t = (P[row * 4 + 0] + P[row * 4 + 1]) + (P[row * 4 + 2] + P[row * 4 + 3]);
            __hip_atomic_store((unsigned*)slot + ((size_t)(u.pm * BM + row) * 4 + u.pn), __float_as_uint(t), __ATOMIC_RELAXED, __HIP_MEMORY_SCOPE_AGENT); }
        asm volatile("s_waitcnt vmcnt(0)" ::: "memory");
        if (lane == 0) __hip_atomic_fetch_add(cnt + 64 * u.pm, 1u, __ATOMIC_RELAXED, __HIP_MEMORY_SCOPE_AGENT);
        if (wid == 0) {
            bool dead = false; const unsigned long long t0 = __builtin_amdgcn_s_memrealtime();
            for (;;) {
                if ((unsigned)__builtin_amdgcn_readfirstlane(__hip_atomic_load(cnt + 64 * u.pm, __ATOMIC_RELAXED, __HIP_MEMORY_SCOPE_AGENT)) >= 32u) break;
                if (__builtin_amdgcn_s_memrealtime() - t0 > 5000000ull) { dead = true; break; }
                __builtin_amdgcn_s_sleep(2);
            }
            __builtin_amdgcn_fence(__ATOMIC_ACQUIRE, "agent");
            if (lane == 0) flag[0] = dead ? 1u : 0u;
        }
        asm volatile("s_waitcnt vmcnt(0) lgkmcnt(0)" ::: "memory"); __builtin_amdgcn_s_barrier(); asm volatile("" ::: "memory");
        const bool bad = flag[0] != 0u;
        if (lane < 32) { const unsigned* sl = (const unsigned*)slot + (size_t)(u.pm * BM + row) * 4; float t = 0.f;
#pragma unroll
            for (int q = 0; q < 4; ++q) t += __uint_as_float(__hip_atomic_load(sl + q, __ATOMIC_RELAXED, __HIP_MEMORY_SCOPE_AGENT));
            S[row] = 1.0f / sqrtf(t * (1.0f / 1024.0f) + 1e-6f); }
        asm volatile("s_waitcnt lgkmcnt(0)" ::: "memory"); __builtin_amdgcn_s_barrier(); asm volatile("" ::: "memory");
        return bad;
    }
    __device__ __forceinline__ void rowsq(const f32x4 (&acc)[2][2][4][2], float (&part)[2][4], int lane) const {
#pragma unroll
        for (int ai = 0; ai < 2; ++ai)
#pragma unroll
            for (int m = 0; m < 4; ++m) { float s = 0.f;
#pragma unroll
                for (int bj = 0; bj < 2; ++bj)
#pragma unroll
                    for (int n = 0; n < 2; ++n) { const f32x4 x = acc[ai][bj][m][n]; s += (x[0] * x[0] + x[1] * x[1]) + (x[2] * x[2] + x[3] * x[3]); }
                s = xor_add(s, lane, 16); s = xor_add(s, lane, 32); part[ai][m] = s; }
    }
    __device__ __forceinline__ void operator()(f32x4 (&acc)[2][2][4][2], const Unit& u, int wr, int wc, int fr_, int fq_) const {
        int lane; asm volatile("v_mbcnt_lo_u32_b32 %0, -1, 0\n\tv_mbcnt_hi_u32_b32 %0, -1, %0" : "=v"(lane));
        const int fr = lane & 15, fq = lane >> 4, wid = wr * 4 + wc; (void)fr_; (void)fq_;
        const PG8_LAS float* S = (const PG8_LAS float*)(xl + 4096);
        const int rmod = u.pm < 128 ? (u.pm >> 5) : 4;
        float* xu = (u.pm < 128 ? a.xlat + (size_t)u.pm * BM * DM : a.xctx + (size_t)(u.pm - 128) * BM * DM);
        const int col0 = u.pn * BM + wc * 32 + 8 * fq;
        const unsigned xoff = (unsigned)((wr * 64 + fr) * DM + col0);
        float part[2][4];
        rowsq(acc, part, lane);
        bool bad = stats(part, a.slot1, a.cnt1, u, wr, wc, fr, fq, wid, lane);
        { float rs[2][4];
#pragma unroll
          for (int ai = 0; ai < 2; ++ai)
#pragma unroll
            for (int m = 0; m < 4; ++m) rs[ai][m] = S[ai * HALF + wr * 64 + m * 16 + fr];
          const float* gate = a.modl + (size_t)(rmod * 6 + a.wgate) * DM;
#pragma unroll
          for (int bj = 0; bj < 2; ++bj)
#pragma unroll
            for (int n = 0; n < 2; ++n) { const int c = col0 + bj * HALF + 4 * n; const f32x4 gg = *(const f32x4*)(gate + c) * *(const f32x4*)(a.g_post + c);
#pragma unroll
              for (int ai = 0; ai < 2; ++ai)
#pragma unroll
                for (int m = 0; m < 4; ++m) { const f32x4 x = *(const f32x4*)(xu + (xoff + (unsigned)((ai * HALF + m * 16) * DM + bj * HALF + 4 * n))); acc[ai][bj][m][n] = x + gg * (acc[ai][bj][m][n] * rs[ai][m]);
                  if (m == 3) asm volatile("" ::: "memory"); } } }
        const float qnan = __builtin_nanf("");
        unsigned xoff2 = xoff; asm volatile("" : "+v"(xoff2));
        if (a.do_norm) {
            rowsq(acc, part, lane);
            bad = stats(part, a.slot2, a.cnt2, u, wr, wc, fr, fq, wid, lane) || bad;
            float rs[2][4];
#pragma unroll
            for (int ai = 0; ai < 2; ++ai)
#pragma unroll
              for (int m = 0; m < 4; ++m) rs[ai][m] = S[ai * HALF + wr * 64 + m * 16 + fr];
            const float* shift = a.modn + (size_t)(rmod * 6 + a.wshift) * DM; const float* scale = a.modn + (size_t)(rmod * 6 + a.wscale) * DM;
            bf16_t* xnu = a.xn + (size_t)u.pm * BM * DM;
#pragma unroll
            for (int bj = 0; bj < 2; ++bj)
#pragma unroll
              for (int n = 0; n < 2; ++n) { const int c = col0 + bj * HALF + 4 * n; const f32x4 g = *(const f32x4*)(a.g_pre + c), sh = *(const f32x4*)(shift + c), sc = *(const f32x4*)(scale + c) + 1.0f;
#pragma unroll
                for (int ai = 0; ai < 2; ++ai)
#pragma unroll
                  for (int m = 0; m < 4; ++m) { f32x4 x = acc[ai][bj][m][n]; if (bad) x = (f32x4){qnan, qnan, qnan, qnan};
                    const unsigned o = xoff2 + (unsigned)((ai * HALF + m * 16) * DM + bj * HALF + 4 * n);
                    *(f32x4*)(xu + o) = x;
                    const f32x4 h = (x * rs[ai][m] * g) * sc + sh; typedef unsigned u32x2 __attribute__((ext_vector_type(2))); u32x2 w; w.x = cvt_pk_bf16(h[0], h[1]); w.y = cvt_pk_bf16(h[2], h[3]);
                    *(u32x2*)(xnu + o) = w; }
                asm volatile("" ::: "memory"); }
        } else {
#pragma unroll
            for (int bj = 0; bj < 2; ++bj)
#pragma unroll
              for (int n = 0; n < 2; ++n) { const int c = col0 + bj * HALF + 4 * n;
#pragma unroll
                for (int ai = 0; ai < 2; ++ai)
#pragma unroll
                  for (int m = 0; m < 4; ++m) { f32x4 x = acc[ai][bj][m][n]; if (bad) x = (f32x4){qnan, qnan, qnan, qnan}; *(f32x4*)(xu + (xoff2 + (unsigned)((ai * HALF + m * 16) * DM + bj * HALF + 4 * n))) = x; } (void)c; }
        }
    }
};
template <class Epi, class Sched, bool ALIGN_EPI = false, bool SP2 = false>
__device__ __forceinline__ void gemm_phase(PG8_LAS unsigned char* lds, const Gemm g, const Sched& S, const Epi& E, const int tid) {
    const int wid = __builtin_amdgcn_readfirstlane(tid >> 6), lane = tid & 63, wr = wid >> 2, wc = wid & 3, fr = lane & 15, fq = lane >> 4;
    const int K = g.K, nt = g.nts ? g.nts : K / BK; const size_t sstep = (size_t)g.nts * BK * 2;
    unsigned voffA[2], voffB[2];
#pragma unroll
    for (int i = 0; i < 2; ++i) { int R, C; stage_rc(tid * 16 + i * 8192, R, C); const int Rb = Epi::PERM ? ((R & ~31) + perm32(R & 31)) : R;
        voffA[i] = (unsigned)(R * K + C) * 2u; voffB[i] = (unsigned)(Rb * K + C) * 2u; }
    const size_t kstep = (size_t)(BK * 2);
    const size_t hstep = (size_t)HALF * K * 2;
    const size_t tstep = 2 * hstep;
    const unsigned ldsw = (unsigned)wid * 1024u;
    const int aoff = lds_byte(wr * 64 + fr, fq * 8), boff = lds_byte(wc * 32 + fr, fq * 8);
#define PG8_SA(b, h) (((b) * 2 + (h)) * HTB)
#define PG8_SB(b, h) ((4 + (b) * 2 + (h)) * HTB)
#define PG8_STAGE(bufoff, gbase, voff) do { _Pragma("unroll") for (int _i = 0; _i < 2; ++_i) \
        __builtin_amdgcn_global_load_lds((const unsigned*)((const char*)(gbase) + (voff)[_i]), (PG8_LAS unsigned*)(lds + (bufoff) + ldsw + _i * 8192), 16, 0, 0); } while (0)
#define PG8_LDA(dst, b, h) do { _Pragma("unroll") for (int m = 0; m < 4; ++m) _Pragma("unroll") for (int k = 0; k < 2; ++k) dst[m][k] = *(const PG8_LAS bf16x8*)(lds + PG8_SA(b, h) + aoff + m * 2048 + k * 1024); } while (0)
#define PG8_LDB(dst, b, h) do { _Pragma("unroll") for (int n = 0; n < 2; ++n) _Pragma("unroll") for (int k = 0; k < 2; ++k) dst[n][k] = *(const PG8_LAS bf16x8*)(lds + PG8_SB(b, h) + boff + n * 2048 + k * 1024); } while (0)
#define PG8_MMA(ai, bj, At, Bt) do { __builtin_amdgcn_s_setprio(1); _Pragma("unroll") for (int m = 0; m < 4; ++m) _Pragma("unroll") for (int n = 0; n < 2; ++n) _Pragma("unroll") for (int k = 0; k < 2; ++k) \
        acc[ai][bj][m][n] = __builtin_amdgcn_mfma_f32_16x16x32_bf16(Bt[n][k], At[m][k], acc[ai][bj][m][n], 0, 0, 0); __builtin_amdgcn_s_setprio(0); } while (0)
#define PG8_WAIT_V(n) asm volatile("s_waitcnt vmcnt(" #n ")" ::: "memory")
#define PG8_WAIT_L(n) asm volatile("s_waitcnt lgkmcnt(" #n ")" ::: "memory")
#define PG8_BAR __builtin_amdgcn_s_barrier()
#define PG8_SCHED __builtin_amdgcn_sched_barrier(0)
    Unit cur, nxt; int ui = 0;
    if (!S.next(0, cur)) return;
    f32x4 acc[2][2][4][2];
#pragma unroll
    for (int a = 0; a < 2; ++a)
#pragma unroll
        for (int b = 0; b < 2; ++b)
#pragma unroll
            for (int m = 0; m < 4; ++m)
#pragma unroll
                for (int n = 0; n < 2; ++n) acc[a][b][m][n] = (f32x4){0.f, 0.f, 0.f, 0.f};
    bf16x8 At[4][2], B0[2][2], B1[2][2];
    const char* cA = (const char*)g.A + (size_t)cur.pm * tstep + (size_t)cur.ks * sstep; const char* cB = (const char*)g.Bt + (size_t)cur.pn * tstep + (size_t)cur.ks * sstep;
    S.a_ready(cur);
    if constexpr (SP2) {
        PG8_STAGE(PG8_SB(0, 0), cB, voffB); PG8_STAGE(PG8_SB(0, 1), cB + hstep, voffB); PG8_STAGE(PG8_SA(0, 0), cA, voffA); PG8_STAGE(PG8_SA(0, 1), cA + hstep, voffA);
        if (wr == 1) PG8_BAR;
        PG8_WAIT_V(2); PG8_BAR;
        PG8_STAGE(PG8_SB(1, 0), cB + kstep, voffB); PG8_STAGE(PG8_SA(1, 0), cA + kstep, voffA); PG8_STAGE(PG8_SB(1, 1), cB + hstep + kstep, voffB);
        PG8_WAIT_V(6); PG8_BAR;
    } else {
        PG8_STAGE(PG8_SB(0, 0), cB, voffB); PG8_STAGE(PG8_SA(0, 0), cA, voffA); PG8_STAGE(PG8_SB(0, 1), cB + hstep, voffB); PG8_STAGE(PG8_SA(0, 1), cA + hstep, voffA);
        if (wr == 1) PG8_BAR;
        PG8_WAIT_V(4); PG8_BAR;
        PG8_STAGE(PG8_SB(1, 0), cB + kstep, voffB); PG8_STAGE(PG8_SA(1, 0), cA + kstep, voffA); PG8_STAGE(PG8_SB(1, 1), cB + hstep + kstep, voffB);
        PG8_WAIT_V(6); PG8_BAR;
    }
    for (;;) {
        const bool has_next = S.next(ui + 1, nxt);
        const char* nA = has_next ? (const char*)g.A + (size_t)nxt.pm * tstep + (size_t)nxt.ks * sstep : cA; const char* nB = has_next ? (const char*)g.Bt + (size_t)nxt.pn * tstep + (size_t)nxt.ks * sstep : cB;
        for (int t = 0; t < nt; t += 2) {
            const bool last = (t == nt - 2);
            const char* a1 = cA + (size_t)(t + 1) * kstep;
            const char* a2 = last ? nA : cA + (size_t)(t + 2) * kstep; const char* b2 = last ? nB : cB + (size_t)(t + 2) * kstep;
            const char* a3 = a2 + kstep; const char* b3 = b2 + kstep;
            if (last && has_next) S.a_ready(nxt);
            if constexpr (SP2) {
            PG8_LDB(B0, 0, 0); PG8_LDB(B1, 0, 1); PG8_SCHED; PG8_LDA(At, 0, 0); PG8_STAGE(PG8_SA(1, 1), a1 + hstep, voffA);
            PG8_WAIT_V(8); PG8_WAIT_L(0); PG8_BAR; PG8_MMA(0, 0, At, B0); PG8_MMA(0, 1, At, B1); PG8_BAR; PG8_SCHED;
            PG8_LDA(At, 0, 1); PG8_STAGE(PG8_SB(0, 0), b2, voffB); PG8_STAGE(PG8_SB(0, 1), b2 + hstep, voffB); PG8_STAGE(PG8_SA(0, 0), a2, voffA);
            PG8_WAIT_V(8); PG8_WAIT_L(0); PG8_BAR; PG8_MMA(1, 0, At, B0); PG8_MMA(1, 1, At, B1); PG8_BAR; PG8_SCHED;
            PG8_LDB(B0, 1, 0); PG8_LDB(B1, 1, 1); PG8_SCHED; PG8_LDA(At, 1, 0); PG8_STAGE(PG8_SA(0, 1), a2 + hstep, voffA);
            PG8_WAIT_V(8); PG8_WAIT_L(0); PG8_BAR; PG8_MMA(0, 0, At, B0); PG8_MMA(0, 1, At, B1); PG8_BAR; PG8_SCHED;
            PG8_LDA(At, 1, 1); PG8_STAGE(PG8_SB(1, 0), b3, voffB); PG8_STAGE(PG8_SB(1, 1), b3 + hstep, voffB); PG8_STAGE(PG8_SA(1, 0), a3, voffA);
            PG8_WAIT_V(8); PG8_WAIT_L(0); PG8_BAR; PG8_MMA(1, 0, At, B0); PG8_MMA(1, 1, At, B1); PG8_BAR; PG8_SCHED;
            } else {
            PG8_LDB(B0, 0, 0); PG8_SCHED; PG8_LDA(At, 0, 0); PG8_STAGE(PG8_SA(1, 1), a1 + hstep, voffA);
            PG8_WAIT_L(8); PG8_BAR; PG8_WAIT_L(0); PG8_MMA(0, 0, At, B0); PG8_BAR; PG8_SCHED;
            PG8_LDB(B1, 0, 1); PG8_STAGE(PG8_SB(0, 0), b2, voffB);
            PG8_BAR; PG8_WAIT_L(0); PG8_MMA(0, 1, At, B1); PG8_BAR;
            PG8_LDA(At, 0, 1); PG8_STAGE(PG8_SA(0, 0), a2, voffA);
            PG8_BAR; PG8_WAIT_L(0); PG8_MMA(1, 0, At, B0); PG8_BAR; PG8_SCHED;
            PG8_STAGE(PG8_SB(0, 1), b2 + hstep, voffB);
            PG8_WAIT_V(6); PG8_BAR; PG8_MMA(1, 1, At, B1); PG8_BAR;
            PG8_LDB(B0, 1, 0); PG8_SCHED; PG8_LDA(At, 1, 0); PG8_STAGE(PG8_SA(0, 1), a2 + hstep, voffA);
            PG8_WAIT_L(8); PG8_BAR; PG8_WAIT_L(0); PG8_MMA(0, 0, At, B0); PG8_BAR; PG8_SCHED;
            PG8_LDB(B1, 1, 1); PG8_STAGE(PG8_SB(1, 0), b3, voffB);
            PG8_BAR; PG8_WAIT_L(0); PG8_MMA(0, 1, At, B1); PG8_BAR;
            PG8_LDA(At, 1, 1); PG8_STAGE(PG8_SA(1, 0), a3, voffA);
            PG8_BAR; PG8_WAIT_L(0); PG8_MMA(1, 0, At, B0); PG8_BAR; PG8_SCHED;
            PG8_STAGE(PG8_SB(1, 1), b3 + hstep, voffB);
            PG8_WAIT_V(6); PG8_BAR; PG8_MMA(1, 1, At, B1); PG8_BAR;
            }
        }
        if constexpr (ALIGN_EPI) { if (wr == 0) PG8_BAR; }
        if constexpr (!Epi::AFTER_DRAIN) { E(acc, cur, wr, wc, fr, fq); S.done(cur); }
        if (!has_next) break;
#pragma unroll
        for (int a = 0; a < 2; ++a)
#pragma unroll
            for (int b = 0; b < 2; ++b)
#pragma unroll
                for (int m = 0; m < 4; ++m)
#pragma unroll
                    for (int n = 0; n < 2; ++n) acc[a][b][m][n] = (f32x4){0.f, 0.f, 0.f, 0.f};
        cur = nxt; cA = nA; cB = nB; ++ui;
        if constexpr (ALIGN_EPI) { if (wr == 1) PG8_BAR; }
    }
    PG8_WAIT_V(0);
    if constexpr (!ALIGN_EPI) { if (wr == 0) PG8_BAR; }
    PG8_BAR;
    if constexpr (Epi::AFTER_DRAIN) { E.fused(acc, cur, wr, wc, fr, fq, lds, wid, lane); S.done(cur); }
#undef PG8_SA
#undef PG8_SB
#undef PG8_STAGE
#undef PG8_LDA
#undef PG8_LDB
#undef PG8_MMA
#undef PG8_WAIT_V
#undef PG8_WAIT_L
#undef PG8_BAR
#undef PG8_SCHED
}
}
namespace att {
using bf16x8 = __attribute__((ext_vector_type(8))) short;
using s16x4  = __attribute__((ext_vector_type(4))) short;
using f32x16 = __attribute__((ext_vector_type(16))) float;
using u32x4  = __attribute__((ext_vector_type(4))) unsigned;
typedef unsigned short bf16_t;
#define SBAR() __builtin_amdgcn_sched_barrier(0)
__device__ __forceinline__ int crow(int r, int hi) { return (r & 3) + 8 * (r >> 2) + 4 * hi; }
__device__ __forceinline__ unsigned cvtpk(float lo, float hi) { unsigned r; asm volatile("v_cvt_pk_bf16_f32 %0, %1, %2" : "=v"(r) : "v"(lo), "v"(hi)); return r; }
template <int DK> __device__ __forceinline__ int kswz(int row, int colB) { return row * (DK * 2) + (colB ^ ((row & 7) << 4)); }

__device__ __forceinline__ void partialSM(f32x16& p0, f32x16& p1, float& m_reg, float& mn, float& alpha, const float C, const float THRS) {
  float pmax = p0[0];
#pragma unroll
  for (int r = 1; r < 16; ++r) pmax = fmaxf(pmax, p0[r]);
#pragma unroll
  for (int r = 0; r < 16; ++r) pmax = fmaxf(pmax, p1[r]);
  { auto rr = __builtin_amdgcn_permlane32_swap(__float_as_uint(pmax), __float_as_uint(pmax), false, false);
    pmax = fmaxf(__uint_as_float(rr[0]), __uint_as_float(rr[1])); }
  if (__builtin_expect(__all(pmax - m_reg <= THRS), 1)) { mn = m_reg; alpha = 1.f; }
  else { mn = fmaxf(m_reg, pmax); alpha = __builtin_amdgcn_exp2f((m_reg - mn) * C); m_reg = mn; }
  const float mnC = -mn * C;
#pragma unroll
  for (int r = 0; r < 16; ++r) p0[r] = fmaf(p0[r], C, mnC);
#pragma unroll
  for (int r = 0; r < 16; ++r) p1[r] = fmaf(p1[r], C, mnC);
#pragma unroll
  for (int r = 0; r < 16; ++r) p0[r] = __builtin_amdgcn_exp2f(p0[r]);
}
__device__ __forceinline__ void finishSM(f32x16& p0, f32x16& p1, float alpha, float& l_reg, bf16x8& pa0, bf16x8& pa1, bf16x8& pa2, bf16x8& pa3) {
#pragma unroll
  for (int r = 0; r < 16; ++r) p1[r] = __builtin_amdgcn_exp2f(p1[r]);
  float ps = 0;
#pragma unroll
  for (int r = 0; r < 16; ++r) ps += p0[r];
#pragma unroll
  for (int r = 0; r < 16; ++r) ps += p1[r];
  { auto rr = __builtin_amdgcn_permlane32_swap(__float_as_uint(ps), __float_as_uint(ps), false, false);
    ps = __uint_as_float(rr[0]) + __uint_as_float(rr[1]); }
  l_reg = l_reg * alpha + ps;
#define PK4(P, BASE, OUT) do { unsigned a0 = cvtpk(P[BASE + 0], P[BASE + 1]), a1 = cvtpk(P[BASE + 2], P[BASE + 3]);   \
    unsigned b0 = cvtpk(P[BASE + 4], P[BASE + 5]), b1 = cvtpk(P[BASE + 6], P[BASE + 7]);                              \
    auto r0 = __builtin_amdgcn_permlane32_swap(a0, b0, false, false); auto r1 = __builtin_amdgcn_permlane32_swap(a1, b1, false, false); \
    u32x4 w = {r0[0], r1[0], r0[1], r1[1]}; OUT = *reinterpret_cast<bf16x8*>(&w); } while (0)
  PK4(p0, 0, pa0); PK4(p0, 8, pa1); PK4(p1, 0, pa2); PK4(p1, 8, pa3);
#undef PK4
}
template <int DK> __device__ __forceinline__ void qkt(f32x16& p0, f32x16& p1, const char* Ks, const bf16x8* qr, const unsigned kb) {
  constexpr int KROW = DK * 2 + 16;
  p0 = f32x16{}; p1 = f32x16{};
  const char* a = Ks + kb;
#pragma unroll
  for (int d0 = 0; d0 < DK / 16; ++d0) {
    const bf16x8 b0 = *reinterpret_cast<const bf16x8*>(a + d0 * 32);
    const bf16x8 b1 = *reinterpret_cast<const bf16x8*>(a + d0 * 32 + 32 * KROW);
    p0 = __builtin_amdgcn_mfma_f32_32x32x16_bf16(b0, qr[d0], p0, 0, 0, 0);
    p1 = __builtin_amdgcn_mfma_f32_32x32x16_bf16(b1, qr[d0], p1, 0, 0, 0); }
}
template <int DV> __device__ __forceinline__ int v_st(int k, int c) { const int kk = (k & ~0xC) | ((k & 4) << 1) | ((k & 8) >> 1); return ((kk >> 3) * (DV / 32) + (c >> 5)) * 512 + ((kk & 7) * 32 + (c & 31)) * 2; }
__device__ __forceinline__ int v_rd_base(int lane) { return ((lane & 3) << 3) | (((lane >> 2) & 3) << 6) | (((lane >> 4) & 1) << 5) | (((lane >> 5) & 1) << 8); }
template <int DV> constexpr int v_rd_off(int d0, int ks, int half) { return d0 * 512 + ks * (DV / 32) * 1024 + half * (DV / 32) * 512; }
template <int OFF> __device__ __forceinline__ s16x4 tr_read(int vb) { s16x4 r; asm volatile("ds_read_b64_tr_b16 %0, %1 offset:%2" : "=&v"(r) : "v"(vb), "i"(OFF) : "memory"); return r; }
template <int DV, int D0> __device__ __forceinline__ void pv_one(f32x16& od, int vb, bf16x8 pa0, bf16x8 pa1, bf16x8 pa2, bf16x8 pa3) {
  const s16x4 l0 = tr_read<v_rd_off<DV>(D0, 0, 0)>(vb), h0 = tr_read<v_rd_off<DV>(D0, 0, 1)>(vb), l1 = tr_read<v_rd_off<DV>(D0, 1, 0)>(vb), h1 = tr_read<v_rd_off<DV>(D0, 1, 1)>(vb);
  const s16x4 l2 = tr_read<v_rd_off<DV>(D0, 2, 0)>(vb), h2 = tr_read<v_rd_off<DV>(D0, 2, 1)>(vb), l3 = tr_read<v_rd_off<DV>(D0, 3, 0)>(vb), h3 = tr_read<v_rd_off<DV>(D0, 3, 1)>(vb);
  asm volatile("s_waitcnt lgkmcnt(0)" ::: "memory"); SBAR();
#define PK(L, H) (bf16x8){L[0], L[1], L[2], L[3], H[0], H[1], H[2], H[3]}
  od = __builtin_amdgcn_mfma_f32_32x32x16_bf16(pa0, PK(l0, h0), od, 0, 0, 0);
  od = __builtin_amdgcn_mfma_f32_32x32x16_bf16(pa1, PK(l1, h1), od, 0, 0, 0);
  od = __builtin_amdgcn_mfma_f32_32x32x16_bf16(pa2, PK(l2, h2), od, 0, 0, 0);
  od = __builtin_amdgcn_mfma_f32_32x32x16_bf16(pa3, PK(l3, h3), od, 0, 0, 0);
#undef PK
}
template <int DV> __device__ __forceinline__ void pv_all(f32x16* o, int vb, bf16x8 pa0, bf16x8 pa1, bf16x8 pa2, bf16x8 pa3) {
  pv_one<DV, 0>(o[0], vb, pa0, pa1, pa2, pa3); pv_one<DV, 1>(o[1], vb, pa0, pa1, pa2, pa3);
  if constexpr (DV == 128) { pv_one<DV, 2>(o[2], vb, pa0, pa1, pa2, pa3); pv_one<DV, 3>(o[3], vb, pa0, pa1, pa2, pa3); }
}
struct UnitP {
  const bf16_t* Q;
  const bf16_t *Kc, *Vc, *Kn, *Vn;
  const bf16_t *Pc, *Pn;
  bf16_t* O;
  int NT; float m0, l0; int a0, a1;
};
template <int MODE> __device__ __forceinline__ void apply_mask(f32x16& p0, f32x16& p1, int jj, const UnitP& u, int wid, int r32, int hi, const float* bias_l) {
  const float NEG = -1e30f;
  if constexpr (MODE == 2) {
    const int ks = u.a0 - 128 + 64 * jj; const bool tv = (ks >= 0 && ks < SEQ);
    const int lo = 64 * jj - 128 - (wid * 32 + 31), hi_ = 64 * jj - 128 + 63 - wid * 32;
    if (!tv || lo > 128 || hi_ < -128) {
#pragma unroll
      for (int r = 0; r < 16; ++r) { p0[r] = NEG; p1[r] = NEG; }
    } else if (!(lo >= -128 && hi_ <= 128)) {
      const int rel0 = -128 + 64 * jj - (wid * 32 + r32);
#pragma unroll
      for (int r = 0; r < 16; ++r) { const int rel = rel0 + crow(r, hi);
        const bool ok0 = (unsigned)(rel + 128) <= 256u, ok1 = (unsigned)(rel + 160) <= 256u;
        p0[r] = ok0 ? p0[r] : NEG; p1[r] = ok1 ? p1[r] : NEG; }
    }
  } else if constexpr (MODE == 1) {
    int r32o = r32; asm volatile("" : "+v"(r32o));
    const int r = u.a0 + (wid >> 1), c = (wid & 1) * 32 + r32o, kr = u.a1 + jj;
    const int rs = min(max(r - 4, 0), 120), cs = min(max(c - 8, 0), 48); const bool rok = (kr >= rs && kr < rs + 8);
    if (!rok) {
#pragma unroll
      for (int q = 0; q < 16; ++q) { p0[q] = NEG; p1[q] = NEG; }
    } else {
      const int xb = 4 * hi - c + 15, xlo = cs - c + 15; const float* brow = bias_l + (kr - r + 7) * 31 + xb;
#pragma unroll
      for (int q = 0; q < 16; ++q) { const int kq = (q & 3) + 8 * (q >> 2);
        const bool ok0 = (unsigned)(xb + kq - xlo) < 16u, ok1 = (unsigned)(xb + kq + 32 - xlo) < 16u;
        const float b0 = brow[kq], b1 = brow[kq + 32];
        p0[q] = ok0 ? p0[q] + b0 : NEG; p1[q] = ok1 ? p1[q] + b1 : NEG;
        if ((q & 3) == 3) asm volatile("" ::: "memory"); }
    }
  }
}
template <int MODE> __device__ __forceinline__ bool tile_active(const UnitP& u, int j, int wid) {
  if (MODE == 0 || j < 4) return true;
  const int jj = j - 4;
  if (MODE == 1) { const int r = u.a0 + (wid >> 1), kr = u.a1 + jj, rs = min(max(r - 4, 0), 120); return kr >= rs && kr < rs + 8; }
  const int ks = u.a0 - 128 + 64 * jj; const int lo = 64 * jj - 128 - (wid * 32 + 31), hi_ = 64 * jj - 128 + 63 - wid * 32;
  return ks >= 0 && ks < SEQ && lo <= 128 && hi_ >= -128;
}
template <int DK, int DV, int LDQ, int LDK, int LDV, int MODE, int SDEPTH, bool SERIAL, bool EARLY>
__device__ __forceinline__ void attn_unit(const UnitP& u, char* lds, const float* bias_l, const int tid) {
  constexpr float SCALE = (DK == 192) ? 0.07216878364870322f : 0.125f;
  constexpr float C = SCALE * 1.4426950408889634f, THRS = 8.f / SCALE;
  constexpr int KROW = DK * 2 + 16, SHM_V = 64 * DV * 2, SHM_K = 64 * KROW, KC = DK / 64, VC = DV / 64, ND = DK / 16, NO = DV / 32;
  const int wid = __builtin_amdgcn_readfirstlane(tid >> 6), lane = tid & 63, r32 = lane & 31, hi = lane >> 5;
  constexpr int NSL = EARLY ? 3 : 2;
  char* V_lds = lds; char* K_lds = lds + NSL * SHM_V;
  float* ws = (float*)(lds + NSL * SHM_V + NSL * SHM_K) + wid * 64; float* li_l = ws; float* al_l = ws + 32;
  float m_reg = u.m0, l_reg = u.l0; f32x16 o[NO]; bf16x8 qr[ND];
#pragma unroll
  for (int d = 0; d < NO; ++d) o[d] = f32x16{};
  const bf16_t* Qw = u.Q + (long)(wid * 32 + r32) * LDQ + hi * 8;
#pragma unroll
  for (int d0 = 0; d0 < ND; ++d0) qr[d0] = *reinterpret_cast<const bf16x8*>(Qw + d0 * 16);
  const unsigned srow = tid >> 3, sch = tid & 7;
  const unsigned kofs0 = srow * LDK + sch * 8, vofs0 = srow * LDV + sch * 8, pofs0 = srow * 64 + sch * 8;
  const unsigned kdst0 = srow * KROW + sch * 16, vdst0 = (unsigned)v_st<DV>((int)srow, (int)sch * 8);
  const int vb0 = (int)(uintptr_t)V_lds + v_rd_base(lane);
  const unsigned kb = (unsigned)(r32 * KROW + hi * 16);
  struct { bf16x8 k[KC]; bf16x8 v[VC]; } sr_[SDEPTH];
#define LBAR() asm volatile("s_waitcnt lgkmcnt(0)\n\ts_barrier" ::: "memory")
#define TILE_PTRS(j, Kt, Vt) do { if ((j) < 4) { Kt = u.Kc + (long)(j) * 64 * LDK; Vt = u.Vc + (long)(j) * 64 * LDV; } \
    else if (MODE == 2) { int ks_ = u.a0 - 128 + 64 * ((j) - 4); if (ks_ < 0 || ks_ >= SEQ) ks_ = 0; Kt = u.Kn + (long)ks_ * LDK; Vt = u.Vn + (long)ks_ * LDV; } \
    else { Kt = u.Kn + (long)((j) - 4) * 64 * LDK; Vt = u.Vn + (long)((j) - 4) * 64 * LDV; } } while (0)
#define SLOAD(i, j) do { const bf16_t *Kt_, *Vt_; TILE_PTRS(j, Kt_, Vt_); \
    _Pragma("unroll") for (int c = 0; c < VC; ++c) sr_[i].v[c] = *reinterpret_cast<const bf16x8*>(Vt_ + vofs0 + 64 * c); \
    _Pragma("unroll") for (int c = 0; c < KC; ++c) { if (DK == 192 && c == 2) { const bf16_t* Pt_ = ((j) < 4) ? u.Pc + (long)(j) * 64 * 64 : u.Pn + (long)((j) - 4) * 64 * 64; \
        sr_[i].k[c] = *reinterpret_cast<const bf16x8*>(Pt_ + pofs0); } else sr_[i].k[c] = *reinterpret_cast<const bf16x8*>(Kt_ + kofs0 + 64 * c); } } while (0)
#define SWRITE(b, i) do { _Pragma("unroll") for (int c = 0; c < VC; ++c) *(bf16x8*)(V_lds + (b) * SHM_V + vdst0 + 1024 * c) = sr_[i].v[c]; \
    _Pragma("unroll") for (int c = 0; c < KC; ++c) *(bf16x8*)(K_lds + (b) * SHM_K + kdst0 + 128 * c) = sr_[i].k[c]; } while (0)
#define SWAIT() do { if constexpr (SDEPTH == 2) asm volatile("s_waitcnt vmcnt(%0)" :: "n"(KC + VC) : "memory"); else asm volatile("s_waitcnt vmcnt(0)" ::: "memory"); } while (0)
#define RESC(a) do { if (__any((a) < 1.f)) { if (hi == 0) al_l[r32] = (a); asm volatile("s_waitcnt lgkmcnt(0)" ::: "memory"); \
    _Pragma("unroll") for (int d = 0; d < NO; ++d) _Pragma("unroll") for (int r = 0; r < 16; ++r) o[d][r] *= al_l[crow(r, hi)]; } } while (0)
#define MASK(P0, P1, j) do { if (MODE != 0 && (j) >= 4) apply_mask<MODE>(P0, P1, (j) - 4, u, wid, r32, hi, bias_l); } while (0)
  bf16x8 pa0, pa1, pa2, pa3; const int NT = u.NT;
  if constexpr (SERIAL) {
    f32x16 p0, p1; float mn, al;
    SLOAD(0, 0); asm volatile("s_waitcnt vmcnt(0)" ::: "memory"); SWRITE(0, 0); LBAR();
    for (int j = 0; j < NT; ++j) {
      const int b = j & 1;
      if (j + 1 < NT) SLOAD(0, j + 1);
      SBAR(); qkt<DK>(p0, p1, K_lds + b * SHM_K, qr, kb); MASK(p0, p1, j);
      partialSM(p0, p1, m_reg, mn, al, C, THRS); RESC(al);
      finishSM(p0, p1, al, l_reg, pa0, pa1, pa2, pa3); SBAR();
      pv_all<DV>(o, vb0 + b * SHM_V, pa0, pa1, pa2, pa3); SBAR();
      if (j + 1 < NT) SWRITE(b ^ 1, 0);
      LBAR();
    }
  } else {
  f32x16 pA0, pA1, pB0, pB1; float mnA, mnB, alA, alB;
  constexpr int SE = 0, SO = SDEPTH - 1;
  if constexpr (EARLY) {
  static_assert(!EARLY || SDEPTH == 1, "RING3 is an SDEPTH == 1 schedule");
  int s_prev = 0, s_cur = 0, s_next = 1;
#define ROT3() do { s_prev = s_cur; s_cur = s_next; s_next = (s_next == 2) ? 0 : s_next + 1; } while (0)
  SLOAD(0, 0); asm volatile("s_waitcnt vmcnt(0)" ::: "memory"); SWRITE(0, 0); LBAR();
  SLOAD(0, 1);
  qkt<DK>(pA0, pA1, K_lds, qr, kb); SBAR();
  asm volatile("s_waitcnt vmcnt(0)" ::: "memory"); SWRITE(1, 0); SBAR(); if (2 < NT) SLOAD(0, 2); SBAR();
  partialSM(pA0, pA1, m_reg, mnA, alA, C, THRS); LBAR(); ROT3();
  for (int t = 1; t + 1 < NT; t += 2) {
    asm volatile("s_waitcnt vmcnt(0)" ::: "memory"); SWRITE(s_next, 0); SBAR();
    qkt<DK>(pB0, pB1, K_lds + s_cur * SHM_K, qr, kb); finishSM(pA0, pA1, alA, l_reg, pa0, pa1, pa2, pa3); SBAR();
    if (t + 2 < NT) SLOAD(0, t + 2); SBAR();
    pv_all<DV>(o, vb0 + s_prev * SHM_V, pa0, pa1, pa2, pa3); MASK(pB0, pB1, t); partialSM(pB0, pB1, m_reg, mnB, alB, C, THRS);
    RESC(alB); LBAR(); ROT3();
    asm volatile("s_waitcnt vmcnt(0)" ::: "memory"); SWRITE(s_next, 0); SBAR();
    qkt<DK>(pA0, pA1, K_lds + s_cur * SHM_K, qr, kb); finishSM(pB0, pB1, alB, l_reg, pa0, pa1, pa2, pa3); SBAR();
    if (t + 3 < NT) SLOAD(0, t + 3); SBAR();
    pv_all<DV>(o, vb0 + s_prev * SHM_V, pa0, pa1, pa2, pa3); MASK(pA0, pA1, t + 1); partialSM(pA0, pA1, m_reg, mnA, alA, C, THRS);
    RESC(alA); LBAR(); ROT3();
  }
  SBAR(); qkt<DK>(pB0, pB1, K_lds + s_cur * SHM_K, qr, kb); finishSM(pA0, pA1, alA, l_reg, pa0, pa1, pa2, pa3); SBAR();
  pv_all<DV>(o, vb0 + s_prev * SHM_V, pa0, pa1, pa2, pa3); MASK(pB0, pB1, NT - 1); partialSM(pB0, pB1, m_reg, mnB, alB, C, THRS);
  RESC(alB);
  finishSM(pB0, pB1, alB, l_reg, pa0, pa1, pa2, pa3); SBAR();
  pv_all<DV>(o, vb0 + s_cur * SHM_V, pa0, pa1, pa2, pa3);
#undef ROT3
  } else {
  if constexpr (MODE == 0) {
  SLOAD(SE, 0); asm volatile("s_waitcnt vmcnt(0)" ::: "memory"); SWRITE(0, SE); LBAR();
  qkt<DK>(pA0, pA1, K_lds, qr, kb); partialSM(pA0, pA1, m_reg, mnA, alA, C, THRS);
  SLOAD(SO, 1); if constexpr (SDEPTH == 2) { if (2 < NT) SLOAD(SE, 2); }
  SWAIT(); SWRITE(1, SO); LBAR();
  for (int j = 1; j + 1 < NT; j += 2) {
    SBAR(); qkt<DK>(pB0, pB1, K_lds + SHM_K, qr, kb); finishSM(pA0, pA1, alA, l_reg, pa0, pa1, pa2, pa3); SBAR();
    SLOAD(SO, j + SDEPTH); SBAR();
    pv_all<DV>(o, vb0, pa0, pa1, pa2, pa3); MASK(pB0, pB1, j); partialSM(pB0, pB1, m_reg, mnB, alB, C, THRS);
    LBAR(); SWAIT(); SWRITE(0, SE);
    RESC(alB); LBAR();
    SBAR(); qkt<DK>(pA0, pA1, K_lds, qr, kb); finishSM(pB0, pB1, alB, l_reg, pa0, pa1, pa2, pa3); SBAR();
    if (SDEPTH == 1 || j + 3 < NT) SLOAD(SE, j + 1 + SDEPTH); SBAR();
    pv_all<DV>(o, vb0 + SHM_V, pa0, pa1, pa2, pa3); MASK(pA0, pA1, j + 1); partialSM(pA0, pA1, m_reg, mnA, alA, C, THRS);
    LBAR(); SWAIT(); SWRITE(1, SO);
    RESC(alA); LBAR();
  }
  SBAR(); qkt<DK>(pB0, pB1, K_lds + SHM_K, qr, kb); finishSM(pA0, pA1, alA, l_reg, pa0, pa1, pa2, pa3); SBAR();
  pv_all<DV>(o, vb0, pa0, pa1, pa2, pa3); MASK(pB0, pB1, NT - 1); partialSM(pB0, pB1, m_reg, mnB, alB, C, THRS);
  LBAR(); RESC(alB);
  finishSM(pB0, pB1, alB, l_reg, pa0, pa1, pa2, pa3); SBAR();
  pv_all<DV>(o, vb0 + SHM_V, pa0, pa1, pa2, pa3);
  } else {
  SLOAD(SE, 0); asm volatile("s_waitcnt vmcnt(0)" ::: "memory"); SWRITE(0, SE); LBAR();
  qkt<DK>(pA0, pA1, K_lds, qr, kb); partialSM(pA0, pA1, m_reg, mnA, alA, C, THRS);
  SLOAD(SO, 1); if constexpr (SDEPTH == 2) { if (2 < NT) SLOAD(SE, 2); }
  SWAIT(); SWRITE(1, SO); LBAR();
  bool actA = true, actB = true;
  for (int j = 1; j + 1 < NT; j += 2) {
    actB = tile_active<MODE>(u, j, wid);
    SBAR();
    if (actA && actB) { qkt<DK>(pB0, pB1, K_lds + SHM_K, qr, kb); finishSM(pA0, pA1, alA, l_reg, pa0, pa1, pa2, pa3); }
    else { if (actB) qkt<DK>(pB0, pB1, K_lds + SHM_K, qr, kb); if (actA) finishSM(pA0, pA1, alA, l_reg, pa0, pa1, pa2, pa3); }
    SBAR(); SLOAD(SO, j + SDEPTH); SBAR();
    alB = 1.f;
    if (actA && actB) { pv_all<DV>(o, vb0, pa0, pa1, pa2, pa3); MASK(pB0, pB1, j); partialSM(pB0, pB1, m_reg, mnB, alB, C, THRS); }
    else { if (actA) pv_all<DV>(o, vb0, pa0, pa1, pa2, pa3); if (actB) { MASK(pB0, pB1, j); partialSM(pB0, pB1, m_reg, mnB, alB, C, THRS); } }
    LBAR(); SWAIT(); SWRITE(0, SE);
    RESC(alB); LBAR();
    actA = tile_active<MODE>(u, j + 1, wid);
    SBAR();
    if (actA && actB) { qkt<DK>(pA0, pA1, K_lds, qr, kb); finishSM(pB0, pB1, alB, l_reg, pa0, pa1, pa2, pa3); }
    else { if (actA) qkt<DK>(pA0, pA1, K_lds, qr, kb); if (actB) finishSM(pB0, pB1, alB, l_reg, pa0, pa1, pa2, pa3); }
    SBAR(); if (SDEPTH == 1 || j + 3 < NT) SLOAD(SE, j + 1 + SDEPTH); SBAR();
    alA = 1.f;
    if (actA && actB) { pv_all<DV>(o, vb0 + SHM_V, pa0, pa1, pa2, pa3); MASK(pA0, pA1, j + 1); partialSM(pA0, pA1, m_reg, mnA, alA, C, THRS); }
    else { if (actB) pv_all<DV>(o, vb0 + SHM_V, pa0, pa1, pa2, pa3); if (actA) { MASK(pA0, pA1, j + 1); partialSM(pA0, pA1, m_reg, mnA, alA, C, THRS); } }
    LBAR(); SWAIT(); SWRITE(1, SO);
    RESC(alA); LBAR();
  }
  actB = tile_active<MODE>(u, NT - 1, wid);
  SBAR(); if (actB) qkt<DK>(pB0, pB1, K_lds + SHM_K, qr, kb); if (actA) finishSM(pA0, pA1, alA, l_reg, pa0, pa1, pa2, pa3); SBAR();
  alB = 1.f;
  if (actA) pv_all<DV>(o, vb0, pa0, pa1, pa2, pa3);
  if (actB) { MASK(pB0, pB1, NT - 1); partialSM(pB0, pB1, m_reg, mnB, alB, C, THRS); }
  LBAR(); RESC(alB);
  if (actB) { finishSM(pB0, pB1, alB, l_reg, pa0, pa1, pa2, pa3); SBAR(); pv_all<DV>(o, vb0 + SHM_V, pa0, pa1, pa2, pa3); }
  }
  }
  }
  { int lane2; asm volatile("v_mbcnt_lo_u32_b32 %0, -1, 0\n\tv_mbcnt_hi_u32_b32 %0, -1, %0" : "=v"(lane2)); const int wid2 = wid, r32b = lane2 & 31, hib = lane2 >> 5;
    float* li2 = (float*)(lds + NSL * SHM_V + NSL * SHM_K) + wid2 * 64;
    if (hib == 0) li2[r32b] = l_reg; asm volatile("s_waitcnt lgkmcnt(0)" ::: "memory");
    LBAR();
    bf16_t* stg = (bf16_t*)lds + wid2 * 32 * DV;
#pragma unroll
    for (int r = 0; r < 16; ++r) { const int orow = crow(r, hib); const float rl = __builtin_amdgcn_rcpf(li2[orow]);
#pragma unroll
      for (int d0 = 0; d0 < NO; ++d0) { const unsigned w = cvtpk(o[d0][r] * rl, 0.f); stg[orow * DV + d0 * 32 + r32b] = (bf16_t)(w & 0xffffu); } }
    asm volatile("s_waitcnt lgkmcnt(0)" ::: "memory");
    bf16_t* Ow = u.O + (long)(wid2 * 32) * DM;
#pragma unroll
    for (int i = 0; i < (32 * DV / 8) / 64; ++i) { const int id = i * 64 + lane2, row = id / (DV / 8), ch = id % (DV / 8);
      const u32x4 v = *(const u32x4*)(stg + row * DV + ch * 8); *(u32x4*)(Ow + (long)row * DM + ch * 8) = v; } }
  LBAR();
#undef LBAR
#undef TILE_PTRS
#undef SLOAD
#undef SWRITE
#undef SWAIT
#undef RESC
#undef MASK
}
#undef SBAR
}
typedef unsigned short bf16_t;
typedef float f32x4 __attribute__((ext_vector_type(4)));
typedef unsigned u32x4 __attribute__((ext_vector_type(4)));
typedef unsigned u32x2 __attribute__((ext_vector_type(2)));
#define LAS __attribute__((address_space(3)))
#define XB_TMO      128
#define XB_XCNT(j)  (256  + 64 * (j))
#define XB_XSUB(j)  (1280 + 64 * (j))
#define XB_XGEN(j)  (2304 + 64 * (j))
#define XB_TOP      3328
#define XB_TOPGEN   3392
#define XCD_BAR_WORDS 3456
#define XB_SPIN_CAP (1u << 18)

__device__ __forceinline__ unsigned xb_ld(unsigned* p)              { return __hip_atomic_load(p, __ATOMIC_RELAXED, __HIP_MEMORY_SCOPE_AGENT); }
__device__ __forceinline__ unsigned xb_add(unsigned* p, unsigned v) { return __hip_atomic_fetch_add(p, v, __ATOMIC_RELAXED, __HIP_MEMORY_SCOPE_AGENT); }
__device__ __forceinline__ unsigned xb_xcc_id() { return (unsigned)__builtin_amdgcn_s_getreg((3 << 11) | 20) & 0xFu; }
#define XB_SPIN(cond, bar) do { unsigned _sp = 0; while (cond) { __builtin_amdgcn_s_sleep(1); \
    if ((++_sp & 255u) == 0u) { if (xb_ld(&(bar)[XB_TMO])) break; if (_sp > XB_SPIN_CAP) { atomicAdd(&(bar)[XB_TMO], 1u); break; } } } } while (0)

struct XcdBarrier {
    unsigned* bar; unsigned x;
    volatile LAS unsigned* st;
};

__device__ __forceinline__ XcdBarrier xcd_barrier_post(unsigned* bar, volatile LAS unsigned* st) {
    XcdBarrier b; b.bar = bar; b.x = xb_xcc_id(); b.st = st;
    if (threadIdx.x == 0) (void)xb_add(&bar[XB_XCNT(b.x)], 1u);
    return b;
}
__device__ __forceinline__ void xcd_barrier_complete(unsigned* bar, unsigned x, unsigned& nloc, unsigned& nx) {
    const unsigned G = gridDim.x * gridDim.y * gridDim.z;
    unsigned sum, cnt, mine, sp = 0u;
    for (;;) {
        sum = 0u; cnt = 0u; mine = 0u;
#pragma unroll
        for (unsigned j = 0; j < 16; ++j) { const unsigned c = xb_ld(&bar[XB_XCNT(j)]); sum += c; cnt += (c > 0u) ? 1u : 0u; mine = (j == x) ? c : mine; }
        if (sum == G) break;
        __builtin_amdgcn_s_sleep(1);
        if ((++sp & 255u) == 0u) { if (xb_ld(&bar[XB_TMO])) break; if (sp > XB_SPIN_CAP) { atomicAdd(&bar[XB_TMO], 1u); break; } }
    }
    nloc = mine > 0u ? mine : 1u; nx = cnt > 0u ? cnt : 1u;
}

__device__ __forceinline__ void xcd_barrier(const XcdBarrier& b, const int tid) {
    asm volatile("s_waitcnt vmcnt(0)" ::: "memory");
    __syncthreads();
    if (tid == 0) {
        unsigned* bar = b.bar;
        __builtin_amdgcn_s_waitcnt(0);
        unsigned nloc = b.st[0], nx = b.st[1];
        if (nloc == 0u) { xcd_barrier_complete(bar, b.x, nloc, nx); b.st[0] = nloc; b.st[1] = nx; }
        const unsigned old = xb_add(&bar[XB_XSUB(b.x)], 1u);
        const unsigned gen = old / nloc;
        if (old + 1u == (gen + 1u) * nloc) {
            __builtin_amdgcn_fence(__ATOMIC_RELEASE, "agent");
            asm volatile("s_waitcnt vmcnt(0)" ::: "memory");
            const unsigned og = xb_add(&bar[XB_TOP], 1u);
            const unsigned tg = og / nx;
            if (og + 1u == (tg + 1u) * nx) xb_add(&bar[XB_TOPGEN], 1u);
            else XB_SPIN(xb_ld(&bar[XB_TOPGEN]) == tg, bar);
            __builtin_amdgcn_fence(__ATOMIC_ACQUIRE, "agent");
            xb_add(&bar[XB_XGEN(b.x)], 1u);
            asm volatile("s_waitcnt vmcnt(0)" ::: "memory");
        } else {
            XB_SPIN(xb_ld(&bar[XB_XGEN(b.x)]) == gen, bar);
            __builtin_amdgcn_fence(__ATOMIC_ACQUIRE, "agent");
            asm volatile("s_waitcnt vmcnt(0)" ::: "memory");
        }
    }
    __syncthreads();
}

constexpr size_t MiB = 1u << 20;
constexpr size_t WS_BAR = 7 * MiB, BAR_BYTES = FUSED_NORM ? 1 * MiB : 16384;
constexpr size_t WS_MOD = 0, WS_ROPE = 1 * MiB, WS_XCTX = 3 * MiB;
constexpr size_t WS_WFI = 8 * MiB, WS_WFO = 52 * MiB, WS_WMLA = 74 * MiB, WS_WNA = 85 * MiB, WS_WSWA = 93 * MiB;
constexpr size_t MLA_W_STRIDE = (size_t)(768 * 1024 + 1536 * 256 + 2048 * 256 + 1024 * 1024) * 2;
constexpr size_t MLA_OFF_UQ = (size_t)768 * 1024 * 2, MLA_OFF_UKV = MLA_OFF_UQ + (size_t)1536 * 256 * 2, MLA_OFF_WO = MLA_OFF_UKV + (size_t)2048 * 256 * 2;
constexpr size_t WS_XN = 98 * MiB, WS_S = 164 * MiB, WS_Q = 197 * MiB, WS_K = 296 * MiB, WS_V = 395 * MiB, WS_SLOT = 461 * MiB, WS_PART = 463 * MiB, WS_END = 507 * MiB, WS_KPE = 463 * MiB, WS_NEED = 468 * MiB;
constexpr size_t SLOT_BYTES = (size_t)TOK * 4 * 4;
constexpr size_t WS_CNT = 7 * MiB + 65536, CNT_BANK = 132 * 256;
static_assert(WS_SLOT + 2 * SLOT_BYTES <= WS_PART && WS_PART + (size_t)11 * NCTX * DM * 4 <= WS_END && WS_CNT + 16 * CNT_BANK <= 8 * MiB, "slots/counters");
static_assert(WS_WMLA + 2 * MLA_W_STRIDE <= WS_WNA && WS_XN + (size_t)TOK * DM * 2 <= WS_S && WS_S + (size_t)TOK * 512 * 2 <= WS_Q, "ws map");
static_assert(WS_Q + (size_t)TOK * 1536 * 2 <= WS_K && WS_K + (size_t)TOK * 8 * 192 * 2 <= WS_V && WS_V + (size_t)TOK * DM * 2 <= WS_SLOT, "ws map 2");
static_assert(WS_Q + (size_t)TOK * 3072 * 2 <= WS_V && WS_Q + (size_t)TOK * DFF * 2 <= WS_V, "overlays");
static_assert(FUSE_LAT && !SPLIT_CTX && WS_KPE + (size_t)NBATCH * MLA_KEYS * 64 * 2 <= WS_NEED, "the shared rotary-key buffer is written by the fused latent epilogue and overlays WS_PART");
constexpr int LDS_BYTES = 147456, NWAVES = 8, NTHREADS = 512;
constexpr float NORM_EPS = 1e-6f;

struct WDesc { const float* src; bf16_t* dst; int K, N, Np, kind, first, pad; };
constexpr int NWD = 20;
struct Params {
  const float* in[24]; float* out; unsigned char* ws;
  int nph, lo, hi, nitems;
  unsigned char prog[64];
  WDesc wd[NWD];
};

__device__ __forceinline__ unsigned f2bf(float f) { unsigned u = __builtin_bit_cast(unsigned, f); return (u + 0x7fffu + ((u >> 16) & 1u)) >> 16; }
__device__ __forceinline__ unsigned pk2(float lo, float hi) { return f2bf(lo) | (f2bf(hi) << 16); }
__device__ __forceinline__ float bf2f(unsigned short b) { return __builtin_bit_cast(float, (unsigned)b << 16); }
__device__ __forceinline__ float wave_sum(float v, int lane) {
#pragma unroll
  for (int o = 1; o < 64; o <<= 1) v += __builtin_bit_cast(float, __builtin_amdgcn_ds_bpermute((lane ^ o) << 2, __builtin_bit_cast(int, v)));
  return v;
}
__device__ __forceinline__ int srccol(int kind, int np) {
  switch (kind) {
    case 1: { const int grp = np >> 3, w = np & 7; return (w < 4) ? grp * 4 + w : DFF + grp * 4 + (w - 4); }
    case 2: { if (np < 512) return np; if (np < 576) { const int q = np - 512; return 512 + (q >> 1) + 32 * (q & 1); } return -1; }
    case 3: { const int h = np / 192, w = np % 192; if (w < 128) return np; const int q = w - 128; return h * 192 + 128 + (q >> 1) + 32 * (q & 1); }
    case 4: { if (np >= 1152) return np; const int hh = np >> 6, q = np & 63; return hh * 64 + (q >> 1) + 32 * (q & 1); }
    default: return np;
  }
}
__device__ __forceinline__ void transpose_item(const WDesc& d, LAS float* scr, int item, int lane) {
  const int nblk = d.Np / 32, kb = item / nblk, nb = item % nblk, k0 = 64 * kb, n0 = 32 * nb;
  const int sc = srccol(d.kind, n0 + (lane & 31));
  float tv[32];
#pragma unroll
  for (int i = 0; i < 32; ++i) { const int kk = 2 * i + (lane >> 5); tv[i] = (sc >= 0) ? __builtin_nontemporal_load(d.src + (size_t)(k0 + kk) * d.N + sc) : 0.f; }
#pragma unroll
  for (int i = 0; i < 32; ++i) { const int kk = 2 * i + (lane >> 5); scr[kk * 33 + (lane & 31)] = tv[i]; }
  asm volatile("s_waitcnt lgkmcnt(0)" ::: "memory");
  const int c = lane & 7;
#pragma unroll
  for (int j = 0; j < 4; ++j) { const int n = (lane >> 3) + 8 * j; const LAS float* s = scr + (8 * c) * 33 + n;
    u32x4 o; o.x = pk2(s[0 * 33], s[1 * 33]); o.y = pk2(s[2 * 33], s[3 * 33]); o.z = pk2(s[4 * 33], s[5 * 33]); o.w = pk2(s[6 * 33], s[7 * 33]);
    *(u32x4*)(d.dst + (size_t)(n0 + n) * d.K + k0 + 8 * c) = o; }
  asm volatile("s_waitcnt lgkmcnt(0)" ::: "memory");
}
__device__ __forceinline__ float* xrow(const Params& P, int row) { return row < NLAT ? P.out + (size_t)row * DM : (float*)(P.ws + WS_XCTX) + (size_t)(row - NLAT) * DM; }
__device__ __forceinline__ const float* modvec(const Params& P, int layer, int row, int which) {
  const int r = row < NLAT ? (row >> 13) : 4; return (const float*)(P.ws + WS_MOD) + ((size_t)(layer * 5 + r) * 6 + which) * DM;
}
template <int NR> __device__ __forceinline__ void wave_sum_n(float (&s)[NR], int lane) {
#pragma unroll
  for (int o = 1; o < 64; o <<= 1) {
#pragma unroll
    for (int i = 0; i < NR; ++i) s[i] += __builtin_bit_cast(float, __builtin_amdgcn_ds_bpermute((lane ^ o) << 2, __builtin_bit_cast(int, s[i]))); }
}
__device__ __forceinline__ void row_pass_ctx(const Params& P, int gw, int NGW, int lane, const float* xs_ctx, const float* part, int nsplit, const float* g_post, int l_gate, int w_gate,
    const float* g_pre, int l_norm, int w_shift, int w_scale, float gscale) {
  for (int r = gw; r < NCTX; r += NGW) { const int row = NLAT + r;
    f32x4 a[4], v[4];
#pragma unroll
    for (int j = 0; j < 4; ++j) { a[j] = (f32x4){0.f, 0.f, 0.f, 0.f}; v[j] = *(const f32x4*)(xs_ctx + (size_t)r * DM + 4 * lane + 256 * j); }
    for (int s = 0; s < nsplit; ++s) {
#pragma unroll
      for (int j = 0; j < 4; ++j) a[j] += *(const f32x4*)(part + ((size_t)s * NCTX + r) * DM + 4 * lane + 256 * j); }
    float ss = 0.f;
#pragma unroll
    for (int j = 0; j < 4; ++j) ss += (a[j][0] * a[j][0] + a[j][1] * a[j][1]) + (a[j][2] * a[j][2] + a[j][3] * a[j][3]);
    float rstd = 1.0f / sqrtf(wave_sum(ss, lane) * (1.0f / DM) + NORM_EPS);
    const float* gate = modvec(P, l_gate, row, w_gate); float* xd = xrow(P, row);
#pragma unroll
    for (int j = 0; j < 4; ++j) { const int c = 4 * lane + 256 * j; const f32x4 g = *(const f32x4*)(g_post + c), gt = *(const f32x4*)(gate + c) * gscale; v[j] = v[j] + gt * (a[j] * rstd * g); *(f32x4*)(xd + c) = v[j]; }
    ss = 0.f;
#pragma unroll
    for (int j = 0; j < 4; ++j) ss += (v[j][0] * v[j][0] + v[j][1] * v[j][1]) + (v[j][2] * v[j][2] + v[j][3] * v[j][3]);
    rstd = 1.0f / sqrtf(wave_sum(ss, lane) * (1.0f / DM) + NORM_EPS);
    const float* shift = modvec(P, l_norm, row, w_shift); const float* scale = modvec(P, l_norm, row, w_scale); bf16_t* xn = (bf16_t*)(P.ws + WS_XN) + (size_t)row * DM;
#pragma unroll
    for (int j = 0; j < 4; ++j) { const int c = 4 * lane + 256 * j; const f32x4 g = *(const f32x4*)(g_pre + c), sh = *(const f32x4*)(shift + c), sc = *(const f32x4*)(scale + c);
      const f32x4 h = (v[j] * rstd * g) * (1.0f + sc) + sh; u32x2 w; w.x = pk2(h[0], h[1]); w.y = pk2(h[2], h[3]); *(u32x2*)(xn + c) = w; }
  }
}
template <int NR> __device__ __forceinline__ void row_pass_multi(const Params& P, int gw, int NGW, int nrows, int lane, const float* xs_lat, const float* xs_ctx,
    bool has_res, const bf16_t* src, const float* g_post, int l_gate, int w_gate, bool do_norm, const float* g_pre, int l_norm, int w_shift, int w_scale, float gscale = 1.0f) {
  f32x4 gp[4], gq[4], gtv[4], shv[4], scv[4]; int cur_g = -1, cur_n = -1;
#pragma unroll
  for (int j = 0; j < 4; ++j) { gp[j] = has_res ? *(const f32x4*)(g_post + 4 * lane + 256 * j) : (f32x4){0.f, 0.f, 0.f, 0.f}; gq[j] = do_norm ? *(const f32x4*)(g_pre + 4 * lane + 256 * j) : (f32x4){0.f, 0.f, 0.f, 0.f};
    gtv[j] = shv[j] = scv[j] = (f32x4){0.f, 0.f, 0.f, 0.f}; }
  for (int base = gw; base < nrows; base += NR * NGW) {
    u32x2 raw[NR][4]; f32x4 v[NR][4];
#pragma unroll
    for (int i = 0; i < NR; ++i) { const int row = base + i * NGW;
      if (row < nrows) { const float* xs = row < NLAT ? xs_lat + (size_t)row * DM : xs_ctx + (size_t)(row - NLAT) * DM;
#pragma unroll
        for (int j = 0; j < 4; ++j) v[i][j] = __builtin_nontemporal_load((const f32x4*)(xs + 4 * lane + 256 * j));
        if (has_res) {
#pragma unroll
          for (int j = 0; j < 4; ++j) raw[i][j] = __builtin_nontemporal_load((const u32x2*)(src + (size_t)row * DM + 4 * lane + 256 * j)); }
      } else {
#pragma unroll
        for (int j = 0; j < 4; ++j) { v[i][j] = (f32x4){0.f, 0.f, 0.f, 0.f}; raw[i][j] = (u32x2){0u, 0u}; } } }
    if (has_res) {
      float ss[NR];
#pragma unroll
      for (int i = 0; i < NR; ++i) { ss[i] = 0.f;
#pragma unroll
        for (int j = 0; j < 4; ++j) { const float a0 = __builtin_bit_cast(float, raw[i][j].x << 16), a1 = __builtin_bit_cast(float, raw[i][j].x & 0xffff0000u), a2 = __builtin_bit_cast(float, raw[i][j].y << 16), a3 = __builtin_bit_cast(float, raw[i][j].y & 0xffff0000u);
          ss[i] += (a0 * a0 + a1 * a1) + (a2 * a2 + a3 * a3); } }
      wave_sum_n<NR>(ss, lane);
#pragma unroll
      for (int i = 0; i < NR; ++i) { const int row = base + i * NGW;
        if (row < nrows) { const float rstd = 1.0f / sqrtf(ss[i] * (1.0f / DM) + NORM_EPS); float* xd = xrow(P, row);
          const int rm = row < NLAT ? (row >> 13) : 4;
          if (rm != cur_g) { const float* gate = modvec(P, l_gate, row, w_gate); cur_g = rm;
#pragma unroll
            for (int j = 0; j < 4; ++j) gtv[j] = *(const f32x4*)(gate + 4 * lane + 256 * j) * gscale; }
#pragma unroll
          for (int j = 0; j < 4; ++j) { const int c = 4 * lane + 256 * j; const f32x4 g = gp[j], gt = gtv[j];
            f32x4 a; a[0] = __builtin_bit_cast(float, raw[i][j].x << 16); a[1] = __builtin_bit_cast(float, raw[i][j].x & 0xffff0000u); a[2] = __builtin_bit_cast(float, raw[i][j].y << 16); a[3] = __builtin_bit_cast(float, raw[i][j].y & 0xffff0000u);
            v[i][j] = v[i][j] + gt * (a * rstd * g); __builtin_nontemporal_store(v[i][j], (f32x4*)(xd + c)); } } }
    }
    if (do_norm) {
      float ss[NR];
#pragma unroll
      for (int i = 0; i < NR; ++i) { ss[i] = 0.f;
#pragma unroll
        for (int j = 0; j < 4; ++j) ss[i] += (v[i][j][0] * v[i][j][0] + v[i][j][1] * v[i][j][1]) + (v[i][j][2] * v[i][j][2] + v[i][j][3] * v[i][j][3]); }
      wave_sum_n<NR>(ss, lane);
#pragma unroll
      for (int i = 0; i < NR; ++i) { const int row = base + i * NGW;
        if (row < nrows) { const float rstd = 1.0f / sqrtf(ss[i] * (1.0f / DM) + NORM_EPS);
          const int rm = row < NLAT ? (row >> 13) : 4;
          if (rm != cur_n) { const float* shift = modvec(P, l_norm, row, w_shift); const float* scale = modvec(P, l_norm, row, w_scale); cur_n = rm;
#pragma unroll
            for (int j = 0; j < 4; ++j) { shv[j] = *(const f32x4*)(shift + 4 * lane + 256 * j); scv[j] = *(const f32x4*)(scale + 4 * lane + 256 * j); } }
          bf16_t* xn = (bf16_t*)(P.ws + WS_XN) + (size_t)row * DM;
#pragma unroll
          for (int j = 0; j < 4; ++j) { const int c = 4 * lane + 256 * j; const f32x4 g = gq[j], sh = shv[j], sc = scv[j];
            const f32x4 h = (v[i][j] * rstd * g) * (1.0f + sc) + sh; u32x2 w; w.x = pk2(h[0], h[1]); w.y = pk2(h[2], h[3]); *(u32x2*)(xn + c) = w; } } }
    }
  }
}

typedef const __attribute__((address_space(4))) Params* KargPtr;
__global__ void __launch_bounds__(NTHREADS, 2) fwd_mega(Params Pbyval) {
  extern __shared__ __attribute__((aligned(16))) unsigned char lds[];
  cg::grid_group grid = cg::this_grid();
  volatile LAS unsigned* bst = (volatile LAS unsigned*)((LAS unsigned char*)lds + (LDS_BYTES - 64));
  if (threadIdx.x < 2) bst[threadIdx.x] = 0u;
  __syncthreads();
  XcdBarrier xbar = xcd_barrier_post((unsigned*)(Pbyval.ws + WS_BAR), bst);
  const int G0 = gridDim.x, bx0 = blockIdx.x;
  const int ph_lo = Pbyval.lo, ph_hi = Pbyval.hi;

  const int wave0 = __builtin_amdgcn_readfirstlane(threadIdx.x >> 6);
  int ph_start = ph_lo;
  if (ph_lo == 0) {
    const int tid = threadIdx.x, lane = tid & 63, wave = wave0, G = G0, bx = bx0;
    const int vcu = (G % 8 == 0) ? (bx % 8) * (G / 8) + bx / 8 : bx, NGW = G * NWAVES, gw = vcu * NWAVES + wave;
    const Params& P = Pbyval; unsigned char* ws = P.ws;
      { LAS float* sc_l = (LAS float*)lds;
        LAS float* red = sc_l + 5 * DM;
        for (int i = tid; i < 5 * DM; i += NTHREADS) { const int r = i >> 10, k = i & 1023; const float c = (r < 4) ? P.in[1][r * DM + k] : P.in[3][k]; sc_l[i] = c / (1.0f + __expf(-c)); }
        __syncthreads();
        for (int task = bx; task < DEPTH * 96; task += G) { const int ly = task / 96, n0 = (task % 96) * 64;
          const float* W = P.in[4] + (size_t)ly * DM * 6 * DM + n0 + lane; float acc[5] = {0.f, 0.f, 0.f, 0.f, 0.f};
#pragma unroll 16
          for (int k = wave * 128; k < wave * 128 + 128; ++k) { const float w = __builtin_nontemporal_load(W + (size_t)k * 6 * DM);
#pragma unroll
            for (int r = 0; r < 5; ++r) acc[r] += sc_l[r * DM + k] * w; }
#pragma unroll
          for (int r = 0; r < 5; ++r) red[(wave * 5 + r) * 64 + lane] = acc[r];
          __syncthreads();
          if (tid < 320) { const int r = tid >> 6, n = tid & 63; float s = P.in[5][(size_t)ly * 6 * DM + n0 + n];
#pragma unroll
            for (int w = 0; w < 8; ++w) s += red[(w * 5 + r) * 64 + n];
            const int col = n0 + n; ((float*)(ws + WS_MOD))[((size_t)(ly * 5 + r) * 6 + (col >> 10)) * DM + (col & 1023)] = s; }
          __syncthreads(); }
      }
    ph_start = 1;
    if (ph_hi > 1) grid.sync();
  }
  int rep = 0; (void)rep;
#ifdef PROBE_EXTRA_SYNCS
  for (int i = 0; i < PROBE_EXTRA_SYNCS; ++i) xcd_barrier(xbar, (int)threadIdx.x);
#endif
  for (int ph = ph_start; ph < ph_hi; ++ph) {
#define FRESH_LANE(v) int v; asm volatile("v_mbcnt_lo_u32_b32 %0, -1, 0\n\tv_mbcnt_hi_u32_b32 %0, -1, %0" : "=v"(v))
    int wave = wave0; asm volatile("" : "+s"(wave));
    int G = G0, bx = bx0; asm volatile("" : "+s"(G), "+s"(bx));
    KargPtr Pq = (KargPtr)__builtin_amdgcn_kernarg_segment_ptr(); asm volatile("" : "+s"(Pq));
    const Params& P = *(const Params*)Pq;
    const int vcu = (G % 8 == 0) ? (bx % 8) * (G / 8) + bx / 8 : bx;
    const int NGW = G * NWAVES;
    const int gw = vcu * NWAVES + wave;
    unsigned char* ws = P.ws;
    const float* rope = (const float*)(ws + WS_ROPE);
    bf16_t* XN = (bf16_t*)(ws + WS_XN); bf16_t* SB = (bf16_t*)(ws + WS_S); bf16_t* QB = (bf16_t*)(ws + WS_Q); bf16_t* KB = (bf16_t*)(ws + WS_K); bf16_t* VB = (bf16_t*)(ws + WS_V);
    const int code = P.prog[ph], l = code >> 4, step = code & 15, kind = l % 3, jl = l / 3; const bool last = (l == DEPTH - 1);
    if (step == 1) {
      FRESH_LANE(lane); const int tid = wave * 64 + lane;
      { LAS float* scr = (LAS float*)lds + wave * (64 * 33);
        for (int it = gw; it < P.nitems; it += NGW) { int m = 0;
#pragma unroll 1
          for (int q = 1; q < NWD; ++q) if (it >= P.wd[q].first) m = q;
          transpose_item(P.wd[m], scr, it - P.wd[m].first, lane); } }
      for (int i = bx * NTHREADS + tid; i < SEQ * 32; i += G * NTHREADS) { const int t = i >> 5, p = i & 31; const float inv = powf(10000.0f, -(float)(p & 15) / 16.0f);
        const float ang = (float)((p < 16) ? (t >> 6) : (t & 63)) * inv; ((float*)(ws + WS_ROPE))[2 * i] = cosf(ang); ((float*)(ws + WS_ROPE))[2 * i + 1] = sinf(ang); }
      row_pass_multi<4>(P, gw, NGW, TOK, lane, P.in[0], P.in[2], false, nullptr, nullptr, 0, 0, true, P.in[6], 0, 0, 1);
#if FUSED_NORM
    } else if (step == 6 || step == 9) {
      pg8::Gemm g; g.M = last ? NLAT : TOK; g.N = DM;
      const unsigned char* wm = ws + WS_WMLA + (size_t)jl * MLA_W_STRIDE;
      pg8::NormArgs na; na.xlat = P.out; na.xctx = (float*)(ws + WS_XCTX); na.xn = XN; na.modl = (const float*)(ws + WS_MOD) + (size_t)l * 30 * DM;
      na.slot1 = (float*)(ws + WS_SLOT); na.slot2 = (float*)(ws + WS_SLOT + SLOT_BYTES);
      const int bank = (l * 2 + (step == 9 ? 1 : 0)) * 2; na.cnt1 = (unsigned*)(ws + WS_CNT + (size_t)bank * CNT_BANK); na.cnt2 = (unsigned*)(ws + WS_CNT + (size_t)(bank + 1) * CNT_BANK);
      if (step == 6) { g.A = XN; g.K = DM;
        g.Bt = (kind == 0) ? (const bf16_t*)(wm + MLA_OFF_WO) : (kind == 1) ? (const bf16_t*)(ws + WS_WNA + (size_t)3072 * 1024 * 2) : (const bf16_t*)(ws + WS_WSWA + (size_t)1280 * 1024 * 2);
        na.g_post = P.in[7] + l * DM; na.wgate = 2; na.do_norm = 1; na.g_pre = P.in[8] + l * DM; na.modn = na.modl; na.wshift = 3; na.wscale = 4;
      } else { g.A = QB; g.K = DFF; g.Bt = (const bf16_t*)(ws + WS_WFO) + (size_t)l * DM * DFF;
        const int ln = last ? l : l + 1;
        na.g_post = P.in[9] + l * DM; na.wgate = 5; na.do_norm = last ? 0 : 1; na.g_pre = P.in[6] + ln * DM; na.modn = (const float*)(ws + WS_MOD) + (size_t)ln * 30 * DM; na.wshift = 0; na.wscale = 1; }
      pg8::PanelOrder S; S.init(g.M, G, vcu); pg8::EpiNorm E{na, (LAS unsigned char*)lds + 131072};
#ifndef DBG_NO_GEMM
      FRESH_LANE(lane_f);
      pg8::gemm_phase<pg8::EpiNorm, pg8::PanelOrder, true, true>((LAS unsigned char*)lds, g, S, E, wave * 64 + lane_f);
#endif
      __syncthreads();
#endif
    } else if (step == 2 || step == 4 || step == 8 || ((step == 6 || step == 9) && !FUSED_NORM)) {
      const bool splitctx = SPLIT_CTX && (step == 6 || step == 9) && !last;
      const int ng = (step == 4 || splitctx) ? 2 : 1;
      for (int gi = 0; gi < ng; ++gi) {
        int nsplit = 1;
        pg8::Gemm g; g.nts = 0; pg8::EpiArgs ea; ea.rope = rope; ea.o1 = nullptr; ea.ldc = DM; ea.kind = 0; ea.o0 = nullptr; ea.g0 = nullptr; ea.g1 = nullptr; ea.xl = (LAS unsigned char*)lds + 131072;
        const unsigned char* wm = ws + WS_WMLA + (size_t)jl * MLA_W_STRIDE;
        g.M = (step >= 6 && (last || splitctx)) ? NLAT : TOK;
        if (step == 2) { g.A = XN; g.K = DM;
#if FUSE_LAT
          if (kind == 0) { g.Bt = (const bf16_t*)wm; g.N = 768; ea.kind = 6; ea.o0 = SB; ea.o1 = (bf16_t*)(ws + WS_KPE); ea.g0 = P.in[13] + jl * 256; ea.g1 = P.in[15] + jl * 256; }
#else
          if (kind == 0) { g.Bt = (const bf16_t*)wm; g.N = 768; ea.kind = 0; ea.o0 = VB; ea.ldc = 768; }
#endif
          else if (kind == 1) { g.Bt = (const bf16_t*)(ws + WS_WNA); g.N = 3072; ea.kind = 0; ea.o0 = QB; ea.ldc = 3072; }
          else { g.Bt = (const bf16_t*)(ws + WS_WSWA); g.N = 1280; ea.kind = 4; ea.o0 = QB; }
        } else if (step == 4) { g.K = 256;
          if (gi == 0) { g.A = SB; g.Bt = (const bf16_t*)(wm + MLA_OFF_UQ); g.N = 1536; ea.kind = 2; ea.o0 = QB; }
          else { g.A = SB + (size_t)TOK * 256; g.Bt = (const bf16_t*)(wm + MLA_OFF_UKV); g.N = 2048; ea.kind = 3; ea.o0 = KB; ea.o1 = VB; }
        } else if (step == 6) { g.A = XN; g.K = DM; g.N = DM; ea.kind = 0; ea.o0 = VB; ea.ldc = DM;
          g.Bt = (kind == 0) ? (const bf16_t*)(wm + MLA_OFF_WO) : (kind == 1) ? (const bf16_t*)(ws + WS_WNA + (size_t)3072 * 1024 * 2) : (const bf16_t*)(ws + WS_WSWA + (size_t)1280 * 1024 * 2);
        } else if (step == 8) { g.A = XN; g.K = DM; g.N = 2 * DFF; g.Bt = (const bf16_t*)(ws + WS_WFI) + (size_t)l * 2 * DFF * DM; ea.kind = 1; ea.o0 = QB; }
        else { g.A = QB; g.K = DFF; g.N = DM; g.Bt = (const bf16_t*)(ws + WS_WFO) + (size_t)l * DM * DFF; ea.kind = 0; ea.o0 = VB; ea.ldc = DM; }
        if (splitctx && gi == 1) {
          g.A += (size_t)NLAT * g.K; g.M = NCTX; g.nts = (step == 6) ? 2 : 4; nsplit = g.K / (g.nts * 64); ea.kind = 5; ea.o0 = (bf16_t*)(ws + WS_PART); }
        pg8::StaticOrder S; S.init(g.M, g.N, G, bx, nsplit); pg8::EpiGen E{ea};
#ifndef DBG_NO_GEMM
        int lane_g; asm volatile("v_mbcnt_lo_u32_b32 %0, -1, 0\n\tv_mbcnt_hi_u32_b32 %0, -1, %0" : "=v"(lane_g));
        pg8::gemm_phase<pg8::EpiGen, pg8::StaticOrder, true, true>((LAS unsigned char*)lds, g, S, E, wave * 64 + lane_g);
#endif
        __syncthreads();
      }
    } else if (step == 3) {
      FRESH_LANE(lane);
      const bf16_t* A1 = VB; const float* gq = P.in[13] + jl * 256; const float* gkv = P.in[15] + jl * 256;
      constexpr int NR = 4;
      for (int base = gw; base < TOK; base += NR * NGW) {
        u32x2 w[NR][2]; unsigned wk[NR]; float ss[2 * NR];
#pragma unroll
        for (int i = 0; i < NR; ++i) { const int row = base + i * NGW; const bf16_t* a = A1 + (size_t)(row < TOK ? row : 0) * 768;
          w[i][0] = __builtin_nontemporal_load((const u32x2*)(a + 4 * lane)); w[i][1] = __builtin_nontemporal_load((const u32x2*)(a + 256 + 4 * lane)); wk[i] = __builtin_nontemporal_load((const unsigned*)(a + 512 + 2 * (lane & 31))); }
#pragma unroll
        for (int i = 0; i < NR; ++i)
#pragma unroll
          for (int part = 0; part < 2; ++part) { const float x0 = __builtin_bit_cast(float, w[i][part].x << 16), x1 = __builtin_bit_cast(float, w[i][part].x & 0xffff0000u), x2 = __builtin_bit_cast(float, w[i][part].y << 16), x3 = __builtin_bit_cast(float, w[i][part].y & 0xffff0000u);
            ss[2 * i + part] = (x0 * x0 + x1 * x1) + (x2 * x2 + x3 * x3); }
        wave_sum_n<2 * NR>(ss, lane);
#pragma unroll
        for (int i = 0; i < NR; ++i) { const int row = base + i * NGW; if (row >= TOK) continue;
#pragma unroll
          for (int part = 0; part < 2; ++part) { const float x0 = __builtin_bit_cast(float, w[i][part].x << 16), x1 = __builtin_bit_cast(float, w[i][part].x & 0xffff0000u), x2 = __builtin_bit_cast(float, w[i][part].y << 16), x3 = __builtin_bit_cast(float, w[i][part].y & 0xffff0000u);
            const float rstd = 1.0f / sqrtf(ss[2 * i + part] * (1.0f / 256.0f) + NORM_EPS);
            const f32x4 g = *(const f32x4*)((part ? gkv : gq) + 4 * lane); u32x2 o; o.x = pk2(x0 * rstd * g[0], x1 * rstd * g[1]); o.y = pk2(x2 * rstd * g[2], x3 * rstd * g[3]);
            *(u32x2*)(SB + (size_t)part * TOK * 256 + (size_t)row * 256 + 4 * lane) = o; }
          if (lane < 32) { float x1 = __builtin_bit_cast(float, wk[i] << 16), x2 = __builtin_bit_cast(float, wk[i] & 0xffff0000u);
            int b, key;
            if (row < NLAT) { const int t = row & (SEQ - 1); const float c = rope[(t * 32 + lane) * 2], s = rope[(t * 32 + lane) * 2 + 1]; const float y1 = x1 * c - x2 * s, y2 = x2 * c + x1 * s; x1 = y1; x2 = y2; b = row >> 13; key = LC + t; }
            else { const int r2 = row - NLAT; b = r2 >> 8; key = r2 & 255; }
            const unsigned o = pk2(x1, x2);
#pragma unroll
            for (int h = 0; h < 8; ++h) *(unsigned*)(KB + ((size_t)(b * 8 + h) * MLA_KEYS + key) * 192 + 128 + 2 * lane) = o; } }
      }
    } else if (step == 5) {
      float* bias_l = (float*)(lds + 135168);
      if (kind == 0) {
        const int nun = last ? 1024 : 1056;
        for (int id = vcu; id < nun; id += G) { int lane_u; asm volatile("v_mbcnt_lo_u32_b32 %0, -1, 0\n\tv_mbcnt_hi_u32_b32 %0, -1, %0" : "=v"(lane_u)); const int tid_u = wave * 64 + lane_u;     att::UnitP u; u.m0 = -1e30f; u.l0 = 0.f; u.a0 = 0; u.a1 = 0;
          int bh, row0; if (id < 1024) { bh = id >> 5; row0 = (bh >> 3) * SEQ + (id & 31) * 256; u.NT = 4 + SEQ / 64; } else { bh = id - 1024; row0 = NLAT + (bh >> 3) * LC; u.NT = 4; }
          const int h = bh & 7; const bf16_t* Kbh = KB + (size_t)bh * MLA_KEYS * 128; const bf16_t* Vbh = VB + (size_t)bh * MLA_KEYS * 128;
          u.Pc = (const bf16_t*)(ws + WS_KPE) + (size_t)(bh >> 3) * MLA_KEYS * 64; u.Pn = u.Pc + (size_t)LC * 64;
          u.Q = QB + (size_t)row0 * 1536 + h * 192; u.Kc = Kbh; u.Vc = Vbh; u.Kn = Kbh + (size_t)LC * 128; u.Vn = Vbh + (size_t)LC * 128; u.O = XN + (size_t)row0 * DM + h * 128;
#ifndef DBG_NO_ATT0
          att::attn_unit<192, 128, 1536, 128, 128, 0, MLA_SDEPTH, MLA_SERIAL, MLA_EARLY>(u, (char*)lds, bias_l, tid_u);
#endif
        }
      } else if (kind == 1) {
        const float* rpb = P.in[19] + (size_t)jl * 16 * 465;
        const int nun = last ? 2048 : 2112;
        for (int id = vcu; id < nun; id += G) { int lane_u; asm volatile("v_mbcnt_lo_u32_b32 %0, -1, 0\n\tv_mbcnt_hi_u32_b32 %0, -1, %0" : "=v"(lane_u)); const int tid_u = wave * 64 + lane_u;     att::UnitP u; u.m0 = -1e30f; u.l0 = 0.f;
          int bh, row0, qb = 0; if (id < 2048) { bh = id >> 5; qb = id & 31; row0 = (bh >> 4) * SEQ + qb * 256; u.NT = 16; } else { bh = id - 2048; row0 = NLAT + (bh >> 4) * LC; u.NT = 4; }
          const int b = bh >> 4, h = bh & 15; const int R0 = qb * 4, KR0 = min(max(R0 - 4, 0), 116); u.a0 = R0; u.a1 = KR0;
          u.Q = QB + (size_t)row0 * 3072 + h * 64; u.Kc = QB + (size_t)(NLAT + b * LC) * 3072 + 1024 + h * 64; u.Vc = u.Kc + 1024;
          u.Kn = QB + (size_t)(b * SEQ + KR0 * 64) * 3072 + 1024 + h * 64; u.Vn = u.Kn + 1024; u.O = XN + (size_t)row0 * DM + h * 64;
          if (tid_u < 465) bias_l[tid_u] = rpb[h * 465 + tid_u] * 8.0f;
          __syncthreads();
#ifndef DBG_NO_ATT1
          att::attn_unit<64, 64, 3072, 3072, 3072, 1, NS_SDEPTH, false, false>(u, (char*)lds, bias_l, tid_u);
#endif
        }
      } else {
        const float* sink = P.in[22] + (size_t)jl * 16;
        const int nun = last ? 2048 : 2112;
        for (int id = vcu; id < nun; id += G) { int lane_u; asm volatile("v_mbcnt_lo_u32_b32 %0, -1, 0\n\tv_mbcnt_hi_u32_b32 %0, -1, %0" : "=v"(lane_u)); const int tid_u = wave * 64 + lane_u;     att::UnitP u; u.a1 = 0;
          int bh, row0, qb = 0; if (id < 2048) { bh = id >> 5; qb = id & 31; row0 = (bh >> 4) * SEQ + qb * 256; u.NT = 12; } else { bh = id - 2048; row0 = NLAT + (bh >> 4) * LC; u.NT = 4; }
          const int b = bh >> 4, h = bh & 15, kvh = h >> 3; u.a0 = qb * 256; u.m0 = sink[h] * 8.0f; u.l0 = 1.0f;
          u.Q = QB + (size_t)row0 * 1280 + h * 64; u.Kc = QB + (size_t)(NLAT + b * LC) * 1280 + 1024 + kvh * 64; u.Vc = u.Kc + 128;
          u.Kn = QB + (size_t)(b * SEQ) * 1280 + 1024 + kvh * 64; u.Vn = u.Kn + 128; u.O = XN + (size_t)row0 * DM + h * 64;
#ifndef DBG_NO_ATT2
          att::attn_unit<64, 64, 1280, 1280, 1280, 2, NS_SDEPTH, false, false>(u, (char*)lds, bias_l, tid_u);
#endif
        }
      }
    } else if (step == 7) {
      FRESH_LANE(lane);
      const float gsc = rep ? 0.0f : 1.0f; const bool first = (l == 0 && !rep);
      row_pass_multi<4>(P, gw, NGW, (SPLIT_CTX || last) ? NLAT : TOK, lane, first ? P.in[0] : P.out, first ? P.in[2] : (const float*)(ws + WS_XCTX), true, VB, P.in[7] + l * DM, l, 2, true, P.in[8] + l * DM, l, 3, 4, gsc);
      if (SPLIT_CTX && !last) row_pass_ctx(P, gw, NGW, lane, first ? P.in[2] : (const float*)(ws + WS_XCTX), (const float*)(ws + WS_PART), 8, P.in[7] + l * DM, l, 2, P.in[8] + l * DM, l, 3, 4, gsc);
    } else if (step == 10) {
      FRESH_LANE(lane);
      const int ln = last ? l : l + 1; const float gsc = rep ? 0.0f : 1.0f;
      row_pass_multi<4>(P, gw, NGW, (SPLIT_CTX || last) ? NLAT : TOK, lane, P.out, (const float*)(ws + WS_XCTX), true, VB, P.in[9] + l * DM, l, 5, !last, P.in[6] + ln * DM, ln, 0, 1, gsc);
      if (SPLIT_CTX && !last) row_pass_ctx(P, gw, NGW, lane, (const float*)(ws + WS_XCTX), (const float*)(ws + WS_PART), 11, P.in[9] + l * DM, l, 5, P.in[6] + ln * DM, ln, 0, 1, gsc);
    }
#ifdef PROBE_MASK
    if (((PROBE_MASK >> step) & 1) && (PROBE_REPEAT_KIND < 0 || kind == PROBE_REPEAT_KIND) && rep == 0) { rep = 1; int lane_b; asm volatile("v_mbcnt_lo_u32_b32 %0, -1, 0\n\tv_mbcnt_hi_u32_b32 %0, -1, %0" : "=v"(lane_b)); xcd_barrier(xbar, wave * 64 + lane_b); --ph; continue; }
    rep = 0;
#endif
    if (ph + 1 < ph_hi) { int lane_b; asm volatile("v_mbcnt_lo_u32_b32 %0, -1, 0\n\tv_mbcnt_hi_u32_b32 %0, -1, %0" : "=v"(lane_b)); xcd_barrier(xbar, wave * 64 + lane_b); }
  }
}

#ifndef N_LAUNCH_SPLIT
#define N_LAUNCH_SPLIT 0
#endif
extern "C" void kernel_launch(void* const* d_in, const int* in_sizes, int n_in, void* d_out, int out_size, void* d_ws, size_t ws_size, hipStream_t stream) {
  static int grid = 0;
  if (grid == 0) {
    if (n_in != 24 || out_size != NLAT * DM || ws_size < ((FUSED_NORM || SPLIT_CTX) ? WS_END : WS_NEED)) { fprintf(stderr, "kernel_launch: unexpected shapes n_in %d out %d ws %zu (need %zu)\n", n_in, out_size, ws_size, (size_t)((FUSED_NORM || SPLIT_CTX) ? WS_END : WS_NEED)); grid = -1; return; }
    int dev = 0, cus = 0, per_cu = 0;
    hipGetDevice(&dev); hipDeviceGetAttribute(&cus, hipDeviceAttributeMultiprocessorCount, dev);
    if (hipFuncSetAttribute((const void*)fwd_mega, hipFuncAttributeMaxDynamicSharedMemorySize, LDS_BYTES) != hipSuccess) { fprintf(stderr, "kernel_launch: hipFuncSetAttribute failed\n"); grid = -1; return; }
    if (hipOccupancyMaxActiveBlocksPerMultiprocessor(&per_cu, (const void*)fwd_mega, NTHREADS, LDS_BYTES) != hipSuccess || per_cu < 1) { fprintf(stderr, "kernel_launch: occupancy query says %d\n", per_cu); per_cu = 1; }
    (void)hipGetLastError();
    grid = cus * 1;
    fprintf(stderr, "kernel_launch: grid %d (cus %d, per_cu %d)\n", grid, cus, per_cu);
  }
  if (grid < 0) return;
  Params p{};
  for (int i = 0; i < 24; ++i) p.in[i] = (const float*)d_in[i];
  p.out = (float*)d_out; p.ws = (unsigned char*)d_ws;
  int n = 0; p.prog[n++] = 0; p.prog[n++] = 1;
  for (int l = 0; l < DEPTH; ++l) { const int kind = l % 3;
#if FUSED_NORM
    const int NS_MLA = 7, NS_O = 5; const int steps_mla[9] = {2, 3, 4, 5, 6, 8, 9, 0, 0}, steps_o[7] = {2, 5, 6, 8, 9, 0, 0};
#else
#if FUSE_LAT
    const int NS_MLA = 8, NS_O = 7; const int steps_mla[9] = {2, 4, 5, 6, 7, 8, 9, 10, 0}, steps_o[7] = {2, 5, 6, 7, 8, 9, 10};
#else
    const int NS_MLA = 9, NS_O = 7; const int steps_mla[9] = {2, 3, 4, 5, 6, 7, 8, 9, 10}, steps_o[7] = {2, 5, 6, 7, 8, 9, 10};
#endif
#endif

    if (kind == 0) for (int s = 0; s < NS_MLA; ++s) p.prog[n++] = (unsigned char)((l << 4) | steps_mla[s]); else for (int s = 0; s < NS_O; ++s) p.prog[n++] = (unsigned char)((l << 4) | steps_o[s]); }
  p.nph = n;
  unsigned char* ws = (unsigned char*)d_ws; int q = 0, first = 0;
  auto add = [&](const float* src, size_t dst_off, int K, int N, int Np, int kind) { WDesc& d = p.wd[q++]; d.src = src; d.dst = (bf16_t*)(ws + dst_off); d.K = K; d.N = N; d.Np = Np; d.kind = kind; d.first = first; d.pad = 0; first += (K / 64) * (Np / 32); };
  for (int l = 0; l < DEPTH; ++l) add(p.in[10] + (size_t)l * DM * 2 * DFF, WS_WFI + (size_t)l * 2 * DFF * DM * 2, DM, 2 * DFF, 2 * DFF, 1);
  for (int l = 0; l < DEPTH; ++l) add(p.in[11] + (size_t)l * DFF * DM, WS_WFO + (size_t)l * DM * DFF * 2, DFF, DM, DM, 0);
  for (int j = 0; j < 2; ++j) { const size_t b = WS_WMLA + j * MLA_W_STRIDE;
    add(p.in[12] + (size_t)j * DM * 576, b, DM, 576, 768, 2); add(p.in[14] + (size_t)j * 256 * 1536, b + MLA_OFF_UQ, 256, 1536, 1536, 3);
    add(p.in[16] + (size_t)j * 256 * 2048, b + MLA_OFF_UKV, 256, 2048, 2048, 0); add(p.in[17] + (size_t)j * DM * DM, b + MLA_OFF_WO, DM, DM, DM, 0); }
  add(p.in[18], WS_WNA, DM, 3072, 3072, 0); add(p.in[20], WS_WNA + (size_t)3072 * 1024 * 2, DM, DM, DM, 0);
  add(p.in[21], WS_WSWA, DM, 1280, 1280, 4); add(p.in[23], WS_WSWA + (size_t)1280 * 1024 * 2, DM, DM, DM, 0);
  p.nitems = first;
#if N_LAUNCH_SPLIT
  for (int ph = 0; ph < n; ++ph) { p.lo = ph; p.hi = ph + 1; hipLaunchKernelGGL(fwd_mega, dim3(grid), dim3(NTHREADS), LDS_BYTES, stream, p); }
#else
  p.lo = 0; p.hi = n;
  if (hipMemsetAsync((char*)d_ws + WS_BAR, 0, BAR_BYTES, stream) != hipSuccess) { fprintf(stderr, "kernel_launch: memset failed\n"); return; }
  void* args[] = {&p};
  hipError_t e = hipLaunchCooperativeKernel((const void*)fwd_mega, dim3(grid), dim3(NTHREADS), args, LDS_BYTES, stream);
  if (e != hipSuccess) fprintf(stderr, "kernel_launch: cooperative launch failed: %s (grid %d)\n", hipGetErrorString(e), grid);
#endif
}
```

```cpp
#include <hip/hip_runtime.h>
#include <hip/hip_cooperative_groups.h>
#include <cstdio>
#include <cstdint>
namespace cg = cooperative_groups;

constexpr int DM = 1024, NBATCH = 4, SEQ = 8192, NLAT = NBATCH * SEQ, LC = 256, NCTX = NBATCH * LC, TOK = NLAT + NCTX, DFF = 2816, DEPTH = 4;
constexpr int MLA_KEYS = SEQ + LC;
#ifndef MLA_SDEPTH
#define MLA_SDEPTH 1
#endif
#ifndef FUSED_NORM
#define FUSED_NORM 0
#endif
#ifndef MLA_EARLY
#define MLA_EARLY false
#endif
#ifndef SPLIT_CTX
#define SPLIT_CTX 0
#endif
#ifndef NS_SDEPTH
#define NS_SDEPTH 1
#endif
#ifndef FUSE_LAT
#define FUSE_LAT 1
#endif
#ifndef MLA_SERIAL
#define MLA_SERIAL false
#endif
namespace pg8 {
#define PG8_LAS __attribute__((address_space(3)))
typedef unsigned short bf16_t;
typedef short bf16x8 __attribute__((ext_vector_type(8)));
typedef float f32x4 __attribute__((ext_vector_type(4)));
typedef unsigned u32x4 __attribute__((ext_vector_type(4)));
constexpr int BM = 256, BK = 64, HALF = 128, HTB = HALF * BK * 2  , STAGE_BYTES = 8 * HTB, NXCD = 8, WGM = 8;

__host__ __device__ __forceinline__ int lds_byte(int r, int c) { const int st = (r >> 4) * 2 + (c >> 5), rr = r & 15, cc = c & 31, ob = rr * 64 + cc * 2; return st * 1024 + (ob ^ (((ob >> 9) & 1) << 5)); }
__host__ __device__ __forceinline__ void stage_rc(int b, int& R, int& C) { const int st = b / 1024, sb = b % 1024, swz = sb ^ (((sb >> 9) & 1) << 5); R = (st >> 1) * 16 + swz / 64; C = (st & 1) * 32 + (swz % 64) / 2; }
__host__ __device__ __forceinline__ int perm32(int rho) { const int n = rho >> 4, i = rho & 15; return 8 * (i >> 2) + 4 * n + (i & 3); }

struct Unit { int pm, pn, ks; };
struct Gemm { const bf16_t* A; const bf16_t* Bt; int M, N, K, nts; };

struct StaticOrder {
    int nM, nN, nwg, G, c, S;
    __host__ __device__ void init(int M, int N, int G_, int c_, int S_ = 1) { nM = M / BM; nN = N / BM; nwg = nM * nN; G = G_; c = c_; S = S_; }
    __host__ __device__ bool next(int i, Unit& u) const {
        if (S > 1) { const int L = i * G + c; if (L >= nwg * S) return false; u.ks = L % S; const int t = L / S; u.pm = t / nN; u.pn = t % nN; return true; }
        u.ks = 0;
        const long L = (long)i * G + c; if (L >= nwg) return false;
        int wgid = (int)L; { const int q = nwg / NXCD, r = nwg % NXCD, xcd = wgid % NXCD, off = wgid / NXCD; wgid = (xcd < r ? xcd * (q + 1) : r * (q + 1) + (xcd - r) * q) + off; }
        const int nig = WGM * nN, gid = wgid / nig, fm = gid * WGM, gsz = (nM - fm) < WGM ? (nM - fm) : WGM;
        u.pm = fm + ((wgid % nig) % gsz); u.pn = (wgid % nig) / gsz; return true;
    }
    __device__ __forceinline__ void a_ready(const Unit&) const {}
    __device__ __forceinline__ void done(const Unit&) const {}
};

__device__ __forceinline__ unsigned cvt_pk_bf16(float lo, float hi) { unsigned r; asm volatile("v_cvt_pk_bf16_f32 %0, %1, %2" : "=v"(r) : "v"(lo), "v"(hi)); return r; }
typedef float f32x2 __attribute__((ext_vector_type(2)));
struct EpiArgs { int kind; int ldc; bf16_t* o0; bf16_t* o1; const float* rope; const float* g0; const float* g1; PG8_LAS unsigned char* xl; };
__device__ __forceinline__ u32x4 pack8(const f32x4& v0, const f32x4& v1) { u32x4 w; w.x = cvt_pk_bf16(v0[0], v0[1]); w.y = cvt_pk_bf16(v0[2], v0[3]); w.z = cvt_pk_bf16(v1[0], v1[1]); w.w = cvt_pk_bf16(v1[2], v1[3]); return w; }
__device__ __forceinline__ void rope8(f32x4& v0, f32x4& v1, const float* rp) {
    const f32x4 a = *(const f32x4*)rp, b = *(const f32x4*)(rp + 4);
    const f32x4 x0 = v0, x1 = v1;
    v0[0] = x0[0] * a[0] - x0[1] * a[1]; v0[1] = x0[1] * a[0] + x0[0] * a[1];
    v0[2] = x0[2] * a[2] - x0[3] * a[3]; v0[3] = x0[3] * a[2] + x0[2] * a[3];
    v1[0] = x1[0] * b[0] - x1[1] * b[1]; v1[1] = x1[1] * b[0] + x1[0] * b[1];
    v1[2] = x1[2] * b[2] - x1[3] * b[3]; v1[3] = x1[3] * b[2] + x1[2] * b[3];
}
template <int KIND> __device__ __forceinline__ void emit8(const EpiArgs& a, int row, int col, f32x4 v0, f32x4 v1, int ks) {
    if constexpr (KIND == 5) { float* o = (float*)a.o0 + ((size_t)ks * NCTX + row) * DM + col; *(f32x4*)o = v0; *(f32x4*)(o + 4) = v1; }
    else if constexpr (KIND == 0) { *(u32x4*)(a.o0 + (unsigned)(row * a.ldc + col)) = pack8(v0, v1); }
    else if constexpr (KIND == 1) {
        float r[4];
#pragma unroll
        for (int i = 0; i < 4; ++i) { const float g = v0[i]; r[i] = g * v1[i] * __builtin_amdgcn_rcpf(1.0f + __builtin_amdgcn_exp2f(-g * 1.4426950408889634f)); }
        typedef unsigned u32x2 __attribute__((ext_vector_type(2))); u32x2 w; w.x = cvt_pk_bf16(r[0], r[1]); w.y = cvt_pk_bf16(r[2], r[3]);
        *(u32x2*)(a.o0 + (size_t)row * DFF + (col >> 1)) = w; }
    else if constexpr (KIND == 2) {
        const int within = col % 192;
        if (within >= 128 && row < NLAT) rope8(v0, v1, a.rope + ((size_t)(row & (SEQ - 1)) * 32 + ((within - 128) >> 1)) * 2);
        *(u32x4*)(a.o0 + (unsigned)(row * 1536 + col)) = pack8(v0, v1); }
    else if constexpr (KIND == 3) {
        const int h = col >> 8, w = col & 255; int b, key;
        if (row < NLAT) { b = row >> 13; key = LC + (row & (SEQ - 1)); } else { const int r2 = row - NLAT; b = r2 >> 8; key = r2 & 255; }
        const size_t base = (size_t)(b * 8 + h) * MLA_KEYS + key;
        if (w < 128) *(u32x4*)(a.o0 + base * 128 + w) = pack8(v0, v1); else *(u32x4*)(a.o1 + base * 128 + (w - 128)) = pack8(v0, v1); }
    else {
        if (col < 1152 && row < NLAT) rope8(v0, v1, a.rope + ((size_t)(row & (SEQ - 1)) * 32 + ((col & 63) >> 1)) * 2);
        *(u32x4*)(a.o0 + (unsigned)(row * 1280 + col)) = pack8(v0, v1); }
}
struct EpiGen {
    static constexpr bool PERM = true, AFTER_DRAIN = false;
    EpiArgs a;
    template <int KIND> __device__ __forceinline__ void run(const f32x4 (&acc)[2][2][4][2], const Unit& u, int wr, int wc, int fr, int fq) const {
        const int row0 = u.pm * BM + wr * 64 + fr, col0 = u.pn * BM + wc * 32 + 8 * fq;
#pragma unroll
        for (int ai = 0; ai < 2; ++ai)
#pragma unroll
            for (int m = 0; m < 4; ++m)
#pragma unroll
                for (int bj = 0; bj < 2; ++bj) { emit8<KIND>(a, row0 + ai * HALF + m * 16, col0 + bj * HALF, acc[ai][bj][m][0], acc[ai][bj][m][1], u.ks); asm volatile("" ::: "memory"); }
    }
    __device__ __forceinline__ void run_lat(const f32x4 (&acc)[2][2][4][2], const Unit& u, int wr, int wc) const {
        int lane; asm volatile("v_mbcnt_lo_u32_b32 %0, -1, 0\n\tv_mbcnt_hi_u32_b32 %0, -1, %0" : "=v"(lane));
        const int fr = lane & 15, fq = lane >> 4;
        const int row0 = u.pm * BM + wr * 64 + fr, tc0 = wc * 32 + 8 * fq;
        if (u.pn < 2) {
            PG8_LAS float* P = (PG8_LAS float*)a.xl;
#pragma unroll
            for (int ai = 0; ai < 2; ++ai)
#pragma unroll
                for (int m = 0; m < 4; ++m) { float s = 0.f;
#pragma unroll
                    for (int bj = 0; bj < 2; ++bj)
#pragma unroll
                        for (int n = 0; n < 2; ++n) { const f32x4 x = acc[ai][bj][m][n]; s += (x[0] * x[0] + x[1] * x[1]) + (x[2] * x[2] + x[3] * x[3]); }
                    s += __builtin_bit_cast(float, __builtin_amdgcn_ds_bpermute((lane ^ 16) << 2, __builtin_bit_cast(int, s)));
                    s += __builtin_bit_cast(float, __builtin_amdgcn_ds_bpermute((lane ^ 32) << 2, __builtin_bit_cast(int, s)));
                    if (fq == 0) P[(ai * HALF + wr * 64 + m * 16 + fr) * 4 + wc] = s; }
            asm volatile("s_waitcnt lgkmcnt(0)" ::: "memory"); __builtin_amdgcn_s_barrier(); asm volatile("" ::: "memory");
            const float* g = u.pn ? a.g1 : a.g0; bf16_t* out = a.o0 + (size_t)u.pn * TOK * 256;
            f32x4 gv[2][2];
#pragma unroll
            for (int bj = 0; bj < 2; ++bj) { gv[bj][0] = *(const f32x4*)(g + tc0 + bj * HALF); gv[bj][1] = *(const f32x4*)(g + tc0 + bj * HALF + 4); }
#pragma unroll
            for (int ai = 0; ai < 2; ++ai)
#pragma unroll
                for (int m = 0; m < 4; ++m) { const int rl = ai * HALF + wr * 64 + m * 16 + fr; const f32x4 pp = *(const PG8_LAS f32x4*)(P + rl * 4);
                    const float rstd = 1.0f / sqrtf(((pp[0] + pp[1]) + (pp[2] + pp[3])) * (1.0f / 256.0f) + 1e-6f);
#pragma unroll
                    for (int bj = 0; bj < 2; ++bj) { const int c = tc0 + bj * HALF; const f32x4 g0 = gv[bj][0], g1 = gv[bj][1];
                        *(u32x4*)(out + (size_t)(row0 + ai * HALF + m * 16) * 256 + c) = pack8(acc[ai][bj][m][0] * rstd * g0, acc[ai][bj][m][1] * rstd * g1); }
                    asm volatile("" ::: "memory"); }
            asm volatile("s_waitcnt lgkmcnt(0)" ::: "memory"); __builtin_amdgcn_s_barrier(); asm volatile("" ::: "memory");
        } else if (tc0 < 64) {
#pragma unroll
            for (int ai = 0; ai < 2; ++ai)
#pragma unroll
                for (int m = 0; m < 4; ++m) { const int row = row0 + ai * HALF + m * 16; f32x4 v0 = acc[ai][0][m][0], v1 = acc[ai][0][m][1]; int b, key;
                    if (row < NLAT) { rope8(v0, v1, a.rope + ((size_t)(row & (SEQ - 1)) * 32 + (tc0 >> 1)) * 2); b = row >> 13; key = LC + (row & (SEQ - 1)); }
                    else { const int r2 = row - NLAT; b = r2 >> 8; key = r2 & 255; }
                    *(u32x4*)(a.o1 + ((size_t)b * MLA_KEYS + key) * 64 + tc0) = pack8(v0, v1);
                    asm volatile("" ::: "memory"); }
        }
    }
    __device__ __forceinline__ void run_swiglu(const f32x4 (&acc)[2][2][4][2], const Unit& u, int wr, int wc, int fr, int fq) const {
        const int row0 = u.pm * BM + wr * 64 + fr;
        const bool odd = (fq & 1) != 0;
        const int ocol = u.pn * (BM / 2) + wc * 16 + (odd ? 64 + 4 * (fq - 1) : 4 * fq);
#pragma unroll
        for (int ai = 0; ai < 2; ++ai)
#pragma unroll
            for (int m = 0; m < 4; ++m) { unsigned w[2][2];
#pragma unroll
                for (int bj = 0; bj < 2; ++bj) { const f32x4 g4 = acc[ai][bj][m][0], u4 = acc[ai][bj][m][1]; float r[4];
#pragma unroll
                    for (int i = 0; i < 4; ++i) { const float g = g4[i]; r[i] = g * u4[i] * __builtin_amdgcn_rcpf(1.0f + __builtin_amdgcn_exp2f(-g * 1.4426950408889634f)); }
                    w[bj][0] = cvt_pk_bf16(r[0], r[1]); w[bj][1] = cvt_pk_bf16(r[2], r[3]); }
                const auto s0 = __builtin_amdgcn_permlane16_swap(w[0][0], w[1][0], false, false); const auto s1 = __builtin_amdgcn_permlane16_swap(w[0][1], w[1][1], false, false);
                u32x4 o; o.x = s0[0]; o.y = s1[0]; o.z = s0[1]; o.w = s1[1];
                *(u32x4*)(a.o0 + (unsigned)((row0 + ai * HALF + m * 16) * DFF + ocol)) = o;
                asm volatile("" ::: "memory"); }
    }
    __device__ __forceinline__ void operator()(const f32x4 (&acc)[2][2][4][2], const Unit& u, int wr, int wc, int fr, int fq) const {
        if (a.kind == 6) { run_lat(acc, u, wr, wc); return; }
        if (a.kind == 1) { run_swiglu(acc, u, wr, wc, fr, fq); return; }
        switch (a.kind) { case 0: run<0>(acc, u, wr, wc, fr, fq); break; case 1: run<1>(acc, u, wr, wc, fr, fq); break; case 2: run<2>(acc, u, wr, wc, fr, fq); break;
                          case 3: run<3>(acc, u, wr, wc, fr, fq); break; case 5: run<5>(acc, u, wr, wc, fr, fq); break; default: run<4>(acc, u, wr, wc, fr, fq); break; }
    }
};
struct PanelOrder {
    int nwg, G, c;
    __device__ __forceinline__ void init(int M, int G_, int c_) { nwg = (M / BM) * 4; G = G_; c = c_; }
    __device__ __forceinline__ bool next(int i, Unit& u) const { const int L = i * G + c; if (L >= nwg) return false; u.pm = L >> 2; u.pn = L & 3; u.ks = 0; return true; }
    __device__ __forceinline__ void a_ready(const Unit&) const {}
    __device__ __forceinline__ void done(const Unit&) const {}
};
struct NormArgs {
    float* xlat; float* xctx; bf16_t* xn;
    const float* g_post; const float* g_pre; const float* modl; const float* modn;
    int wgate, wshift, wscale, do_norm;
    float* slot1; float* slot2; unsigned* cnt1; unsigned* cnt2;
};
struct EpiNorm {
    static constexpr bool PERM = true, AFTER_DRAIN = false;
    NormArgs a; PG8_LAS unsigned char* xl;
    __device__ __forceinline__ static float xor_add(float v, int lane, int o) { return v + __builtin_bit_cast(float, __builtin_amdgcn_ds_bpermute((lane ^ o) << 2, __builtin_bit_cast(int, v))); }
    __device__ __forceinline__ bool stats(const float (&part)[2][4], float* slot, unsigned* cnt, const Unit& u, int wr, int wc, int fr, int fq, int wid, int lane) const {
        PG8_LAS float* P = (PG8_LAS float*)xl; PG8_LAS float* S = (PG8_LAS float*)(xl + 4096); PG8_LAS unsigned* flag = (PG8_LAS unsigned*)(xl + 4096 + 1024);
#pragma unroll
        for (int ai = 0; ai < 2; ++ai)
#pragma unroll
            for (int m = 0; m < 4; ++m) if (fq == 0) P[(ai * HALF + wr * 64 + m * 16 + fr) * 4 + wc] = part[ai][m];
        asm volatile("s_waitcnt lgkmcnt(0)" ::: "memory"); __builtin_amdgcn_s_barrier(); asm volatile("" ::: "memory");
        const int row = wid * 32 + (lane & 31);
        if (lane < 32) { const float t = (P[row * 4 + 0] + P[row * 4 + 1]) + (P[row * 4 + 2] + P[row * 4 + 3]);
            __hip_atomic_store((unsigned*)slot + ((size_t)(u.pm * BM + row) * 4 + u.pn), __float_as_uint(t), __ATOMIC_RELAXED, __HIP_MEMORY_SCOPE_AGENT); }
        asm volatile("s_waitcnt vmcnt(0)" ::: "memory");
        if (lane == 0) __hip_atomic_fetch_add(cnt + 64 * u.pm, 1u, __ATOMIC_RELAXED, __HIP_MEMORY_SCOPE_AGENT);
        if (wid == 0) {
            bool dead = false; const unsigned long long t0 = __builtin_amdgcn_s_memrealtime();
            for (;;) {
                if ((unsigned)__builtin_amdgcn_readfirstlane(__hip_atomic_load(cnt + 64 * u.pm, __ATOMIC_RELAXED, __HIP_MEMORY_SCOPE_AGENT)) >= 32u) break;
                if (__builtin_amdgcn_s_memrealtime() - t0 > 5000000ull) { dead = true; break; }
                __builtin_amdgcn_s_sleep(2);
            }
            __builtin_amdgcn_fence(__ATOMIC_ACQUIRE, "agent");
            if (lane == 0) flag[0] = dead ? 1u : 0u;
        }
        asm volatile("s_waitcnt vmcnt(0) lgkmcnt(0)" ::: "memory"); __builtin_amdgcn_s_barrier(); asm volatile("" ::: "memory");
        const bool bad = flag[0] != 0u;
        if (lane < 32) { const unsigned* sl = (const unsigned*)slot + (size_t)(u.pm * BM + row) * 4; float t = 0.f;
#pragma unroll
            for (int q = 0; q < 4; ++q) t += __uint_as_float(__hip_atomic_load(sl + q, __ATOMIC_RELAXED, __HIP_MEMORY_SCOPE_AGENT));
            S[row] = 1.0f / sqrtf(t * (1.0f / 1024.0f) + 1e-6f); }
        asm volatile("s_waitcnt lgkmcnt(0)" ::: "memory"); __builtin_amdgcn_s_barrier(); asm volatile("" ::: "memory");
        return bad;
    }
    __device__ __forceinline__ void rowsq(const f32x4 (&acc)[2][2][4][2], float (&part)[2][4], int lane) const {
#pragma unroll
        for (int ai = 0; ai < 2; ++ai)
#pragma unroll
            for (int m = 0; m < 4; ++m) { float s = 0.f;
#pragma unroll
                for (int bj = 0; bj < 2; ++bj)
#pragma unroll
                    for (int n = 0; n < 2; ++n) { const f32x4 x = acc[ai][bj][m][n]; s += (x[0] * x[0] + x[1] * x[1]) + (x[2] * x[2] + x[3] * x[3]); }
                s = xor_add(s, lane, 16); s = xor_add(s, lane, 32); part[ai][m] = s; }
    }
    __device__ __forceinline__ void operator()(f32x4 (&acc)[2][2][4][2], const Unit& u, int wr, int wc, int fr_, int fq_) const {
        int lane; asm volatile("v_mbcnt_lo_u32_b32 %0, -1, 0\n\tv_mbcnt_hi_u32_b32 %0, -1, %0" : "=v"(lane));
        const int fr = lane & 15, fq = lane >> 4, wid = wr * 4 + wc; (void)fr_; (void)fq_;
        const PG8_LAS float* S = (const PG8_LAS float*)(xl + 4096);
        const int rmod = u.pm < 128 ? (u.pm >> 5) : 4;
        float* xu = (u.pm < 128 ? a.xlat + (size_t)u.pm * BM * DM : a.xctx + (size_t)(u.pm - 128) * BM * DM);
        const int col0 = u.pn * BM + wc * 32 + 8 * fq;
        const unsigned xoff = (unsigned)((wr * 64 + fr) * DM + col0);
        float part[2][4];
        rowsq(acc, part, lane);
        bool bad = stats(part, a.slot1, a.cnt1, u, wr, wc, fr, fq, wid, lane);
        { float rs[2][4];
#pragma unroll
          for (int ai = 0; ai < 2; ++ai)
#pragma unroll
            for (int m = 0; m < 4; ++m) rs[ai][m] = S[ai * HALF + wr * 64 + m * 16 + fr];
          const float* gate = a.modl + (size_t)(rmod * 6 + a.wgate) * DM;
#pragma unroll
          for (int bj = 0; bj < 2; ++bj)
#pragma unroll
            for (int n = 0; n < 2; ++n) { const int c = col0 + bj * HALF + 4 * n; const f32x4 gg = *(const f32x4*)(gate + c) * *(const f32x4*)(a.g_post + c);
#pragma unroll
              for (int ai = 0; ai < 2; ++ai)
#pragma unroll
                for (int m = 0; m < 4; ++m) { const f32x4 x = *(const f32x4*)(xu + (xoff + (unsigned)((ai * HALF + m * 16) * DM + bj * HALF + 4 * n))); acc[ai][bj][m][n] = x + gg * (acc[ai][bj][m][n] * rs[ai][m]);
                  if (m == 3) asm volatile("" ::: "memory"); } } }
        const float qnan = __builtin_nanf("");
        unsigned xoff2 = xoff; asm volatile("" : "+v"(xoff2));
        if (a.do_norm) {
            rowsq(acc, part, lane);
            bad = stats(part, a.slot2, a.cnt2, u, wr, wc, fr, fq, wid, lane) || bad;
            float rs[2][4];
#pragma unroll
            for (int ai = 0; ai < 2; ++ai)
#pragma unroll
              for (int m = 0; m < 4; ++m) rs[ai][m] = S[ai * HALF + wr * 64 + m * 16 + fr];
            const float* shift = a.modn + (size_t)(rmod * 6 + a.wshift) * DM; const float* scale = a.modn + (size_t)(rmod * 6 + a.wscale) * DM;
            bf16_t* xnu = a.xn + (size_t)u.pm * BM * DM;
#pragma unroll
            for (int bj = 0; bj < 2; ++bj)
#pragma unroll
              for (int n = 0; n < 2; ++n) { const int c = col0 + bj * HALF + 4 * n; const f32x4 g = *(const f32x4*)(a.g_pre + c), sh = *(const f32x4*)(shift + c), sc = *(const f32x4*)(scale + c) + 1.0f;
#pragma unroll
                for (int ai = 0; ai < 2; ++ai)
#pragma unroll
                  for (int m = 0; m < 4; ++m) { f32x4 x = acc[ai][bj][m][n]; if (bad) x = (f32x4){qnan, qnan, qnan, qnan};
                    const unsigned o = xoff2 + (unsigned)((ai * HALF + m * 16) * DM + bj * HALF + 4 * n);
                    *(f32x4*)(xu + o) = x;
                    const f32x4 h = (x * rs[ai][m] * g) * sc + sh; typedef unsigned u32x2 __attribute__((ext_vector_type(2))); u32x2 w; w.x = cvt_pk_bf16(h[0], h[1]); w.y = cvt_pk_bf16(h[2], h[3]);
                    *(u32x2*)(xnu + o) = w; }
                asm volatile("" ::: "memory"); }
        } else {
#pragma unroll
            for (int bj = 0; bj < 2; ++bj)
#pragma unroll
              for (int n = 0; n < 2; ++n) { const int c = col0 + bj * HALF + 4 * n;
#pragma unroll
                for (int ai = 0; ai < 2; ++ai)
#pragma unroll
                  for (int m = 0; m < 4; ++m) { f32x4 x = acc[ai][bj][m][n]; if (bad) x = (f32x4){qnan, qnan, qnan, qnan}; *(f32x4*)(xu + (xoff2 + (unsigned)((ai * HALF + m * 16) * DM + bj * HALF + 4 * n))) = x; } (void)c; }
        }
    }
};
template <class Epi, class Sched, bool ALIGN_EPI = false, bool SP2 = false>
__device__ __forceinline__ void gemm_phase(PG8_LAS unsigned char* lds, const Gemm g, const Sched& S, const Epi& E, const int tid) {
    const int wid = __builtin_amdgcn_readfirstlane(tid >> 6), lane = tid & 63, wr = wid >> 2, wc = wid & 3, fr = lane & 15, fq = lane >> 4;
    const int K = g.K, nt = g.nts ? g.nts : K / BK; const size_t sstep = (size_t)g.nts * BK * 2;
    unsigned voffA[2], voffB[2];
#pragma unroll
    for (int i = 0; i < 2; ++i) { int R, C; stage_rc(tid * 16 + i * 8192, R, C); const int Rb = Epi::PERM ? ((R & ~31) + perm32(R & 31)) : R;
        voffA[i] = (unsigned)(R * K + C) * 2u; voffB[i] = (unsigned)(Rb * K + C) * 2u; }
    const size_t kstep = (size_t)(BK * 2);
    const size_t hstep = (size_t)HALF * K * 2;
    const size_t tstep = 2 * hstep;
    const unsigned ldsw = (unsigned)wid * 1024u;
    const int aoff = lds_byte(wr * 64 + fr, fq * 8), boff = lds_byte(wc * 32 + fr, fq * 8);
#define PG8_SA(b, h) (((b) * 2 + (h)) * HTB)
#define PG8_SB(b, h) ((4 + (b) * 2 + (h)) * HTB)
#define PG8_STAGE(bufoff, gbase, voff) do { _Pragma("unroll") for (int _i = 0; _i < 2; ++_i) \
        __builtin_amdgcn_global_load_lds((const unsigned*)((const char*)(gbase) + (voff)[_i]), (PG8_LAS unsigned*)(lds + (bufoff) + ldsw + _i * 8192), 16, 0, 0); } while (0)
#define PG8_LDA(dst, b, h) do { _Pragma("unroll") for (int m = 0; m < 4; ++m) _Pragma("unroll") for (int k = 0; k < 2; ++k) dst[m][k] = *(const PG8_LAS bf16x8*)(lds + PG8_SA(b, h) + aoff + m * 2048 + k * 1024); } while (0)
#define PG8_LDB(dst, b, h) do { _Pragma("unroll") for (int n = 0; n < 2; ++n) _Pragma("unroll") for (int k = 0; k < 2; ++k) dst[n][k] = *(const PG8_LAS bf16x8*)(lds + PG8_SB(b, h) + boff + n * 2048 + k * 1024); } while (0)
#define PG8_MMA(ai, bj, At, Bt) do { __builtin_amdgcn_s_setprio(1); _Pragma("unroll") for (int m = 0; m < 4; ++m) _Pragma("unroll") for (int n = 0; n < 2; ++n) _Pragma("unroll") for (int k = 0; k < 2; ++k) \
        acc[ai][bj][m][n] = __builtin_amdgcn_mfma_f32_16x16x32_bf16(Bt[n][k], At[m][k], acc[ai][bj][m][n], 0, 0, 0); __builtin_amdgcn_s_setprio(0); } while (0)
#define PG8_WAIT_V(n) asm volatile("s_waitcnt vmcnt(" #n ")" ::: "memory")
#define PG8_WAIT_L(n) asm volatile("s_waitcnt lgkmcnt(" #n ")" ::: "memory")
#define PG8_BAR __builtin_amdgcn_s_barrier()
#define PG8_SCHED __builtin_amdgcn_sched_barrier(0)
    Unit cur, nxt; int ui = 0;
    if (!S.next(0, cur)) return;
    f32x4 acc[2][2][4][2];
#pragma unroll
    for (int a = 0; a < 2; ++a)
#pragma unroll
        for (int b = 0; b < 2; ++b)
#pragma unroll
            for (int m = 0; m < 4; ++m)
#pragma unroll
                for (int n = 0; n < 2; ++n) acc[a][b][m][n] = (f32x4){0.f, 0.f, 0.f, 0.f};
    bf16x8 At[4][2], B0[2][2], B1[2][2];
    const char* cA = (const char*)g.A + (size_t)cur.pm * tstep + (size_t)cur.ks * sstep; const char* cB = (const char*)g.Bt + (size_t)cur.pn * tstep + (size_t)cur.ks * sstep;
    S.a_ready(cur);
    if constexpr (SP2) {
        PG8_STAGE(PG8_SB(0, 0), cB, voffB); PG8_STAGE(PG8_SB(0, 1), cB + hstep, voffB); PG8_STAGE(PG8_SA(0, 0), cA, voffA); PG8_STAGE(PG8_SA(0, 1), cA + hstep, voffA);
        if (wr == 1) PG8_BAR;
        PG8_WAIT_V(2); PG8_BAR;
        PG8_STAGE(PG8_SB(1, 0), cB + kstep, voffB); PG8_STAGE(PG8_SA(1, 0), cA + kstep, voffA); PG8_STAGE(PG8_SB(1, 1), cB + hstep + kstep, voffB);
        PG8_WAIT_V(6); PG8_BAR;
    } else {
        PG8_STAGE(PG8_SB(0, 0), cB, voffB); PG8_STAGE(PG8_SA(0, 0), cA, voffA); PG8_STAGE(PG8_SB(0, 1), cB + hstep, voffB); PG8_STAGE(PG8_SA(0, 1), cA + hstep, voffA);
        if (wr == 1) PG8_BAR;
        PG8_WAIT_V(4); PG8_BAR;
        PG8_STAGE(PG8_SB(1, 0), cB + kstep, voffB); PG8_STAGE(PG8_SA(1, 0), cA + kstep, voffA); PG8_STAGE(PG8_SB(1, 1), cB + hstep + kstep, voffB);
        PG8_WAIT_V(6); PG8_BAR;
    }
    for (;;) {
        const bool has_next = S.next(ui + 1, nxt);
        const char* nA = has_next ? (const char*)g.A + (size_t)nxt.pm * tstep + (size_t)nxt.ks * sstep : cA; const char* nB = has_next ? (const char*)g.Bt + (size_t)nxt.pn * tstep + (size_t)nxt.ks * sstep : cB;
        for (int t = 0; t < nt; t += 2) {
            const bool last = (t == nt - 2);
            const char* a1 = cA + (size_t)(t + 1) * kstep;
            const char* a2 = last ? nA : cA + (size_t)(t + 2) * kstep; const char* b2 = last ? nB : cB + (size_t)(t + 2) * kstep;
            const char* a3 = a2 + kstep; const char* b3 = b2 + kstep;
            if (last && has_next) S.a_ready(nxt);
            if constexpr (SP2) {
            PG8_LDB(B0, 0, 0); PG8_LDB(B1, 0, 1); PG8_SCHED; PG8_LDA(At, 0, 0); PG8_STAGE(PG8_SA(1, 1), a1 + hstep, voffA);
            PG8_WAIT_V(8); PG8_WAIT_L(0); PG8_BAR; PG8_MMA(0, 0, At, B0); PG8_MMA(0, 1, At, B1); PG8_BAR; PG8_SCHED;
            PG8_LDA(At, 0, 1); PG8_STAGE(PG8_SB(0, 0), b2, voffB); PG8_STAGE(PG8_SB(0, 1), b2 + hstep, voffB); PG8_STAGE(PG8_SA(0, 0), a2, voffA);
            PG8_WAIT_V(8); PG8_WAIT_L(0); PG8_BAR; PG8_MMA(1, 0, At, B0); PG8_MMA(1, 1, At, B1); PG8_BAR; PG8_SCHED;
            PG8_LDB(B0, 1, 0); PG8_LDB(B1, 1, 1); PG8_SCHED; PG8_LDA(At, 1, 0); PG8_STAGE(PG8_SA(0, 1), a2 + hstep, voffA);
            PG8_WAIT_V(8); PG8_WAIT_L(0); PG8_BAR; PG8_MMA(0, 0, At, B0); PG8_MMA(0, 1, At, B1); PG8_BAR; PG8_SCHED;
            PG8_LDA(At, 1, 1); PG8_STAGE(PG8_SB(1, 0), b3, voffB); PG8_STAGE(PG8_SB(1, 1), b3 + hstep, voffB); PG8_STAGE(PG8_SA(1, 0), a3, voffA);
            PG8_WAIT_V(8); PG8_WAIT_L(0); PG8_BAR; PG8_MMA(1, 0, At, B0); PG8_MMA(1, 1, At, B1); PG8_BAR; PG8_SCHED;
            } else {
            PG8_LDB(B0, 0, 0); PG8_SCHED; PG8_LDA(At, 0, 0); PG8_STAGE(PG8_SA(1, 1), a1 + hstep, voffA);
            PG8_WAIT_L(8); PG8_BAR; PG8_WAIT_L(0); PG8_MMA(0, 0, At, B0); PG8_BAR; PG8_SCHED;
            PG8_LDB(B1, 0, 1); PG8_STAGE(PG8_SB(0, 0), b2, voffB);
            PG8_BAR; PG8_WAIT_L(0); PG8_MMA(0, 1, At, B1); PG8_BAR;
            PG8_LDA(At, 0, 1); PG8_STAGE(PG8_SA(0, 0), a2, voffA);
            PG8_BAR; PG8_WAIT_L(0); PG8_MMA(1, 0, At, B0); PG8_BAR; PG8_SCHED;
            PG8_STAGE(PG8_SB(0, 1), b2 + hstep, voffB);
            PG8_WAIT_V(6); PG8_BAR; PG8_MMA(1, 1, At, B1); PG8_BAR;
            PG8_LDB(B0, 1, 0); PG8_SCHED; PG8_LDA(At, 1, 0); PG8_STAGE(PG8_SA(0, 1), a2 + hstep, voffA);
            PG8_WAIT_L(8); PG8_BAR; PG8_WAIT_L(0); PG8_MMA(0, 0, At, B0); PG8_BAR; PG8_SCHED;
            PG8_LDB(B1, 1, 1); PG8_STAGE(PG8_SB(1, 0), b3, voffB);
            PG8_BAR; PG8_WAIT_L(0); PG8_MMA(0, 1, At, B1); PG8_BAR;
            PG8_LDA(At, 1, 1); PG8_STAGE(PG8_SA(1, 0), a3, voffA);
            PG8_BAR; PG8_WAIT_L(0); PG8_MMA(1, 0, At, B0); PG8_BAR; PG8_SCHED;
            PG8_STAGE(PG8_SB(1, 1), b3 + hstep, voffB);
            PG8_WAIT_V(6); PG8_BAR; PG8_MMA(1, 1, At, B1); PG8_BAR;
            }
        }
        if constexpr (ALIGN_EPI) { if (wr == 0) PG8_BAR; }
        if constexpr (!Epi::AFTER_DRAIN) { E(acc, cur, wr, wc, fr, fq); S.done(cur); }
        if (!has_next) break;
#pragma unroll
        for (int a = 0; a < 2; ++a)
#pragma unroll
            for (int b = 0; b < 2; ++b)
#pragma unroll
                for (int m = 0; m < 4; ++m)
#pragma unroll
                    for (int n = 0; n < 2; ++n) acc[a][b][m][n] = (f32x4){0.f, 0.f, 0.f, 0.f};
        cur = nxt; cA = nA; cB = nB; ++ui;
        if constexpr (ALIGN_EPI) { if (wr == 1) PG8_BAR; }
    }
    PG8_WAIT_V(0);
    if constexpr (!ALIGN_EPI) { if (wr == 0) PG8_BAR; }
    PG8_BAR;
    if constexpr (Epi::AFTER_DRAIN) { E.fused(acc, cur, wr, wc, fr, fq, lds, wid, lane); S.done(cur); }
#undef PG8_SA
#undef PG8_SB
#undef PG8_STAGE
#undef PG8_LDA
#undef PG8_LDB
#undef PG8_MMA
#undef PG8_WAIT_V
#undef PG8_WAIT_L
#undef PG8_BAR
#undef PG8_SCHED
}
}
namespace att {
using bf16x8 = __attribute__((ext_vector_type(8))) short;
using s16x4  = __attribute__((ext_vector_type(4))) short;
using f32x16 = __attribute__((ext_vector_type(16))) float;
using u32x4  = __attribute__((ext_vector_type(4))) unsigned;
typedef unsigned short bf16_t;
#define SBAR() __builtin_amdgcn_sched_barrier(0)
__device__ __forceinline__ int crow(int r, int hi) { return (r & 3) + 8 * (r >> 2) + 4 * hi; }
__device__ __forceinline__ unsigned cvtpk(float lo, float hi) { unsigned r; asm volatile("v_cvt_pk_bf16_f32 %0, %1, %2" : "=v"(r) : "v"(lo), "v"(hi)); return r; }
template <int DK> __device__ __forceinline__ int kswz(int row, int colB) { return row * (DK * 2) + (colB ^ ((row & 7) << 4)); }

__device__ __forceinline__ void partialSM(f32x16& p0, f32x16& p1, float& m_reg, float& mn, float& alpha, const float C, const float THRS) {
  float pmax = p0[0];
#pragma unroll
  for (int r = 1; r < 16; ++r) pmax = fmaxf(pmax, p0[r]);
#pragma unroll
  for (int r = 0; r < 16; ++r) pmax = fmaxf(pmax, p1[r]);
  { auto rr = __builtin_amdgcn_permlane32_swap(__float_as_uint(pmax), __float_as_uint(pmax), false, false);
    pmax = fmaxf(__uint_as_float(rr[0]), __uint_as_float(rr[1])); }
  if (__builtin_expect(__all(pmax - m_reg <= THRS), 1)) { mn = m_reg; alpha = 1.f; }
  else { mn = fmaxf(m_reg, pmax); alpha = __builtin_amdgcn_exp2f((m_reg - mn) * C); m_reg = mn; }
  const float mnC = -mn * C;
#pragma unroll
  for (int r = 0; r < 16; ++r) p0[r] = fmaf(p0[r], C, mnC);
#pragma unroll
  for (int r = 0; r < 16; ++r) p1[r] = fmaf(p1[r], C, mnC);
#pragma unroll
  for (int r = 0; r < 16; ++r) p0[r] = __builtin_amdgcn_exp2f(p0[r]);
}
__device__ __forceinline__ void finishSM(f32x16& p0, f32x16& p1, float alpha, float& l_reg, bf16x8& pa0, bf16x8& pa1, bf16x8& pa2, bf16x8& pa3) {
#pragma unroll
  for (int r = 0; r < 16; ++r) p1[r] = __builtin_amdgcn_exp2f(p1[r]);
  float ps = 0;
#pragma unroll
  for (int r = 0; r < 16; ++r) ps += p0[r];
#pragma unroll
  for (int r = 0; r < 16; ++r) ps += p1[r];
  { auto rr = __builtin_amdgcn_permlane32_swap(__float_as_uint(ps), __float_as_uint(ps), false, false);
    ps = __uint_as_float(rr[0]) + __uint_as_float(rr[1]); }
  l_reg = l_reg * alpha + ps;
#define PK4(P, BASE, OUT) do { unsigned a0 = cvtpk(P[BASE + 0], P[BASE + 1]), a1 = cvtpk(P[BASE + 2], P[BASE + 3]);   \
    unsigned b0 = cvtpk(P[BASE + 4], P[BASE + 5]), b1 = cvtpk(P[BASE + 6], P[BASE + 7]);                              \
    auto r0 = __builtin_amdgcn_permlane32_swap(a0, b0, false, false); auto r1 = __builtin_amdgcn_permlane32_swap(a1, b1, false, false); \
    u32x4 w = {r0[0], r1[0], r0[1], r1[1]}; OUT = *reinterpret_cast<bf16x8*>(&w); } while (0)
  PK4(p0, 0, pa0); PK4(p0, 8, pa1); PK4(p1, 0, pa2); PK4(p1, 8, pa3);
#undef PK4
}
template <int DK> __device__ __forceinline__ void qkt(f32x16& p0, f32x16& p1, const char* Ks, const bf16x8* qr, const unsigned kb) {
  constexpr int KROW = DK * 2 + 16;
  p0 = f32x16{}; p1 = f32x16{};
  const char* a = Ks + kb;
#pragma unroll
  for (int d0 = 0; d0 < DK / 16; ++d0) {
    const bf16x8 b0 = *reinterpret_cast<const bf16x8*>(a + d0 * 32);
    const bf16x8 b1 = *reinterpret_cast<const bf16x8*>(a + d0 * 32 + 32 * KROW);
    p0 = __builtin_amdgcn_mfma_f32_32x32x16_bf16(b0, qr[d0], p0, 0, 0, 0);
    p1 = __builtin_amdgcn_mfma_f32_32x32x16_bf16(b1, qr[d0], p1, 0, 0, 0); }
}
template <int DV> __device__ __forceinline__ int v_st(int k, int c) { const int kk = (k & ~0xC) | ((k & 4) << 1) | ((k & 8) >> 1); return ((kk >> 3) * (DV / 32) + (c >> 5)) * 512 + ((kk & 7) * 32 + (c & 31)) * 2; }
__device__ __forceinline__ int v_rd_base(int lane) { return ((lane & 3) << 3) | (((lane >> 2) & 3) << 6) | (((lane >> 4) & 1) << 5) | (((lane >> 5) & 1) << 8); }
template <int DV> constexpr int v_rd_off(int d0, int ks, int half) { return d0 * 512 + ks * (DV / 32) * 1024 + half * (DV / 32) * 512; }
template <int OFF> __device__ __forceinline__ s16x4 tr_read(int vb) { s16x4 r; asm volatile("ds_read_b64_tr_b16 %0, %1 offset:%2" : "=&v"(r) : "v"(vb), "i"(OFF) : "memory"); return r; }
template <int DV, int D0> __device__ __forceinline__ void pv_one(f32x16& od, int vb, bf16x8 pa0, bf16x8 pa1, bf16x8 pa2, bf16x8 pa3) {
  const s16x4 l0 = tr_read<v_rd_off<DV>(D0, 0, 0)>(vb), h0 = tr_read<v_rd_off<DV>(D0, 0, 1)>(vb), l1 = tr_read<v_rd_off<DV>(D0, 1, 0)>(vb), h1 = tr_read<v_rd_off<DV>(D0, 1, 1)>(vb);
  const s16x4 l2 = tr_read<v_rd_off<DV>(D0, 2, 0)>(vb), h2 = tr_read<v_rd_off<DV>(D0, 2, 1)>(vb), l3 = tr_read<v_rd_off<DV>(D0, 3, 0)>(vb), h3 = tr_read<v_rd_off<DV>(D0, 3, 1)>(vb);
  asm volatile("s_waitcnt lgkmcnt(0)" ::: "memory"); SBAR();
#define PK(L, H) (bf16x8){L[0], L[1], L[2], L[3], H[0], H[1], H[2], H[3]}
  od = __builtin_amdgcn_mfma_f32_32x32x16_bf16(pa0, PK(l0, h0), od, 0, 0, 0);
  od = __builtin_amdgcn_mfma_f32_32x32x16_bf16(pa1, PK(l1, h1), od, 0, 0, 0);
  od = __builtin_amdgcn_mfma_f32_32x32x16_bf16(pa2, PK(l2, h2), od, 0, 0, 0);
  od = __builtin_amdgcn_mfma_f32_32x32x16_bf16(pa3, PK(l3, h3), od, 0, 0, 0);
#undef PK
}
template <int DV> __device__ __forceinline__ void pv_all(f32x16* o, int vb, bf16x8 pa0, bf16x8 pa1, bf16x8 pa2, bf16x8 pa3) {
  pv_one<DV, 0>(o[0], vb, pa0, pa1, pa2, pa3); pv_one<DV, 1>(o[1], vb, pa0, pa1, pa2, pa3);
  if constexpr (DV == 128) { pv_one<DV, 2>(o[2], vb, pa0, pa1, pa2, pa3); pv_one<DV, 3>(o[3], vb, pa0, pa1, pa2, pa3); }
}
struct UnitP {
  const bf16_t* Q;
  const bf16_t *Kc, *Vc, *Kn, *Vn;
  const bf16_t *Pc, *Pn;
  bf16_t* O;
  int NT; float m0, l0; int a0, a1;
};
template <int MODE> __device__ __forceinline__ void apply_mask(f32x16& p0, f32x16& p1, int jj, const UnitP& u, int wid, int r32, int hi, const float* bias_l) {
  const float NEG = -1e30f;
  if constexpr (MODE == 2) {
    const int ks = u.a0 - 128 + 64 * jj; const bool tv = (ks >= 0 && ks < SEQ);
    const int lo = 64 * jj - 128 - (wid * 32 + 31), hi_ = 64 * jj - 128 + 63 - wid * 32;
    if (!tv || lo > 128 || hi_ < -128) {
#pragma unroll
      for (int r = 0; r < 16; ++r) { p0[r] = NEG; p1[r] = NEG; }
    } else if (!(lo >= -128 && hi_ <= 128)) {
      const int rel0 = -128 + 64 * jj - (wid * 32 + r32);
#pragma unroll
      for (int r = 0; r < 16; ++r) { const int rel = rel0 + crow(r, hi);
        const bool ok0 = (unsigned)(rel + 128) <= 256u, ok1 = (unsigned)(rel + 160) <= 256u;
        p0[r] = ok0 ? p0[r] : NEG; p1[r] = ok1 ? p1[r] : NEG; }
    }
  } else if constexpr (MODE == 1) {
    int r32o = r32; asm volatile("" : "+v"(r32o));
    const int r = u.a0 + (wid >> 1), c = (wid & 1) * 32 + r32o, kr = u.a1 + jj;
    const int rs = min(max(r - 4, 0), 120), cs = min(max(c - 8, 0), 48); const bool rok = (kr >= rs && kr < rs + 8);
    if (!rok) {
#pragma unroll
      for (int q = 0; q < 16; ++q) { p0[q] = NEG; p1[q] = NEG; }
    } else {
      const int xb = 4 * hi - c + 15, xlo = cs - c + 15; const float* brow = bias_l + (kr - r + 7) * 31 + xb;
#pragma unroll
      for (int q = 0; q < 16; ++q) { const int kq = (q & 3) + 8 * (q >> 2);
        const bool ok0 = (unsigned)(xb + kq - xlo) < 16u, ok1 = (unsigned)(xb + kq + 32 - xlo) < 16u;
        const float b0 = brow[kq], b1 = brow[kq + 32];
        p0[q] = ok0 ? p0[q] + b0 : NEG; p1[q] = ok1 ? p1[q] + b1 : NEG;
        if ((q & 3) == 3) asm volatile("" ::: "memory"); }
    }
  }
}
template <int MODE> __device__ __forceinline__ bool tile_active(const UnitP& u, int j, int wid) {
  if (MODE == 0 || j < 4) return true;
  const int jj = j - 4;
  if (MODE == 1) { const int r = u.a0 + (wid >> 1), kr = u.a1 + jj, rs = min(max(r - 4, 0), 120); return kr >= rs && kr < rs + 8; }
  const int ks = u.a0 - 128 + 64 * jj; const int lo = 64 * jj - 128 - (wid * 32 + 31), hi_ = 64 * jj - 128 + 63 - wid * 32;
  return ks >= 0 && ks < SEQ && lo <= 128 && hi_ >= -128;
}
template <int DK, int DV, int LDQ, int LDK, int LDV, int MODE, int SDEPTH, bool SERIAL, bool EARLY>
__device__ __forceinline__ void attn_unit(const UnitP& u, char* lds, const float* bias_l, const int tid) {
  constexpr float SCALE = (DK == 192) ? 0.07216878364870322f : 0.125f;
  constexpr float C = SCALE * 1.4426950408889634f, THRS = 8.f / SCALE;
  constexpr int KROW = DK * 2 + 16, SHM_V = 64 * DV * 2, SHM_K = 64 * KROW, KC = DK / 64, VC = DV / 64, ND = DK / 16, NO = DV / 32;
  const int wid = __builtin_amdgcn_readfirstlane(tid >> 6), lane = tid & 63, r32 = lane & 31, hi = lane >> 5;
  constexpr int NSL = EARLY ? 3 : 2;
  char* V_lds = lds; char* K_lds = lds + NSL * SHM_V;
  float* ws = (float*)(lds + NSL * SHM_V + NSL * SHM_K) + wid * 64; float* li_l = ws; float* al_l = ws + 32;
  float m_reg = u.m0, l_reg = u.l0; f32x16 o[NO]; bf16x8 qr[ND];
#pragma unroll
  for (int d = 0; d < NO; ++d) o[d] = f32x16{};
  const bf16_t* Qw = u.Q + (long)(wid * 32 + r32) * LDQ + hi * 8;
#pragma unroll
  for (int d0 = 0; d0 < ND; ++d0) qr[d0] = *reinterpret_cast<const bf16x8*>(Qw + d0 * 16);
  const unsigned srow = tid >> 3, sch = tid & 7;
  const unsigned kofs0 = srow * LDK + sch * 8, vofs0 = srow * LDV + sch * 8, pofs0 = srow * 64 + sch * 8;
  const unsigned kdst0 = srow * KROW + sch * 16, vdst0 = (unsigned)v_st<DV>((int)srow, (int)sch * 8);
  const int vb0 = (int)(uintptr_t)V_lds + v_rd_base(lane);
  const unsigned kb = (unsigned)(r32 * KROW + hi * 16);
  struct { bf16x8 k[KC]; bf16x8 v[VC]; } sr_[SDEPTH];
#define LBAR() asm volatile("s_waitcnt lgkmcnt(0)\n\ts_barrier" ::: "memory")
#define TILE_PTRS(j, Kt, Vt) do { if ((j) < 4) { Kt = u.Kc + (long)(j) * 64 * LDK; Vt = u.Vc + (long)(j) * 64 * LDV; } \
    else if (MODE == 2) { int ks_ = u.a0 - 128 + 64 * ((j) - 4); if (ks_ < 0 || ks_ >= SEQ) ks_ = 0; Kt = u.Kn + (long)ks_ * LDK; Vt = u.Vn + (long)ks_ * LDV; } \
    else { Kt = u.Kn + (long)((j) - 4) * 64 * LDK; Vt = u.Vn + (long)((j) - 4) * 64 * LDV; } } while (0)
#define SLOAD(i, j) do { const bf16_t *Kt_, *Vt_; TILE_PTRS(j, Kt_, Vt_); \
    _Pragma("unroll") for (int c = 0; c < VC; ++c) sr_[i].v[c] = *reinterpret_cast<const bf16x8*>(Vt_ + vofs0 + 64 * c); \
    _Pragma("unroll") for (int c = 0; c < KC; ++c) { if (DK == 192 && c == 2) { const bf16_t* Pt_ = ((j) < 4) ? u.Pc + (long)(j) * 64 * 64 : u.Pn + (long)((j) - 4) * 64 * 64; \
        sr_[i].k[c] = *reinterpret_cast<const bf16x8*>(Pt_ + pofs0); } else sr_[i].k[c] = *reinterpret_cast<const bf16x8*>(Kt_ + kofs0 + 64 * c); } } while (0)
#define SWRITE(b, i) do { _Pragma("unroll") for (int c = 0; c < VC; ++c) *(bf16x8*)(V_lds + (b) * SHM_V + vdst0 + 1024 * c) = sr_[i].v[c]; \
    _Pragma("unroll") for (int c = 0; c < KC; ++c) *(bf16x8*)(K_lds + (b) * SHM_K + kdst0 + 128 * c) = sr_[i].k[c]; } while (0)
#define SWAIT() do { if constexpr (SDEPTH == 2) asm volatile("s_waitcnt vmcnt(%0)" :: "n"(KC + VC) : "memory"); else asm volatile("s_waitcnt vmcnt(0)" ::: "memory"); } while (0)
#define RESC(a) do { if (__any((a) < 1.f)) { if (hi == 0) al_l[r32] = (a); asm volatile("s_waitcnt lgkmcnt(0)" ::: "memory"); \
    _Pragma("unroll") for (int d = 0; d < NO; ++d) _Pragma("unroll") for (int r = 0; r < 16; ++r) o[d][r] *= al_l[crow(r, hi)]; } } while (0)
#define MASK(P0, P1, j) do { if (MODE != 0 && (j) >= 4) apply_mask<MODE>(P0, P1, (j) - 4, u, wid, r32, hi, bias_l); } while (0)
  bf16x8 pa0, pa1, pa2, pa3; const int NT = u.NT;
  if constexpr (SERIAL) {
    f32x16 p0, p1; float mn, al;
    SLOAD(0, 0); asm volatile("s_waitcnt vmcnt(0)" ::: "memory"); SWRITE(0, 0); LBAR();
    for (int j = 0; j < NT; ++j) {
      const int b = j & 1;
      if (j + 1 < NT) SLOAD(0, j + 1);
      SBAR(); qkt<DK>(p0, p1, K_lds + b * SHM_K, qr, kb); MASK(p0, p1, j);
      partialSM(p0, p1, m_reg, mn, al, C, THRS); RESC(al);
      finishSM(p0, p1, al, l_reg, pa0, pa1, pa2, pa3); SBAR();
      pv_all<DV>(o, vb0 + b * SHM_V, pa0, pa1, pa2, pa3); SBAR();
      if (j + 1 < NT) SWRITE(b ^ 1, 0);
      LBAR();
    }
  } else {
  f32x16 pA0, pA1, pB0, pB1; float mnA, mnB, alA, alB;
  constexpr int SE = 0, SO = SDEPTH - 1;
  if constexpr (EARLY) {
  static_assert(!EARLY || SDEPTH == 1, "RING3 is an SDEPTH == 1 schedule");
  int s_prev = 0, s_cur = 0, s_next = 1;
#define ROT3() do { s_prev = s_cur; s_cur = s_next; s_next = (s_next == 2) ? 0 : s_next + 1; } while (0)
  SLOAD(0, 0); asm volatile("s_waitcnt vmcnt(0)" ::: "memory"); SWRITE(0, 0); LBAR();
  SLOAD(0, 1);
  qkt<DK>(pA0, pA1, K_lds, qr, kb); SBAR();
  asm volatile("s_waitcnt vmcnt(0)" ::: "memory"); SWRITE(1, 0); SBAR(); if (2 < NT) SLOAD(0, 2); SBAR();
  partialSM(pA0, pA1, m_reg, mnA, alA, C, THRS); LBAR(); ROT3();
  for (int t = 1; t + 1 < NT; t += 2) {
    asm volatile("s_waitcnt vmcnt(0)" ::: "memory"); SWRITE(s_next, 0); SBAR();
    qkt<DK>(pB0, pB1, K_lds + s_cur * SHM_K, qr, kb); finishSM(pA0, pA1, alA, l_reg, pa0, pa1, pa2, pa3); SBAR();
    if (t + 2 < NT) SLOAD(0, t + 2); SBAR();
    pv_all<DV>(o, vb0 + s_prev * SHM_V, pa0, pa1, pa2, pa3); MASK(pB0, pB1, t); partialSM(pB0, pB1, m_reg, mnB, alB, C, THRS);
    RESC(alB); LBAR(); ROT3();
    asm volatile("s_waitcnt vmcnt(0)" ::: "memory"); SWRITE(s_next, 0); SBAR();
    qkt<DK>(pA0, pA1, K_lds + s_cur * SHM_K, qr, kb); finishSM(pB0, pB1, alB, l_reg, pa0, pa1, pa2, pa3); SBAR();
    if (t + 3 < NT) SLOAD(0, t + 3); SBAR();
    pv_all<DV>(o, vb0 + s_prev * SHM_V, pa0, pa1, pa2, pa3); MASK(pA0, pA1, t + 1); partialSM(pA0, pA1, m_reg, mnA, alA, C, THRS);
    RESC(alA); LBAR(); ROT3();
  }
  SBAR(); qkt<DK>(pB0, pB1, K_lds + s_cur * SHM_K, qr, kb); finishSM(pA0, pA1, alA, l_reg, pa0, pa1, pa2, pa3); SBAR();
  pv_all<DV>(o, vb0 + s_prev * SHM_V, pa0, pa1, pa2, pa3); MASK(pB0, pB1, NT - 1); partialSM(pB0, pB1, m_reg, mnB, alB, C, THRS);
  RESC(alB);
  finishSM(pB0, pB1, alB, l_reg, pa0, pa1, pa2, pa3); SBAR();
  pv_all<DV>(o, vb0 + s_cur * SHM_V, pa0, pa1, pa2, pa3);
#undef ROT3
  } else {
  if constexpr (MODE == 0) {
  SLOAD(SE, 0); asm volatile("s_waitcnt vmcnt(0)" ::: "memory"); SWRITE(0, SE); LBAR();
  qkt<DK>(pA0, pA1, K_lds, qr, kb); partialSM(pA0, pA1, m_reg, mnA, alA, C, THRS);
  SLOAD(SO, 1); if constexpr (SDEPTH == 2) { if (2 < NT) SLOAD(SE, 2); }
  SWAIT(); SWRITE(1, SO); LBAR();
  for (int j = 1; j + 1 < NT; j += 2) {
    SBAR(); qkt<DK>(pB0, pB1, K_lds + SHM_K, qr, kb); finishSM(pA0, pA1, alA, l_reg, pa0, pa1, pa2, pa3); SBAR();
    SLOAD(SO, j + SDEPTH); SBAR();
    pv_all<DV>(o, vb0, pa0, pa1, pa2, pa3); MASK(pB0, pB1, j); partialSM(pB0, pB1, m_reg, mnB, alB, C, THRS);
    LBAR(); SWAIT(); SWRITE(0, SE);
    RESC(alB); LBAR();
    SBAR(); qkt<DK>(pA0, pA1, K_lds, qr, kb); finishSM(pB0, pB1, alB, l_reg, pa0, pa1, pa2, pa3); SBAR();
    if (SDEPTH == 1 || j + 3 < NT) SLOAD(SE, j + 1 + SDEPTH); SBAR();
    pv_all<DV>(o, vb0 + SHM_V, pa0, pa1, pa2, pa3); MASK(pA0, pA1, j + 1); partialSM(pA0, pA1, m_reg, mnA, alA, C, THRS);
    LBAR(); SWAIT(); SWRITE(1, SO);
    RESC(alA); LBAR();
  }
  SBAR(); qkt<DK>(pB0, pB1, K_lds + SHM_K, qr, kb); finishSM(pA0, pA1, alA, l_reg, pa0, pa1, pa2, pa3); SBAR();
  pv_all<DV>(o, vb0, pa0, pa1, pa2, pa3); MASK(pB0, pB1, NT - 1); partialSM(pB0, pB1, m_reg, mnB, alB, C, THRS);
  LBAR(); RESC(alB);
  finishSM(pB0, pB1, alB, l_reg, pa0, pa1, pa2, pa3); SBAR();
  pv_all<DV>(o, vb0 + SHM_V, pa0, pa1, pa2, pa3);
  } else {
  SLOAD(SE, 0); asm volatile("s_waitcnt vmcnt(0)" ::: "memory"); SWRITE(0, SE); LBAR();
  qkt<DK>(pA0, pA1, K_lds, qr, kb); partialSM(pA0, pA1, m_reg, mnA, alA, C, THRS);
  SLOAD(SO, 1); if constexpr (SDEPTH == 2) { if (2 < NT) SLOAD(SE, 2); }
  SWAIT(); SWRITE(1, SO); LBAR();
  bool actA = true, actB = true;
  for (int j = 1; j + 1 < NT; j += 2) {
    actB = tile_active<MODE>(u, j, wid);
    SBAR();
    if (actA && actB) { qkt<DK>(pB0, pB1, K_lds + SHM_K, qr, kb); finishSM(pA0, pA1, alA, l_reg, pa0, pa1, pa2, pa3); }
    else { if (actB) qkt<DK>(pB0, pB1, K_lds + SHM_K, qr, kb); if (actA) finishSM(pA0, pA1, alA, l_reg, pa0, pa1, pa2, pa3); }
    SBAR(); SLOAD(SO, j + SDEPTH); SBAR();
    alB = 1.f;
    if (actA && actB) { pv_all<DV>(o, vb0, pa0, pa1, pa2, pa3); MASK(pB0, pB1, j); partialSM(pB0, pB1, m_reg, mnB, alB, C, THRS); }
    else { if (actA) pv_all<DV>(o, vb0, pa0, pa1, pa2, pa3); if (actB) { MASK(pB0, pB1, j); partialSM(pB0, pB1, m_reg, mnB, alB, C, THRS); } }
    LBAR(); SWAIT(); SWRITE(0, SE);
    RESC(alB); LBAR();
    actA = tile_active<MODE>(u, j + 1, wid);
    SBAR();
    if (actA && actB) { qkt<DK>(pA0, pA1, K_lds, qr, kb); finishSM(pB0, pB1, alB, l_reg, pa0, pa1, pa2, pa3); }
    else { if (actA) qkt<DK>(pA0, pA1, K_lds, qr, kb); if (actB) finishSM(pB0, pB1, alB, l_reg, pa0, pa1, pa2, pa3); }
    SBAR(); if (SDEPTH == 1 || j + 3 < NT) SLOAD(SE, j + 1 + SDEPTH); SBAR();
    alA = 1.f;
    if (actA && actB) { pv_all<DV>(o, vb0 + SHM_V, pa0, pa1, pa2, pa3); MASK(pA0, pA1, j + 1); partialSM(pA0, pA1, m_reg, mnA, alA, C, THRS); }
    else { if (actB) pv_all<DV>(o, vb0 + SHM_V, pa0, pa1, pa2, pa3); if (actA) { MASK(pA0, pA1, j + 1); partialSM(pA0, pA1, m_reg, mnA, alA, C, THRS); } }
    LBAR(); SWAIT(); SWRITE(1, SO);
    RESC(alA); LBAR();
  }
  actB = tile_active<MODE>(u, NT - 1, wid);
  SBAR(); if (actB) qkt<DK>(pB0, pB1, K_lds + SHM_K, qr, kb); if (actA) finishSM(pA0, pA1, alA, l_reg, pa0, pa1, pa2, pa3); SBAR();
  alB = 1.f;
  if (actA) pv_all<DV>(o, vb0, pa0, pa1, pa2, pa3);
  if (actB) { MASK(pB0, pB1, NT - 1); partialSM(pB0, pB1, m_reg, mnB, alB, C, THRS); }
  LBAR(); RESC(alB);
  if (actB) { finishSM(pB0, pB1, alB, l_reg, pa0, pa1, pa2, pa3); SBAR(); pv_all<DV>(o, vb0 + SHM_V, pa0, pa1, pa2, pa3); }
  }
  }
  }
  { int lane2; asm volatile("v_mbcnt_lo_u32_b32 %0, -1, 0\n\tv_mbcnt_hi_u32_b32 %0, -1, %0" : "=v"(lane2)); const int wid2 = wid, r32b = lane2 & 31, hib = lane2 >> 5;
    float* li2 = (float*)(lds + NSL * SHM_V + NSL * SHM_K) + wid2 * 64;
    if (hib == 0) li2[r32b] = l_reg; asm volatile("s_waitcnt lgkmcnt(0)" ::: "memory");
    LBAR();
    bf16_t* stg = (bf16_t*)lds + wid2 * 32 * DV;
#pragma unroll
    for (int r = 0; r < 16; ++r) { const int orow = crow(r, hib); const float rl = __builtin_amdgcn_rcpf(li2[orow]);
#pragma unroll
      for (int d0 = 0; d0 < NO; ++d0) { const unsigned w = cvtpk(o[d0][r] * rl, 0.f); stg[orow * DV + d0 * 32 + r32b] = (bf16_t)(w & 0xffffu); } }
    asm volatile("s_waitcnt lgkmcnt(0)" ::: "memory");
    bf16_t* Ow = u.O + (long)(wid2 * 32) * DM;
#pragma unroll
    for (int i = 0; i < (32 * DV / 8) / 64; ++i) { const int id = i * 64 + lane2, row = id / (DV / 8), ch = id % (DV / 8);
      const u32x4 v = *(const u32x4*)(stg + row * DV + ch * 8); *(u32x4*)(Ow + (long)row * DM + ch * 8) = v; } }
  LBAR();
#undef LBAR
#undef TILE_PTRS
#undef SLOAD
#undef SWRITE
#undef SWAIT
#undef RESC
#undef MASK
}
#undef SBAR
}
typedef unsigned short bf16_t;
typedef float f32x4 __attribute__((ext_vector_type(4)));
typedef unsigned u32x4 __attribute__((ext_vector_type(4)));
typedef unsigned u32x2 __attribute__((ext_vector_type(2)));
#define LAS __attribute__((address_space(3)))
#define XB_TMO      128
#define XB_XCNT(j)  (256  + 64 * (j))
#define XB_XSUB(j)  (1280 + 64 * (j))
#define XB_XGEN(j)  (2304 + 64 * (j))
#define XB_TOP      3328
#define XB_TOPGEN   3392
#define XCD_BAR_WORDS 3456
#define XB_SPIN_CAP (1u << 18)

__device__ __forceinline__ unsigned xb_ld(unsigned* p)              { return __hip_atomic_load(p, __ATOMIC_RELAXED, __HIP_MEMORY_SCOPE_AGENT); }
__device__ __forceinline__ unsigned xb_add(unsigned* p, unsigned v) { return __hip_atomic_fetch_add(p, v, __ATOMIC_RELAXED, __HIP_MEMORY_SCOPE_AGENT); }
__device__ __forceinline__ unsigned xb_xcc_id() { return (unsigned)__builtin_amdgcn_s_getreg((3 << 11) | 20) & 0xFu; }
#define XB_SPIN(cond, bar) do { unsigned _sp = 0; while (cond) { __builtin_amdgcn_s_sleep(1); \
    if ((++_sp & 255u) == 0u) { if (xb_ld(&(bar)[XB_TMO])) break; if (_sp > XB_SPIN_CAP) { atomicAdd(&(bar)[XB_TMO], 1u); break; } } } } while (0)

struct XcdBarrier {
    unsigned* bar; unsigned x;
    volatile LAS unsigned* st;
};

__device__ __forceinline__ XcdBarrier xcd_barrier_post(unsigned* bar, volatile LAS unsigned* st) {
    XcdBarrier b; b.bar = bar; b.x = xb_xcc_id(); b.st = st;
    if (threadIdx.x == 0) (void)xb_add(&bar[XB_XCNT(b.x)], 1u);
    return b;
}
__device__ __forceinline__ void xcd_barrier_complete(unsigned* bar, unsigned x, unsigned& nloc, unsigned& nx) {
    const unsigned G = gridDim.x * gridDim.y * gridDim.z;
    unsigned sum, cnt, mine, sp = 0u;
    for (;;) {
        sum = 0u; cnt = 0u; mine = 0u;
#pragma unroll
        for (unsigned j = 0; j < 16; ++j) { const unsigned c = xb_ld(&bar[XB_XCNT(j)]); sum += c; cnt += (c > 0u) ? 1u : 0u; mine = (j == x) ? c : mine; }
        if (sum == G) break;
        __builtin_amdgcn_s_sleep(1);
        if ((++sp & 255u) == 0u) { if (xb_ld(&bar[XB_TMO])) break; if (sp > XB_SPIN_CAP) { atomicAdd(&bar[XB_TMO], 1u); break; } }
    }
    nloc = mine > 0u ? mine : 1u; nx = cnt > 0u ? cnt : 1u;
}

__device__ __forceinline__ void xcd_barrier(const XcdBarrier& b, const int tid) {
    asm volatile("s_waitcnt vmcnt(0)" ::: "memory");
    __syncthreads();
    if (tid == 0) {
        unsigned* bar = b.bar;
        __builtin_amdgcn_s_waitcnt(0);
        unsigned nloc = b.st[0], nx = b.st[1];
        if (nloc == 0u) { xcd_barrier_complete(bar, b.x, nloc, nx); b.st[0] = nloc; b.st[1] = nx; }
        const unsigned old = xb_add(&bar[XB_XSUB(b.x)], 1u);
        const unsigned gen = old / nloc;
        if (old + 1u == (gen + 1u) * nloc) {
            __builtin_amdgcn_fence(__ATOMIC_RELEASE, "agent");
            asm volatile("s_waitcnt vmcnt(0)" ::: "memory");
            const unsigned og = xb_add(&bar[XB_TOP], 1u);
            const unsigned tg = og / nx;
            if (og + 1u == (tg + 1u) * nx) xb_add(&bar[XB_TOPGEN], 1u);
            else XB_SPIN(xb_ld(&bar[XB_TOPGEN]) == tg, bar);
            __builtin_amdgcn_fence(__ATOMIC_ACQUIRE, "agent");
            xb_add(&bar[XB_XGEN(b.x)], 1u);
            asm volatile("s_waitcnt vmcnt(0)" ::: "memory");
        } else {
            XB_SPIN(xb_ld(&bar[XB_XGEN(b.x)]) == gen, bar);
            __builtin_amdgcn_fence(__ATOMIC_ACQUIRE, "agent");
            asm volatile("s_waitcnt vmcnt(0)" ::: "memory");
        }
    }
    __syncthreads();
}

constexpr size_t MiB = 1u << 20;
constexpr size_t WS_BAR = 7 * MiB, BAR_BYTES = FUSED_NORM ? 1 * MiB : 16384;
constexpr size_t WS_MOD = 0, WS_ROPE = 1 * MiB, WS_XCTX = 3 * MiB;
constexpr size_t WS_WFI = 8 * MiB, WS_WFO = 52 * MiB, WS_WMLA = 74 * MiB, WS_WNA = 85 * MiB, WS_WSWA = 93 * MiB;
constexpr size_t MLA_W_STRIDE = (size_t)(768 * 1024 + 1536 * 256 + 2048 * 256 + 1024 * 1024) * 2;
constexpr size_t MLA_OFF_UQ = (size_t)768 * 1024 * 2, MLA_OFF_UKV = MLA_OFF_UQ + (size_t)1536 * 256 * 2, MLA_OFF_WO = MLA_OFF_UKV + (size_t)2048 * 256 * 2;
constexpr size_t WS_XN = 98 * MiB, WS_S = 164 * MiB, WS_Q = 197 * MiB, WS_K = 296 * MiB, WS_V = 395 * MiB, WS_SLOT = 461 * MiB, WS_PART = 463 * MiB, WS_END = 507 * MiB, WS_KPE = 463 * MiB, WS_NEED = 468 * MiB;
constexpr size_t SLOT_BYTES = (size_t)TOK * 4 * 4;
constexpr size_t WS_CNT = 7 * MiB + 65536, CNT_BANK = 132 * 256;
static_assert(WS_SLOT + 2 * SLOT_BYTES <= WS_PART && WS_PART + (size_t)11 * NCTX * DM * 4 <= WS_END && WS_CNT + 16 * CNT_BANK <= 8 * MiB, "slots/counters");
static_assert(WS_WMLA + 2 * MLA_W_STRIDE <= WS_WNA && WS_XN + (size_t)TOK * DM * 2 <= WS_S && WS_S + (size_t)TOK * 512 * 2 <= WS_Q, "ws map");
static_assert(WS_Q + (size_t)TOK * 1536 * 2 <= WS_K && WS_K + (size_t)TOK * 8 * 192 * 2 <= WS_V && WS_V + (size_t)TOK * DM * 2 <= WS_SLOT, "ws map 2");
static_assert(WS_Q + (size_t)TOK * 3072 * 2 <= WS_V && WS_Q + (size_t)TOK * DFF * 2 <= WS_V, "overlays");
static_assert(FUSE_LAT && !SPLIT_CTX && WS_KPE + (size_t)NBATCH * MLA_KEYS * 64 * 2 <= WS_NEED, "the shared rotary-key buffer is written by the fused latent epilogue and overlays WS_PART");
constexpr int LDS_BYTES = 147456, NWAVES = 8, NTHREADS = 512;
constexpr float NORM_EPS = 1e-6f;

struct WDesc { const float* src; bf16_t* dst; int K, N, Np, kind, first, pad; };
constexpr int NWD = 20;
struct Params {
  const float* in[24]; float* out; unsigned char* ws;
  int nph, lo, hi, nitems;
  unsigned char prog[64];
  WDesc wd[NWD];
};

__device__ __forceinline__ unsigned f2bf(float f) { unsigned u = __builtin_bit_cast(unsigned, f); return (u + 0x7fffu + ((u >> 16) & 1u)) >> 16; }
__device__ __forceinline__ unsigned pk2(float lo, float hi) { return f2bf(lo) | (f2bf(hi) << 16); }
__device__ __forceinline__ float bf2f(unsigned short b) { return __builtin_bit_cast(float, (unsigned)b << 16); }
__device__ __forceinline__ float wave_sum(float v, int lane) {
#pragma unroll
  for (int o = 1; o < 64; o <<= 1) v += __builtin_bit_cast(float, __builtin_amdgcn_ds_bpermute((lane ^ o) << 2, __builtin_bit_cast(int, v)));
  return v;
}
__device__ __forceinline__ int srccol(int kind, int np) {
  switch (kind) {
    case 1: { const int grp = np >> 3, w = np & 7; return (w < 4) ? grp * 4 + w : DFF + grp * 4 + (w - 4); }
    case 2: { if (np < 512) return np; if (np < 576) { const int q = np - 512; return 512 + (q >> 1) + 32 * (q & 1); } return -1; }
    case 3: { const int h = np / 192, w = np % 192; if (w < 128) return np; const int q = w - 128; return h * 192 + 128 + (q >> 1) + 32 * (q & 1); }
    case 4: { if (np >= 1152) return np; const int hh = np >> 6, q = np & 63; return hh * 64 + (q >> 1) + 32 * (q & 1); }
    default: return np;
  }
}
__device__ __forceinline__ void transpose_item(const WDesc& d, LAS float* scr, int item, int lane) {
  const int nblk = d.Np / 32, kb = item / nblk, nb = item % nblk, k0 = 64 * kb, n0 = 32 * nb;
  const int sc = srccol(d.kind, n0 + (lane & 31));
  float tv[32];
#pragma unroll
  for (int i = 0; i < 32; ++i) { const int kk = 2 * i + (lane >> 5); tv[i] = (sc >= 0) ? __builtin_nontemporal_load(d.src + (size_t)(k0 + kk) * d.N + sc) : 0.f; }
#pragma unroll
  for (int i = 0; i < 32; ++i) { const int kk = 2 * i + (lane >> 5); scr[kk * 33 + (lane & 31)] = tv[i]; }
  asm volatile("s_waitcnt lgkmcnt(0)" ::: "memory");
  const int c = lane & 7;
#pragma unroll
  for (int j = 0; j < 4; ++j) { const int n = (lane >> 3) + 8 * j; const LAS float* s = scr + (8 * c) * 33 + n;
    u32x4 o; o.x = pk2(s[0 * 33], s[1 * 33]); o.y = pk2(s[2 * 33], s[3 * 33]); o.z = pk2(s[4 * 33], s[5 * 33]); o.w = pk2(s[6 * 33], s[7 * 33]);
    *(u32x4*)(d.dst + (size_t)(n0 + n) * d.K + k0 + 8 * c) = o; }
  asm volatile("s_waitcnt lgkmcnt(0)" ::: "memory");
}
__device__ __forceinline__ float* xrow(const Params& P, int row) { return row < NLAT ? P.out + (size_t)row * DM : (float*)(P.ws + WS_XCTX) + (size_t)(row - NLAT) * DM; }
__device__ __forceinline__ const float* modvec(const Params& P, int layer, int row, int which) {
  const int r = row < NLAT ? (row >> 13) : 4; return (const float*)(P.ws + WS_MOD) + ((size_t)(layer * 5 + r) * 6 + which) * DM;
}
template <int NR> __device__ __forceinline__ void wave_sum_n(float (&s)[NR], int lane) {
#pragma unroll
  for (int o = 1; o < 64; o <<= 1) {
#pragma unroll
    for (int i = 0; i < NR; ++i) s[i] += __builtin_bit_cast(float, __builtin_amdgcn_ds_bpermute((lane ^ o) << 2, __builtin_bit_cast(int, s[i]))); }
}
__device__ __forceinline__ void row_pass_ctx(const Params& P, int gw, int NGW, int lane, const float* xs_ctx, const float* part, int nsplit, const float* g_post, int l_gate, int w_gate,
    const float* g_pre, int l_norm, int w_shift, int w_scale, float gscale) {
  for (int r = gw; r < NCTX; r += NGW) { const int row = NLAT + r;
    f32x4 a[4], v[4];
#pragma unroll
    for (int j = 0; j < 4; ++j) { a[j] = (f32x4){0.f, 0.f, 0.f, 0.f}; v[j] = *(const f32x4*)(xs_ctx + (size_t)r * DM + 4 * lane + 256 * j); }
    for (int s = 0; s < nsplit; ++s) {
#pragma unroll
      for (int j = 0; j < 4; ++j) a[j] += *(const f32x4*)(part + ((size_t)s * NCTX + r) * DM + 4 * lane + 256 * j); }
    float ss = 0.f;
#pragma unroll
    for (int j = 0; j < 4; ++j) ss += (a[j][0] * a[j][0] + a[j][1] * a[j][1]) + (a[j][2] * a[j][2] + a[j][3] * a[j][3]);
    float rstd = 1.0f / sqrtf(wave_sum(ss, lane) * (1.0f / DM) + NORM_EPS);
    const float* gate = modvec(P, l_gate, row, w_gate); float* xd = xrow(P, row);
#pragma unroll
    for (int j = 0; j < 4; ++j) { const int c = 4 * lane + 256 * j; const f32x4 g = *(const f32x4*)(g_post + c), gt = *(const f32x4*)(gate + c) * gscale; v[j] = v[j] + gt * (a[j] * rstd * g); *(f32x4*)(xd + c) = v[j]; }
    ss = 0.f;
#pragma unroll
    for (int j = 0; j < 4; ++j) ss += (v[j][0] * v[j][0] + v[j][1] * v[j][1]) + (v[j][2] * v[j][2] + v[j][3] * v[j][3]);
    rstd = 1.0f / sqrtf(wave_sum(ss, lane) * (1.0f / DM) + NORM_EPS);
    const float* shift = modvec(P, l_norm, row, w_shift); const float* scale = modvec(P, l_norm, row, w_scale); bf16_t* xn = (bf16_t*)(P.ws + WS_XN) + (size_t)row * DM;
#pragma unroll
    for (int j = 0; j < 4; ++j) { const int c = 4 * lane + 256 * j; const f32x4 g = *(const f32x4*)(g_pre + c), sh = *(const f32x4*)(shift + c), sc = *(const f32x4*)(scale + c);
      const f32x4 h = (v[j] * rstd * g) * (1.0f + sc) + sh; u32x2 w; w.x = pk2(h[0], h[1]); w.y = pk2(h[2], h[3]); *(u32x2*)(xn + c) = w; }
  }
}
template <int NR> __device__ __forceinline__ void row_pass_multi(const Params& P, int gw, int NGW, int nrows, int lane, const float* xs_lat, const float* xs_ctx,
    bool has_res, const bf16_t* src, const float* g_post, int l_gate, int w_gate, bool do_norm, const float* g_pre, int l_norm, int w_shift, int w_scale, float gscale = 1.0f) {
  f32x4 gp[4], gq[4], gtv[4], shv[4], scv[4]; int cur_g = -1, cur_n = -1;
#pragma unroll
  for (int j = 0; j < 4; ++j) { gp[j] = has_res ? *(const f32x4*)(g_post + 4 * lane + 256 * j) : (f32x4){0.f, 0.f, 0.f, 0.f}; gq[j] = do_norm ? *(const f32x4*)(g_pre + 4 * lane + 256 * j) : (f32x4){0.f, 0.f, 0.f, 0.f};
    gtv[j] = shv[j] = scv[j] = (f32x4){0.f, 0.f, 0.f, 0.f}; }
  for (int base = gw; base < nrows; base += NR * NGW) {
    u32x2 raw[NR][4]; f32x4 v[NR][4];
#pragma unroll
    for (int i = 0; i < NR; ++i) { const int row = base + i * NGW;
      if (row < nrows) { const float* xs = row < NLAT ? xs_lat + (size_t)row * DM : xs_ctx + (size_t)(row - NLAT) * DM;
#pragma unroll
        for (int j = 0; j < 4; ++j) v[i][j] = __builtin_nontemporal_load((const f32x4*)(xs + 4 * lane + 256 * j));
        if (has_res) {
#pragma unroll
          for (int j = 0; j < 4; ++j) raw[i][j] = __builtin_nontemporal_load((const u32x2*)(src + (size_t)row * DM + 4 * lane + 256 * j)); }
      } else {
#pragma unroll
        for (int j = 0; j < 4; ++j) { v[i][j] = (f32x4){0.f, 0.f, 0.f, 0.f}; raw[i][j] = (u32x2){0u, 0u}; } } }
    if (has_res) {
      float ss[NR];
#pragma unroll
      for (int i = 0; i < NR; ++i) { ss[i] = 0.f;
#pragma unroll
        for (int j = 0; j < 4; ++j) { const float a0 = __builtin_bit_cast(float, raw[i][j].x << 16), a1 = __builtin_bit_cast(float, raw[i][j].x & 0xffff0000u), a2 = __builtin_bit_cast(float, raw[i][j].y << 16), a3 = __builtin_bit_cast(float, raw[i][j].y & 0xffff0000u);
          ss[i] += (a0 * a0 + a1 * a1) + (a2 * a2 + a3 * a3); } }
      wave_sum_n<NR>(ss, lane);
#pragma unroll
      for (int i = 0; i < NR; ++i) { const int row = base + i * NGW;
        if (row < nrows) { const float rstd = 1.0f / sqrtf(ss[i] * (1.0f / DM) + NORM_EPS); float* xd = xrow(P, row);
          const int rm = row < NLAT ? (row >> 13) : 4;
          if (rm != cur_g) { const float* gate = modvec(P, l_gate, row, w_gate); cur_g = rm;
#pragma unroll
            for (int j = 0; j < 4; ++j) gtv[j] = *(const f32x4*)(gate + 4 * lane + 256 * j) * gscale; }
#pragma unroll
          for (int j = 0; j < 4; ++j) { const int c = 4 * lane + 256 * j; const f32x4 g = gp[j], gt = gtv[j];
            f32x4 a; a[0] = __builtin_bit_cast(float, raw[i][j].x << 16); a[1] = __builtin_bit_cast(float, raw[i][j].x & 0xffff0000u); a[2] = __builtin_bit_cast(float, raw[i][j].y << 16); a[3] = __builtin_bit_cast(float, raw[i][j].y & 0xffff0000u);
            v[i][j] = v[i][j] + gt * (a * rstd * g); __builtin_nontemporal_store(v[i][j], (f32x4*)(xd + c)); } } }
    }
    if (do_norm) {
      float ss[NR];
#pragma unroll
      for (int i = 0; i < NR; ++i) { ss[i] = 0.f;
#pragma unroll
        for (int j = 0; j < 4; ++j) ss[i] += (v[i][j][0] * v[i][j][0] + v[i][j][1] * v[i][j][1]) + (v[i][j][2] * v[i][j][2] + v[i][j][3] * v[i][j][3]); }
      wave_sum_n<NR>(ss, lane);
#pragma unroll
      for (int i = 0; i < NR; ++i) { const int row = base + i * NGW;
        if (row < nrows) { const float rstd = 1.0f / sqrtf(ss[i] * (1.0f / DM) + NORM_EPS);
          const int rm = row < NLAT ? (row >> 13) : 4;
          if (rm != cur_n) { const float* shift = modvec(P, l_norm, row, w_shift); const float* scale = modvec(P, l_norm, row, w_scale); cur_n = rm;
#pragma unroll
            for (int j = 0; j < 4; ++j) { shv[j] = *(const f32x4*)(shift + 4 * lane + 256 * j); scv[j] = *(const f32x4*)(scale + 4 * lane + 256 * j); } }
          bf16_t* xn = (bf16_t*)(P.ws + WS_XN) + (size_t)row * DM;
#pragma unroll
          for (int j = 0; j < 4; ++j) { const int c = 4 * lane + 256 * j; const f32x4 g = gq[j], sh = shv[j], sc = scv[j];
            const f32x4 h = (v[i][j] * rstd * g) * (1.0f + sc) + sh; u32x2 w; w.x = pk2(h[0], h[1]); w.y = pk2(h[2], h[3]); *(u32x2*)(xn + c) = w; } } }
    }
  }
}

typedef const __attribute__((address_space(4))) Params* KargPtr;
__global__ void __launch_bounds__(NTHREADS, 2) fwd_mega(Params Pbyval) {
  extern __shared__ __attribute__((aligned(16))) unsigned char lds[];
  cg::grid_group grid = cg::this_grid();
  volatile LAS unsigned* bst = (volatile LAS unsigned*)((LAS unsigned char*)lds + (LDS_BYTES - 64));
  if (threadIdx.x < 2) bst[threadIdx.x] = 0u;
  __syncthreads();
  XcdBarrier xbar = xcd_barrier_post((unsigned*)(Pbyval.ws + WS_BAR), bst);
  const int G0 = gridDim.x, bx0 = blockIdx.x;
  const int ph_lo = Pbyval.lo, ph_hi = Pbyval.hi;

  const int wave0 = __builtin_amdgcn_readfirstlane(threadIdx.x >> 6);
  int ph_start = ph_lo;
  if (ph_lo == 0) {
    const int tid = threadIdx.x, lane = tid & 63, wave = wave0, G = G0, bx = bx0;
    const int vcu = (G % 8 == 0) ? (bx % 8) * (G / 8) + bx / 8 : bx, NGW = G * NWAVES, gw = vcu * NWAVES + wave;
    const Params& P = Pbyval; unsigned char* ws = P.ws;
      { LAS float* sc_l = (LAS float*)lds;
        LAS float* red = sc_l + 5 * DM;
        for (int i = tid; i < 5 * DM; i += NTHREADS) { const int r = i >> 10, k = i & 1023; const float c = (r < 4) ? P.in[1][r * DM + k] : P.in[3][k]; sc_l[i] = c / (1.0f + __expf(-c)); }
        __syncthreads();
        for (int task = bx; task < DEPTH * 96; task += G) { const int ly = task / 96, n0 = (task % 96) * 64;
          const float* W = P.in[4] + (size_t)ly * DM * 6 * DM + n0 + lane; float acc[5] = {0.f, 0.f, 0.f, 0.f, 0.f};
#pragma unroll 16
          for (int k = wave * 128; k < wave * 128 + 128; ++k) { const float w = __builtin_nontemporal_load(W + (size_t)k * 6 * DM);
#pragma unroll
            for (int r = 0; r < 5; ++r) acc[r] += sc_l[r * DM + k] * w; }
#pragma unroll
          for (int r = 0; r < 5; ++r) red[(wave * 5 + r) * 64 + lane] = acc[r];
          __syncthreads();
          if (tid < 320) { const int r = tid >> 6, n = tid & 63; float s = P.in[5][(size_t)ly * 6 * DM + n0 + n];
#pragma unroll
            for (int w = 0; w < 8; ++w) s += red[(w * 5 + r) * 64 + n];
            const int col = n0 + n; ((float*)(ws + WS_MOD))[((size_t)(ly * 5 + r) * 6 + (col >> 10)) * DM + (col & 1023)] = s; }
          __syncthreads(); }
      }
    ph_start = 1;
    if (ph_hi > 1) grid.sync();
  }
  int rep = 0; (void)rep;
#ifdef PROBE_EXTRA_SYNCS
  for (int i = 0; i < PROBE_EXTRA_SYNCS; ++i) xcd_barrier(xbar, (int)threadIdx.x);
#endif
  for (int ph = ph_start; ph < ph_hi; ++ph) {
#define FRESH_LANE(v) int v; asm volatile("v_mbcnt_lo_u32_b32 %0, -1, 0\n\tv_mbcnt_hi_u32_b32 %0, -1, %0" : "=v"(v))
    int wave = wave0; asm volatile("" : "+s"(wave));
    int G = G0, bx = bx0; asm volatile("" : "+s"(G), "+s"(bx));
    KargPtr Pq = (KargPtr)__builtin_amdgcn_kernarg_segment_ptr(); asm volatile("" : "+s"(Pq));
    const Params& P = *(const Params*)Pq;
    const int vcu = (G % 8 == 0) ? (bx % 8) * (G / 8) + bx / 8 : bx;
    const int NGW = G * NWAVES;
    const int gw = vcu * NWAVES + wave;
    unsigned char* ws = P.ws;
    const float* rope = (const float*)(ws + WS_ROPE);
    bf16_t* XN = (bf16_t*)(ws + WS_XN); bf16_t* SB = (bf16_t*)(ws + WS_S); bf16_t* QB = (bf16_t*)(ws + WS_Q); bf16_t* KB = (bf16_t*)(ws + WS_K); bf16_t* VB = (bf16_t*)(ws + WS_V);
    const int code = P.prog[ph], l = code >> 4, step = code & 15, kind = l % 3, jl = l / 3; const bool last = (l == DEPTH - 1);
    if (step == 1) {
      FRESH_LANE(lane); const int tid = wave * 64 + lane;
      { LAS float* scr = (LAS float*)lds + wave * (64 * 33);
        for (int it = gw; it < P.nitems; it += NGW) { int m = 0;
#pragma unroll 1
          for (int q = 1; q < NWD; ++q) if (it >= P.wd[q].first) m = q;
          transpose_item(P.wd[m], scr, it - P.wd[m].first, lane); } }
      for (int i = bx * NTHREADS + tid; i < SEQ * 32; i += G * NTHREADS) { const int t = i >> 5, p = i & 31; const float inv = powf(10000.0f, -(float)(p & 15) / 16.0f);
        const float ang = (float)((p < 16) ? (t >> 6) : (t & 63)) * inv; ((float*)(ws + WS_ROPE))[2 * i] = cosf(ang); ((float*)(ws + WS_ROPE))[2 * i + 1] = sinf(ang); }
      row_pass_multi<4>(P, gw, NGW, TOK, lane, P.in[0], P.in[2], false, nullptr, nullptr, 0, 0, true, P.in[6], 0, 0, 1);
#if FUSED_NORM
    } else if (step == 6 || step == 9) {
      pg8::Gemm g; g.M = last ? NLAT : TOK; g.N = DM;
      const unsigned char* wm = ws + WS_WMLA + (size_t)jl * MLA_W_STRIDE;
      pg8::NormArgs na; na.xlat = P.out; na.xctx = (float*)(ws + WS_XCTX); na.xn = XN; na.modl = (const float*)(ws + WS_MOD) + (size_t)l * 30 * DM;
      na.slot1 = (float*)(ws + WS_SLOT); na.slot2 = (float*)(ws + WS_SLOT + SLOT_BYTES);
      const int bank = (l * 2 + (step == 9 ? 1 : 0)) * 2; na.cnt1 = (unsigned*)(ws + WS_CNT + (size_t)bank * CNT_BANK); na.cnt2 = (unsigned*)(ws + WS_CNT + (size_t)(bank + 1) * CNT_BANK);
      if (step == 6) { g.A = XN; g.K = DM;
        g.Bt = (kind == 0) ? (const bf16_t*)(wm + MLA_OFF_WO) : (kind == 1) ? (const bf16_t*)(ws + WS_WNA + (size_t)3072 * 1024 * 2) : (const bf16_t*)(ws + WS_WSWA + (size_t)1280 * 1024 * 2);
        na.g_post = P.in[7] + l * DM; na.wgate = 2; na.do_norm = 1; na.g_pre = P.in[8] + l * DM; na.modn = na.modl; na.wshift = 3; na.wscale = 4;
      } else { g.A = QB; g.K = DFF; g.Bt = (const bf16_t*)(ws + WS_WFO) + (size_t)l * DM * DFF;
        const int ln = last ? l : l + 1;
        na.g_post = P.in[9] + l * DM; na.wgate = 5; na.do_norm = last ? 0 : 1; na.g_pre = P.in[6] + ln * DM; na.modn = (const float*)(ws + WS_MOD) + (size_t)ln * 30 * DM; na.wshift = 0; na.wscale = 1; }
      pg8::PanelOrder S; S.init(g.M, G, vcu); pg8::EpiNorm E{na, (LAS unsigned char*)lds + 131072};
#ifndef DBG_NO_GEMM
      FRESH_LANE(lane_f);
      pg8::gemm_phase<pg8::EpiNorm, pg8::PanelOrder, true, true>((LAS unsigned char*)lds, g, S, E, wave * 64 + lane_f);
#endif
      __syncthreads();
#endif
    } else if (step == 2 || step == 4 || step == 8 || ((step == 6 || step == 9) && !FUSED_NORM)) {
      const bool splitctx = SPLIT_CTX && (step == 6 || step == 9) && !last;
      const int ng = (step == 4 || splitctx) ? 2 : 1;
      for (int gi = 0; gi < ng; ++gi) {
        int nsplit = 1;
        pg8::Gemm g; g.nts = 0; pg8::EpiArgs ea; ea.rope = rope; ea.o1 = nullptr; ea.ldc = DM; ea.kind = 0; ea.o0 = nullptr; ea.g0 = nullptr; ea.g1 = nullptr; ea.xl = (LAS unsigned char*)lds + 131072;
        const unsigned char* wm = ws + WS_WMLA + (size_t)jl * MLA_W_STRIDE;
        g.M = (step >= 6 && (last || splitctx)) ? NLAT : TOK;
        if (step == 2) { g.A = XN; g.K = DM;
#if FUSE_LAT
          if (kind == 0) { g.Bt = (const bf16_t*)wm; g.N = 768; ea.kind = 6; ea.o0 = SB; ea.o1 = (bf16_t*)(ws + WS_KPE); ea.g0 = P.in[13] + jl * 256; ea.g1 = P.in[15] + jl * 256; }
#else
          if (kind == 0) { g.Bt = (const bf16_t*)wm; g.N = 768; ea.kind = 0; ea.o0 = VB; ea.ldc = 768; }
#endif
          else if (kind == 1) { g.Bt = (const bf16_t*)(ws + WS_WNA); g.N = 3072; ea.kind = 0; ea.o0 = QB; ea.ldc = 3072; }
          else { g.Bt = (const bf16_t*)(ws + WS_WSWA); g.N = 1280; ea.kind = 4; ea.o0 = QB; }
        } else if (step == 4) { g.K = 256;
          if (gi == 0) { g.A = SB; g.Bt = (const bf16_t*)(wm + MLA_OFF_UQ); g.N = 1536; ea.kind = 2; ea.o0 = QB; }
          else { g.A = SB + (size_t)TOK * 256; g.Bt = (const bf16_t*)(wm + MLA_OFF_UKV); g.N = 2048; ea.kind = 3; ea.o0 = KB; ea.o1 = VB; }
        } else if (step == 6) { g.A = XN; g.K = DM; g.N = DM; ea.kind = 0; ea.o0 = VB; ea.ldc = DM;
          g.Bt = (kind == 0) ? (const bf16_t*)(wm + MLA_OFF_WO) : (kind == 1) ? (const bf16_t*)(ws + WS_WNA + (size_t)3072 * 1024 * 2) : (const bf16_t*)(ws + WS_WSWA + (size_t)1280 * 1024 * 2);
        } else if (step == 8) { g.A = XN; g.K = DM; g.N = 2 * DFF; g.Bt = (const bf16_t*)(ws + WS_WFI) + (size_t)l * 2 * DFF * DM; ea.kind = 1; ea.o0 = QB; }
        else { g.A = QB; g.K = DFF; g.N = DM; g.Bt = (const bf16_t*)(ws + WS_WFO) + (size_t)l * DM * DFF; ea.kind = 0; ea.o0 = VB; ea.ldc = DM; }
        if (splitctx && gi == 1) {
          g.A += (size_t)NLAT * g.K; g.M = NCTX; g.nts = (step == 6) ? 2 : 4; nsplit = g.K / (g.nts * 64); ea.kind = 5; ea.o0 = (bf16_t*)(ws + WS_PART); }
        pg8::StaticOrder S; S.init(g.M, g.N, G, bx, nsplit); pg8::EpiGen E{ea};
#ifndef DBG_NO_GEMM
        int lane_g; asm volatile("v_mbcnt_lo_u32_b32 %0, -1, 0\n\tv_mbcnt_hi_u32_b32 %0, -1, %0" : "=v"(lane_g));
        pg8::gemm_phase<pg8::EpiGen, pg8::StaticOrder, true, true>((LAS unsigned char*)lds, g, S, E, wave * 64 + lane_g);
#endif
        __syncthreads();
      }
    } else if (step == 3) {
      FRESH_LANE(lane);
      const bf16_t* A1 = VB; const float* gq = P.in[13] + jl * 256; const float* gkv = P.in[15] + jl * 256;
      constexpr int NR = 4;
      for (int base = gw; base < TOK; base += NR * NGW) {
        u32x2 w[NR][2]; unsigned wk[NR]; float ss[2 * NR];
#pragma unroll
        for (int i = 0; i < NR; ++i) { const int row = base + i * NGW; const bf16_t* a = A1 + (size_t)(row < TOK ? row : 0) * 768;
          w[i][0] = __builtin_nontemporal_load((const u32x2*)(a + 4 * lane)); w[i][1] = __builtin_nontemporal_load((const u32x2*)(a + 256 + 4 * lane)); wk[i] = __builtin_nontemporal_load((const unsigned*)(a + 512 + 2 * (lane & 31))); }
#pragma unroll
        for (int i = 0; i < NR; ++i)
#pragma unroll
          for (int part = 0; part < 2; ++part) { const float x0 = __builtin_bit_cast(float, w[i][part].x << 16), x1 = __builtin_bit_cast(float, w[i][part].x & 0xffff0000u), x2 = __builtin_bit_cast(float, w[i][part].y << 16), x3 = __builtin_bit_cast(float, w[i][part].y & 0xffff0000u);
            ss[2 * i + part] = (x0 * x0 + x1 * x1) + (x2 * x2 + x3 * x3); }
        wave_sum_n<2 * NR>(ss, lane);
#pragma unroll
        for (int i = 0; i < NR; ++i) { const int row = base + i * NGW; if (row >= TOK) continue;
#pragma unroll
          for (int part = 0; part < 2; ++part) { const float x0 = __builtin_bit_cast(float, w[i][part].x << 16), x1 = __builtin_bit_cast(float, w[i][part].x & 0xffff0000u), x2 = __builtin_bit_cast(float, w[i][part].y << 16), x3 = __builtin_bit_cast(float, w[i][part].y & 0xffff0000u);
            const float rstd = 1.0f / sqrtf(ss[2 * i + part] * (1.0f / 256.0f) + NORM_EPS);
            const f32x4 g = *(const f32x4*)((part ? gkv : gq) + 4 * lane); u32x2 o; o.x = pk2(x0 * rstd * g[0], x1 * rstd * g[1]); o.y = pk2(x2 * rstd * g[2], x3 * rstd * g[3]);
            *(u32x2*)(SB + (size_t)part * TOK * 256 + (size_t)row * 256 + 4 * lane) = o; }
          if (lane < 32) { float x1 = __builtin_bit_cast(float, wk[i] << 16), x2 = __builtin_bit_cast(float, wk[i] & 0xffff0000u);
            int b, key;
            if (row < NLAT) { const int t = row & (SEQ - 1); const float c = rope[(t * 32 + lane) * 2], s = rope[(t * 32 + lane) * 2 + 1]; const float y1 = x1 * c - x2 * s, y2 = x2 * c + x1 * s; x1 = y1; x2 = y2; b = row >> 13; key = LC + t; }
            else { const int r2 = row - NLAT; b = r2 >> 8; key = r2 & 255; }
            const unsigned o = pk2(x1, x2);
#pragma unroll
            for (int h = 0; h < 8; ++h) *(unsigned*)(KB + ((size_t)(b * 8 + h) * MLA_KEYS + key) * 192 + 128 + 2 * lane) = o; } }
      }
    } else if (step == 5) {
      float* bias_l = (float*)(lds + 135168);
      if (kind == 0) {
        const int nun = last ? 1024 : 1056;
        for (int id = vcu; id < nun; id += G) { int lane_u; asm volatile("v_mbcnt_lo_u32_b32 %0, -1, 0\n\tv_mbcnt_hi_u32_b32 %0, -1, %0" : "=v"(lane_u)); const int tid_u = wave * 64 + lane_u;     att::UnitP u; u.m0 = -1e30f; u.l0 = 0.f; u.a0 = 0; u.a1 = 0;
          int bh, row0; if (id < 1024) { bh = id >> 5; row0 = (bh >> 3) * SEQ + (id & 31) * 256; u.NT = 4 + SEQ / 64; } else { bh = id - 1024; row0 = NLAT + (bh >> 3) * LC; u.NT = 4; }
          const int h = bh & 7; const bf16_t* Kbh = KB + (size_t)bh * MLA_KEYS * 128; const bf16_t* Vbh = VB + (size_t)bh * MLA_KEYS * 128;
          u.Pc = (const bf16_t*)(ws + WS_KPE) + (size_t)(bh >> 3) * MLA_KEYS * 64; u.Pn = u.Pc + (size_t)LC * 64;
          u.Q = QB + (size_t)row0 * 1536 + h * 192; u.Kc = Kbh; u.Vc = Vbh; u.Kn = Kbh + (size_t)LC * 128; u.Vn = Vbh + (size_t)LC * 128; u.O = XN + (size_t)row0 * DM + h * 128;
#ifndef DBG_NO_ATT0
          att::attn_unit<192, 128, 1536, 128, 128, 0, MLA_SDEPTH, MLA_SERIAL, MLA_EARLY>(u, (char*)lds, bias_l, tid_u);
#endif
        }
      } else if (kind == 1) {
        const float* rpb = P.in[19] + (size_t)jl * 16 * 465;
        const int nun = last ? 2048 : 2112;
        for (int id = vcu; id < nun; id += G) { int lane_u; asm volatile("v_mbcnt_lo_u32_b32 %0, -1, 0\n\tv_mbcnt_hi_u32_b32 %0, -1, %0" : "=v"(lane_u)); const int tid_u = wave * 64 + lane_u;     att::UnitP u; u.m0 = -1e30f; u.l0 = 0.f;
          int bh, row0, qb = 0; if (id < 2048) { bh = id >> 5; qb = id & 31; row0 = (bh >> 4) * SEQ + qb * 256; u.NT = 16; } else { bh = id - 2048; row0 = NLAT + (bh >> 4) * LC; u.NT = 4; }
          const int b = bh >> 4, h = bh & 15; const int R0 = qb * 4, KR0 = min(max(R0 - 4, 0), 116); u.a0 = R0; u.a1 = KR0;
          u.Q = QB + (size_t)row0 * 3072 + h * 64; u.Kc = QB + (size_t)(NLAT + b * LC) * 3072 + 1024 + h * 64; u.Vc = u.Kc + 1024;
          u.Kn = QB + (size_t)(b * SEQ + KR0 * 64) * 3072 + 1024 + h * 64; u.Vn = u.Kn + 1024; u.O = XN + (size_t)row0 * DM + h * 64;
          if (tid_u < 465) bias_l[tid_u] = rpb[h * 465 + tid_u] * 8.0f;
          __syncthreads();
#ifndef DBG_NO_ATT1
          att::attn_unit<64, 64, 3072, 3072, 3072, 1, NS_SDEPTH, false, false>(u, (char*)lds, bias_l, tid_u);
#endif
        }
      } else {
        const float* sink = P.in[22] + (size_t)jl * 16;
        const int nun = last ? 2048 : 2112;
        for (int id = vcu; id < nun; id += G) { int lane_u; asm volatile("v_mbcnt_lo_u32_b32 %0, -1, 0\n\tv_mbcnt_hi_u32_b32 %0, -1, %0" : "=v"(lane_u)); const int tid_u = wave * 64 + lane_u;     att::UnitP u; u.a1 = 0;
          int bh, row0, qb = 0; if (id < 2048) { bh = id >> 5; qb = id & 31; row0 = (bh >> 4) * SEQ + qb * 256; u.NT = 12; } else { bh = id - 2048; row0 = NLAT + (bh >> 4) * LC; u.NT = 4; }
          const int b = bh >> 4, h = bh & 15, kvh = h >> 3; u.a0 = qb * 256; u.m0 = sink[h] * 8.0f; u.l0 = 1.0f;
          u.Q = QB + (size_t)row0 * 1280 + h * 64; u.Kc = QB + (size_t)(NLAT + b * LC) * 1280 + 1024 + kvh * 64; u.Vc = u.Kc + 128;
          u.Kn = QB + (size_t)(b * SEQ) * 1280 + 1024 + kvh * 64; u.Vn = u.Kn + 128; u.O = XN + (size_t)row0 * DM + h * 64;
#ifndef DBG_NO_ATT2
          att::attn_unit<64, 64, 1280, 1280, 1280, 2, NS_SDEPTH, false, false>(u, (char*)lds, bias_l, tid_u);
#endif
        }
      }
    } else if (step == 7) {
      FRESH_LANE(lane);
      const float gsc = rep ? 0.0f : 1.0f; const bool first = (l == 0 && !rep);
      row_pass_multi<4>(P, gw, NGW, (SPLIT_CTX || last) ? NLAT : TOK, lane, first ? P.in[0] : P.out, first ? P.in[2] : (const float*)(ws + WS_XCTX), true, VB, P.in[7] + l * DM, l, 2, true, P.in[8] + l * DM, l, 3, 4, gsc);
      if (SPLIT_CTX && !last) row_pass_ctx(P, gw, NGW, lane, first ? P.in[2] : (const float*)(ws + WS_XCTX), (const float*)(ws + WS_PART), 8, P.in[7] + l * DM, l, 2, P.in[8] + l * DM, l, 3, 4, gsc);
    } else if (step == 10) {
      FRESH_LANE(lane);
      const int ln = last ? l : l + 1; const float gsc = rep ? 0.0f : 1.0f;
      row_pass_multi<4>(P, gw, NGW, (SPLIT_CTX || last) ? NLAT : TOK, lane, P.out, (const float*)(ws + WS_XCTX), true, VB, P.in[9] + l * DM, l, 5, !last, P.in[6] + ln * DM, ln, 0, 1, gsc);
      if (SPLIT_CTX && !last) row_pass_ctx(P, gw, NGW, lane, (const float*)(ws + WS_XCTX), (const float*)(ws + WS_PART), 11, P.in[9] + l * DM, l, 5, P.in[6] + ln * DM, ln, 0, 1, gsc);
    }
#ifdef PROBE_MASK
    if (((PROBE_MASK >> step) & 1) && (PROBE_REPEAT_KIND < 0 || kind == PROBE_REPEAT_KIND) && rep == 0) { rep = 1; int lane_b; asm volatile("v_mbcnt_lo_u32_b32 %0, -1, 0\n\tv_mbcnt_hi_u32_b32 %0, -1, %0" : "=v"(lane_b)); xcd_barrier(xbar, wave * 64 + lane_b); --ph; continue; }
    rep = 0;
#endif
    if (ph + 1 < ph_hi) { int lane_b; asm volatile("v_mbcnt_lo_u32_b32 %0, -1, 0\n\tv_mbcnt_hi_u32_b32 %0, -1, %0" : "=v"(lane_b)); xcd_barrier(xbar, wave * 64 + lane_b); }
  }
}

#ifndef N_LAUNCH_SPLIT
#define N_LAUNCH_SPLIT 0
#endif
extern "C" void kernel_launch(void* const* d_in, const int* in_sizes, int n_in, void* d_out, int out_size, void* d_ws, size_t ws_size, hipStream_t stream) {
  static int grid = 0;
  if (grid == 0) {
    if (n_in != 24 || out_size != NLAT * DM || ws_size < ((FUSED_NORM || SPLIT_CTX) ? WS_END : WS_NEED)) { fprintf(stderr, "kernel_launch: unexpected shapes n_in %d out %d ws %zu (need %zu)\n", n_in, out_size, ws_size, (size_t)((FUSED_NORM || SPLIT_CTX) ? WS_END : WS_NEED)); grid = -1; return; }
    int dev = 0, cus = 0, per_cu = 0;
    hipGetDevice(&dev); hipDeviceGetAttribute(&cus, hipDeviceAttributeMultiprocessorCount, dev);
    if (hipFuncSetAttribute((const void*)fwd_mega, hipFuncAttributeMaxDynamicSharedMemorySize, LDS_BYTES) != hipSuccess) { fprintf(stderr, "kernel_launch: hipFuncSetAttribute failed\n"); grid = -1; return; }
    if (hipOccupancyMaxActiveBlocksPerMultiprocessor(&per_cu, (const void*)fwd_mega, NTHREADS, LDS_BYTES) != hipSuccess || per_cu < 1) { fprintf(stderr, "kernel_launch: occupancy query says %d\n", per_cu); per_cu = 1; }
    (void)hipGetLastError();
    grid = cus * 1;
    fprintf(stderr, "kernel_launch: grid %d (cus %d, per_cu %d)\n", grid, cus, per_cu);
  }
  if (grid < 0) return;
  Params p{};
  for (int i = 0; i < 24; ++i) p.in[i] = (const float*)d_in[i];
  p.out = (float*)d_out; p.ws = (unsigned char*)d_ws;
  int n = 0; p.prog[n++] = 0; p.prog[n++] = 1;
  for (int l = 0; l < DEPTH; ++l) { const int kind = l % 3;
#if FUSED_NORM
    const int NS_MLA = 7, NS_O = 5; const int steps_mla[9] = {2, 3, 4, 5, 6, 8, 9, 0, 0}, steps_o[7] = {2, 5, 6, 8, 9, 0, 0};
#else
#if FUSE_LAT
    const int NS_MLA = 8, NS_O = 7; const int steps_mla[9] = {2, 4, 5, 6, 7, 8, 9, 10, 0}, steps_o[7] = {2, 5, 6, 7, 8, 9, 10};
#else
    const int NS_MLA = 9, NS_O = 7; const int steps_mla[9] = {2, 3, 4, 5, 6, 7, 8, 9, 10}, steps_o[7] = {2, 5, 6, 7, 8, 9, 10};
#endif
#endif

    if (kind == 0) for (int s = 0; s < NS_MLA; ++s) p.prog[n++] = (unsigned char)((l << 4) | steps_mla[s]); else for (int s = 0; s < NS_O; ++s) p.prog[n++] = (unsigned char)((l << 4) | steps_o[s]); }
  p.nph = n;
  unsigned char* ws = (unsigned char*)d_ws; int q = 0, first = 0;
  auto add = [&](const float* src, size_t dst_off, int K, int N, int Np, int kind) { WDesc& d = p.wd[q++]; d.src = src; d.dst = (bf16_t*)(ws + dst_off); d.K = K; d.N = N; d.Np = Np; d.kind = kind; d.first = first; d.pad = 0; first += (K / 64) * (Np / 32); };
  for (int l = 0; l < DEPTH; ++l) add(p.in[10] + (size_t)l * DM * 2 * DFF, WS_WFI + (size_t)l * 2 * DFF * DM * 2, DM, 2 * DFF, 2 * DFF, 1);
  for (int l = 0; l < DEPTH; ++l) add(p.in[11] + (size_t)l * DFF * DM, WS_WFO + (size_t)l * DM * DFF * 2, DFF, DM, DM, 0);
  for (int j = 0; j < 2; ++j) { const size_t b = WS_WMLA + j * MLA_W_STRIDE;
    add(p.in[12] + (size_t)j * DM * 576, b, DM, 576, 768, 2); add(p.in[14] + (size_t)j * 256 * 1536, b + MLA_OFF_UQ, 256, 1536, 1536, 3);
    add(p.in[16] + (size_t)j * 256 * 2048, b + MLA_OFF_UKV, 256, 2048, 2048, 0); add(p.in[17] + (size_t)j * DM * DM, b + MLA_OFF_WO, DM, DM, DM, 0); }
  add(p.in[18], WS_WNA, DM, 3072, 3072, 0); add(p.in[20], WS_WNA + (size_t)3072 * 1024 * 2, DM, DM, DM, 0);
  add(p.in[21], WS_WSWA, DM, 1280, 1280, 4); add(p.in[23], WS_WSWA + (size_t)1280 * 1024 * 2, DM, DM, DM, 0);
  p.nitems = first;
#if N_LAUNCH_SPLIT
  for (int ph = 0; ph < n; ++ph) { p.lo = ph; p.hi = ph + 1; hipLaunchKernelGGL(fwd_mega, dim3(grid), dim3(NTHREADS), LDS_BYTES, stream, p); }
#else
  p.lo = 0; p.hi = n;
  if (hipMemsetAsync((char*)d_ws + WS_BAR, 0, BAR_BYTES, stream) != hipSuccess) { fprintf(stderr, "kernel_launch: memset failed\n"); return; }
  void* args[] = {&p};
  hipError_t e = hipLaunchCooperativeKernel((const void*)fwd_mega, dim3(grid), dim3(NTHREADS), args, LDS_BYTES, stream);
  if (e != hipSuccess) fprintf(stderr, "kernel_launch: cooperative launch failed: %s (grid %d)\n", hipGetErrorString(e), grid);
#endif
}
```
